# Optimizing an MI355X kernel written in HIP

```python
import jax, jax.numpy as jnp
from jax import lax
import numpy as np

D_MODEL = 1024
BATCH = 16
SEQ = 2048
DEPTH = 2

HEAD_DIM = 64
EPS = 1e-6
LRU_WIDTH = D_MODEL // 2
LRU_BLOCKS = 8
LRU_BLOCK = LRU_WIDTH // LRU_BLOCKS
LRU_CONV = 4
LRU_C = 8.0
SB_HEADS = 8
SB_WIDTH = SB_HEADS * HEAD_DIM
Q_BLOCK = 128
N_EVEN_SPLITS = 5
SWA_HEADS = D_MODEL // HEAD_DIM
SWA_KV_HEADS = 4
SWA_GROUP = SWA_HEADS // SWA_KV_HEADS
WINDOW = 128
D_FF = 2816
FFN_CONV = 3
N_EVEN = (DEPTH + 1) // 2
N_ODD = DEPTH // 2

kernel_name = "hybrid_rglru_stickbreak_swasink_convffn"


def rms_norm(x, g):
    xf = x.astype(jnp.float32)
    y = xf * lax.rsqrt(jnp.mean(xf * xf, axis=-1, keepdims=True) + EPS)
    return (y * g.astype(jnp.float32)).astype(x.dtype)


def causal_dwconv(x, w, b):
    k_width, ch = w.shape
    y = lax.conv_general_dilated(
        x, w[:, None, :].astype(x.dtype), window_strides=(1,),
        padding=[(k_width - 1, 0)], dimension_numbers=("NWC", "WIO", "NWC"),
        feature_group_count=ch)
    return y + b.astype(x.dtype)


def adaln_params(c, w, b):
    m = jax.nn.silu(c) @ w + b
    return [t[:, None, :] for t in jnp.split(m, 6, axis=-1)]


def rg_lru(x, wa, ba, wx, bx, lam):
    bsz, seq, width = x.shape
    xb = x.reshape(bsz, seq, LRU_BLOCKS, LRU_BLOCK)
    r = jax.nn.sigmoid((jnp.einsum("bsnk,nkj->bsnj", xb, wa).reshape(bsz, seq, width) + ba).astype(jnp.float32))
    i = jax.nn.sigmoid((jnp.einsum("bsnk,nkj->bsnj", xb, wx).reshape(bsz, seq, width) + bx).astype(jnp.float32))
    log_a = -LRU_C * r * jax.nn.softplus(-lam.astype(jnp.float32))
    a = jnp.exp(log_a)
    u = jnp.sqrt(-jnp.expm1(2.0 * log_a)) * (i * x.astype(jnp.float32))

    def combine(e1, e2):
        a1, b1 = e1
        a2, b2 = e2
        return a1 * a2, a2 * b1 + b2

    _, h = lax.associative_scan(combine, (a, u), axis=1)
    return h.astype(x.dtype)


def stick_breaking(q, k, v):
    bsz, seq, heads, dh = q.shape
    nb = seq // Q_BLOCK
    scale = 1.0 / np.sqrt(dh)
    qb = q.reshape(bsz, nb, Q_BLOCK, heads, dh).transpose(1, 0, 3, 2, 4)
    kh = k.transpose(0, 2, 1, 3)
    vh = v.transpose(0, 2, 1, 3)
    kpos = jnp.arange(seq)

    def block(args):
        qi, blk = args
        z = jnp.einsum("bhqd,bhkd->bhqk", qi, kh).astype(jnp.float32) * scale
        qpos = blk * Q_BLOCK + jnp.arange(Q_BLOCK)
        mask = kpos[None, :] < qpos[:, None]
        sp = jnp.where(mask, jax.nn.softplus(z), 0.0)
        rev = lax.cumsum(sp, axis=3, reverse=True)
        w = jnp.exp(jnp.where(mask, z - rev, -jnp.inf))
        return jnp.einsum("bhqk,bhkd->bhqd", w.astype(v.dtype), vh)

    out = lax.map(block, (qb, jnp.arange(nb)))
    return out.transpose(1, 0, 3, 2, 4).reshape(bsz, seq, heads * dh)


def swa_sinks(q, k, v, sinks):
    bsz, seq, _, dh = q.shape
    nb = seq // WINDOW
    scale = 1.0 / np.sqrt(dh)
    qb = q.reshape(bsz, nb, WINDOW, SWA_KV_HEADS, SWA_GROUP, dh)

    def banded(t):
        tb = t.reshape(bsz, nb, WINDOW, SWA_KV_HEADS, dh)
        prev = jnp.concatenate([jnp.zeros_like(tb[:, :1]), tb[:, :-1]], axis=1)
        return jnp.concatenate([prev, tb], axis=2)

    kk, vv = banded(k), banded(v)
    s = jnp.einsum("bnqkgd,bnjkd->bnkgqj", qb, kk).astype(jnp.float32) * scale
    i = jnp.arange(WINDOW)[:, None]
    j = jnp.arange(2 * WINDOW)[None, :]
    band = (j > i) & (j <= i + WINDOW)
    blk = jnp.arange(nb)[:, None, None]
    mask = band[None] & ((j >= WINDOW)[None] | (blk > 0))
    s = jnp.where(mask[None, :, None, None], s, -jnp.inf)
    sink = sinks.astype(jnp.float32).reshape(SWA_KV_HEADS, SWA_GROUP)[None, None, :, :, None, None]
    m = jnp.maximum(jnp.max(s, axis=-1, keepdims=True), sink)
    p = jnp.exp(s - m)
    p = p / (jnp.sum(p, axis=-1, keepdims=True) + jnp.exp(sink - m))
    out = jnp.einsum("bnkgqj,bnjkd->bnqkgd", p.astype(v.dtype), vv)
    return out.reshape(bsz, seq, SWA_HEADS * dh)


def conv_ffn(h, w_gate, w_up, conv_w, conv_b, w_down):
    a = causal_dwconv(h @ w_gate, conv_w, conv_b)
    return (jax.nn.silu(a) * (h @ w_up)) @ w_down


def setup_inputs(seed: int = 0) -> dict:
    key = jax.random.key(seed)
    ks = iter(jax.random.split(key, 40))

    def nrm(shape, scale):
        return jax.random.normal(next(ks), shape, jnp.float32) * scale

    d = D_MODEL
    u = jax.random.uniform(next(ks), (N_EVEN, LRU_WIDTH), jnp.float32, minval=0.9, maxval=0.999)
    a0 = u ** (1.0 / LRU_C)
    lam = jnp.log(a0) - jnp.log1p(-a0)
    return {
        "x": nrm((BATCH, SEQ, d), 1.0),
        "c": nrm((BATCH, d), 1.0),
        "ada_w": nrm((DEPTH, d, 6 * d), 0.5 * d ** -0.5),
        "ada_b": nrm((DEPTH, 6 * d), 0.02),
        "norm_mix_g": 1.0 + nrm((DEPTH, d), 0.02),
        "norm_ffn_g": 1.0 + nrm((DEPTH, d), 0.02),
        "ev_w_in": nrm((N_EVEN, d, N_EVEN_SPLITS * LRU_WIDTH), d ** -0.5),
        "ev_conv_w": nrm((N_EVEN, LRU_CONV, LRU_WIDTH), LRU_CONV ** -0.5),
        "ev_conv_b": nrm((N_EVEN, LRU_WIDTH), 0.02),
        "ev_wa": nrm((N_EVEN, LRU_BLOCKS, LRU_BLOCK, LRU_BLOCK), LRU_BLOCK ** -0.5),
        "ev_ba": nrm((N_EVEN, LRU_WIDTH), 0.02),
        "ev_wx": nrm((N_EVEN, LRU_BLOCKS, LRU_BLOCK, LRU_BLOCK), LRU_BLOCK ** -0.5),
        "ev_bx": nrm((N_EVEN, LRU_WIDTH), 0.02),
        "ev_lam": lam,
        "ev_qn_g": 1.0 + nrm((N_EVEN, HEAD_DIM), 0.02),
        "ev_kn_g": 1.0 + nrm((N_EVEN, HEAD_DIM), 0.02),
        "ev_w_out": nrm((N_EVEN, LRU_WIDTH + SB_WIDTH, d), (LRU_WIDTH + SB_WIDTH) ** -0.5),
        "od_w_in": nrm((N_ODD, d, (SWA_HEADS + 2 * SWA_KV_HEADS) * HEAD_DIM), d ** -0.5),
        "od_qn_g": 1.0 + nrm((N_ODD, HEAD_DIM), 0.02),
        "od_kn_g": 1.0 + nrm((N_ODD, HEAD_DIM), 0.02),
        "od_sinks": nrm((N_ODD, SWA_HEADS), 1.0),
        "od_w_out": nrm((N_ODD, SWA_HEADS * HEAD_DIM, d), (SWA_HEADS * HEAD_DIM) ** -0.5),
        "ffn_w_gate": nrm((DEPTH, d, D_FF), d ** -0.5),
        "ffn_w_up": nrm((DEPTH, d, D_FF), d ** -0.5),
        "ffn_conv_w": nrm((DEPTH, FFN_CONV, D_FF), FFN_CONV ** -0.5),
        "ffn_conv_b": nrm((DEPTH, D_FF), 0.02),
        "ffn_w_down": nrm((DEPTH, D_FF, d), D_FF ** -0.5),
    }


def reference(x, c, ada_w, ada_b, norm_mix_g, norm_ffn_g,
              ev_w_in, ev_conv_w, ev_conv_b, ev_wa, ev_ba, ev_wx, ev_bx, ev_lam,
              ev_qn_g, ev_kn_g, ev_w_out,
              od_w_in, od_qn_g, od_kn_g, od_sinks, od_w_out,
              ffn_w_gate, ffn_w_up, ffn_conv_w, ffn_conv_b, ffn_w_down):
    bsz, seq, _ = x.shape
    for layer in range(DEPTH):
        sh1, sc1, g1, sh2, sc2, g2 = adaln_params(c, ada_w[layer], ada_b[layer])
        h = rms_norm(x, norm_mix_g[layer]) * (1.0 + sc1) + sh1
        if layer % 2 == 0:
            e = layer // 2
            xr, gr, q, k, v = jnp.split(h @ ev_w_in[e], N_EVEN_SPLITS, axis=-1)
            xr = causal_dwconv(xr, ev_conv_w[e], ev_conv_b[e])
            hr = rg_lru(xr, ev_wa[e], ev_ba[e], ev_wx[e], ev_bx[e], ev_lam[e])
            ya = hr * jax.nn.gelu(gr)
            q = rms_norm(q.reshape(bsz, seq, SB_HEADS, HEAD_DIM), ev_qn_g[e])
            k = rms_norm(k.reshape(bsz, seq, SB_HEADS, HEAD_DIM), ev_kn_g[e])
            v = v.reshape(bsz, seq, SB_HEADS, HEAD_DIM)
            yb = stick_breaking(q, k, v)
            mix = jnp.concatenate([ya, yb], axis=-1) @ ev_w_out[e]
        else:
            o = layer // 2
            p = h @ od_w_in[o]
            q_w = SWA_HEADS * HEAD_DIM
            kv_w = SWA_KV_HEADS * HEAD_DIM
            q = rms_norm(p[..., :q_w].reshape(bsz, seq, SWA_HEADS, HEAD_DIM), od_qn_g[o])
            k = rms_norm(p[..., q_w:q_w + kv_w].reshape(bsz, seq, SWA_KV_HEADS, HEAD_DIM), od_kn_g[o])
            v = p[..., q_w + kv_w:].reshape(bsz, seq, SWA_KV_HEADS, HEAD_DIM)
            mix = swa_sinks(q, k, v, od_sinks[o]) @ od_w_out[o]
        x = x + g1 * mix
        h = rms_norm(x, norm_ffn_g[layer]) * (1.0 + sc2) + sh2
        x = x + g2 * conv_ffn(h, ffn_w_gate[layer], ffn_w_up[layer], ffn_conv_w[layer],
                              ffn_conv_b[layer], ffn_w_down[layer])
    return x
```

```cpp
#include <hip/hip_runtime.h>
#include <hip/hip_cooperative_groups.h>
#include <cstdio>
#include <cstdint>
namespace cg = cooperative_groups;

#define LAS __attribute__((address_space(3)))
typedef unsigned short bf16_t;
typedef short bf16x8 __attribute__((ext_vector_type(8)));
typedef short s16x4 __attribute__((ext_vector_type(4)));
typedef float f32x4 __attribute__((ext_vector_type(4)));
typedef float f32x2 __attribute__((ext_vector_type(2)));
typedef float f32x16 __attribute__((ext_vector_type(16)));
typedef unsigned u32x4 __attribute__((ext_vector_type(4)));
typedef unsigned u32x2 __attribute__((ext_vector_type(2)));
typedef __bf16 bf2_t __attribute__((ext_vector_type(2)));

__device__ __forceinline__ unsigned pk2(float lo, float hi) { f32x2 v = {lo, hi}; bf2_t r = __builtin_convertvector(v, bf2_t); return __builtin_bit_cast(unsigned, r); }
__device__ __forceinline__ float bflo(unsigned u) { return __uint_as_float(u << 16); }
__device__ __forceinline__ float bfhi(unsigned u) { return __uint_as_float(u & 0xffff0000u); }
#define LDS_WAIT() asm volatile("s_waitcnt lgkmcnt(0)" ::: "memory")

constexpr int NB = 16, SEQ = 2048, DM = 1024, M = NB * SEQ, FF = 2816;
constexpr float EPS = 1e-6f;
constexpr float LOG2E = 1.4426950408889634f;
constexpr float QSCALE = 0.125f * LOG2E;

constexpr size_t MiB = 1u << 20;
constexpr size_t WS_SSQ1 = 0, WS_SSQ2 = 128 * 1024, WS_SSQ3 = 256 * 1024, WS_ZERO_BYTES = 512 * 1024;
constexpr size_t WS_SSQ0 = 512 * 1024;
constexpr size_t WS_MOD = 1 * MiB;
constexpr size_t WS_SHW = 2 * MiB;
constexpr size_t SHW_IN0 = 0, SHW_GU0 = 16 * 2560, SHW_IN1 = SHW_GU0 + 16 * 5632, SHW_GU1 = SHW_IN1 + 16 * 1536;
constexpr size_t WS_HALO = 3 * MiB, WS_FIXP = 15 * MiB, WS_FIXU = 27 * MiB;
constexpr size_t WS_W_IN0 = 40 * MiB, WS_W_OUT0 = 45 * MiB, WS_W_GU0 = 47 * MiB, WS_W_DN0 = 58 * MiB;
constexpr size_t WS_W_IN1 = 64 * MiB, WS_W_OUT1 = 67 * MiB, WS_W_GU1 = 69 * MiB, WS_W_DN1 = 80 * MiB;
constexpr size_t WS_XG = 96 * MiB;
constexpr size_t WS_P = 160 * MiB;
constexpr size_t WS_Y = 320 * MiB;
constexpr size_t WS_ACT = 160 * MiB;
constexpr size_t WS_END = 384 * MiB;

constexpr int LDS_BYTES = 147456;

namespace pg8 {
constexpr int BM = 256, BK = 64, HALF = 128, HTB = HALF * BK * 2, STAGE_BYTES = 8 * HTB, NXCD = 8, WGM = 8;
__host__ __device__ __forceinline__ int lds_byte(int r, int c) { const int st = (r >> 4) * 2 + (c >> 5), rr = r & 15, cc = c & 31, ob = rr * 64 + cc * 2; return st * 1024 + (ob ^ (((ob >> 9) & 1) << 5)); }
__host__ __device__ __forceinline__ void stage_rc(int b, int& R, int& C) { const int st = b / 1024, sb = b % 1024, swz = sb ^ (((sb >> 9) & 1) << 5); R = (st >> 1) * 16 + swz / 64; C = (st & 1) * 32 + (swz % 64) / 2; }
struct Unit { int pm, pn; };
struct Gemm { const bf16_t* A; const bf16_t* Bt; int M, N, K; };
struct StaticOrder {
    int nM, nN, nwg, G, c;
    __host__ __device__ void init(int M_, int N_, int G_, int c_) { nM = M_ / BM; nN = N_ / BM; nwg = nM * nN; G = G_; c = c_; }
    __host__ __device__ bool next(int i, Unit& u) const {
        const long L = (long)i * G + c; if (L >= nwg) return false;
        int wgid = (int)L; { const int q = nwg / NXCD, r = nwg % NXCD, xcd = wgid % NXCD, off = wgid / NXCD; wgid = (xcd < r ? xcd * (q + 1) : r * (q + 1) + (xcd - r) * q) + off; }
        const int nig = WGM * nN, gid = wgid / nig, fm = gid * WGM, gsz = (nM - fm) < WGM ? (nM - fm) : WGM;
        u.pm = fm + ((wgid % nig) % gsz); u.pn = (wgid % nig) / gsz; return true;
    }
};

template <class Epi, bool ALIGN_EPI = true, bool SP2 = true>
__device__ __forceinline__ void gemm_phase(LAS unsigned char* lds, const Gemm g, const StaticOrder& S, const Epi& E, const int tid) {
    const int wid = __builtin_amdgcn_readfirstlane(tid >> 6), lane = tid & 63, wr = wid >> 2, wc = wid & 3, fr = lane & 15, fq = lane >> 4;
    const int K = g.K, nt = K / BK;
    unsigned voffA[2];
#pragma unroll
    for (int i = 0; i < 2; ++i) { int R, C; stage_rc(tid * 16 + i * 8192, R, C); voffA[i] = (unsigned)(R * K + C) * 2u; }
    const size_t kstep = (size_t)(BK * 2);
    const size_t hstep = (size_t)HALF * K * 2;
    const size_t tstep = 2 * hstep;
    const unsigned ldsw = (unsigned)wid * 1024u;
    const int aoff = lds_byte(wr * 64 + fr, fq * 8), boff = lds_byte(wc * 32 + fr, fq * 8);
#define PG8_SA(b, h) (((b) * 2 + (h)) * HTB)
#define PG8_SB(b, h) ((4 + (b) * 2 + (h)) * HTB)
#define PG8_STAGE(bufoff, gbase, voff) do { _Pragma("unroll") for (int _i = 0; _i < 2; ++_i) \
        __builtin_amdgcn_global_load_lds((const unsigned*)((const char*)(gbase) + (voff)[_i]), (LAS unsigned*)(lds + (bufoff) + ldsw + _i * 8192), 16, 0, 0); } while (0)
#define PG8_LDA(dst, b, h) do { _Pragma("unroll") for (int m = 0; m < 4; ++m) _Pragma("unroll") for (int k = 0; k < 2; ++k) dst[m][k] = *(const LAS bf16x8*)(lds + PG8_SA(b, h) + aoff + m * 2048 + k * 1024); } while (0)
#define PG8_LDB(dst, b, h) do { _Pragma("unroll") for (int n = 0; n < 2; ++n) _Pragma("unroll") for (int k = 0; k < 2; ++k) dst[n][k] = *(const LAS bf16x8*)(lds + PG8_SB(b, h) + boff + n * 2048 + k * 1024); } while (0)
#define PG8_MMA(ai, bj, At, Bt) do { __builtin_amdgcn_s_setprio(1); _Pragma("unroll") for (int m = 0; m < 4; ++m) _Pragma("unroll") for (int n = 0; n < 2; ++n) _Pragma("unroll") for (int k = 0; k < 2; ++k) \
        acc[ai][bj][m][n] = __builtin_amdgcn_mfma_f32_16x16x32_bf16(Bt[n][k], At[m][k], acc[ai][bj][m][n], 0, 0, 0); __builtin_amdgcn_s_setprio(0); } while (0)
#define PG8_WAIT_V(n) asm volatile("s_waitcnt vmcnt(" #n ")" ::: "memory")
#define PG8_WAIT_L(n) asm volatile("s_waitcnt lgkmcnt(" #n ")" ::: "memory")
#define PG8_BAR __builtin_amdgcn_s_barrier()
#define PG8_SCHED __builtin_amdgcn_sched_barrier(0)
    Unit cur, nxt; int ui = 0;
    if (!S.next(0, cur)) return;
    f32x4 acc[2][2][4][2];
#pragma unroll
    for (int a = 0; a < 2; ++a)
#pragma unroll
        for (int b = 0; b < 2; ++b)
#pragma unroll
            for (int m = 0; m < 4; ++m)
#pragma unroll
                for (int n = 0; n < 2; ++n) acc[a][b][m][n] = (f32x4){0.f, 0.f, 0.f, 0.f};
    bf16x8 At[4][2], B0[2][2], B1[2][2];
    const char* cA = (const char*)g.A + (size_t)cur.pm * tstep; const char* cB = (const char*)g.Bt + (size_t)cur.pn * tstep;
    {
        PG8_STAGE(PG8_SB(0, 0), cB, voffA); PG8_STAGE(PG8_SB(0, 1), cB + hstep, voffA); PG8_STAGE(PG8_SA(0, 0), cA, voffA); PG8_STAGE(PG8_SA(0, 1), cA + hstep, voffA);
        if (wr == 1) PG8_BAR;
        PG8_WAIT_V(2); PG8_BAR;
        PG8_STAGE(PG8_SB(1, 0), cB + kstep, voffA); PG8_STAGE(PG8_SA(1, 0), cA + kstep, voffA); PG8_STAGE(PG8_SB(1, 1), cB + hstep + kstep, voffA);
        PG8_WAIT_V(6); PG8_BAR;
    }
    for (;;) {
        const bool has_next = S.next(ui + 1, nxt);
        const char* nA = has_next ? (const char*)g.A + (size_t)nxt.pm * tstep : cA; const char* nB = has_next ? (const char*)g.Bt + (size_t)nxt.pn * tstep : cB;
        for (int t = 0; t < nt; t += 2) {
            const bool last = (t == nt - 2);
            const char* a1 = cA + (size_t)(t + 1) * kstep;
            const char* a2 = last ? nA : cA + (size_t)(t + 2) * kstep; const char* b2 = last ? nB : cB + (size_t)(t + 2) * kstep;
            const char* a3 = a2 + kstep; const char* b3 = b2 + kstep;
            PG8_LDB(B0, 0, 0); PG8_LDB(B1, 0, 1); PG8_SCHED; PG8_LDA(At, 0, 0); PG8_STAGE(PG8_SA(1, 1), a1 + hstep, voffA);
            PG8_WAIT_V(8); PG8_WAIT_L(0); PG8_BAR; PG8_MMA(0, 0, At, B0); PG8_MMA(0, 1, At, B1); PG8_BAR; PG8_SCHED;
            PG8_LDA(At, 0, 1); PG8_STAGE(PG8_SB(0, 0), b2, voffA); PG8_STAGE(PG8_SB(0, 1), b2 + hstep, voffA); PG8_STAGE(PG8_SA(0, 0), a2, voffA);
            PG8_WAIT_V(8); PG8_WAIT_L(0); PG8_BAR; PG8_MMA(1, 0, At, B0); PG8_MMA(1, 1, At, B1); PG8_BAR; PG8_SCHED;
            PG8_LDB(B0, 1, 0); PG8_LDB(B1, 1, 1); PG8_SCHED; PG8_LDA(At, 1, 0); PG8_STAGE(PG8_SA(0, 1), a2 + hstep, voffA);
            PG8_WAIT_V(8); PG8_WAIT_L(0); PG8_BAR; PG8_MMA(0, 0, At, B0); PG8_MMA(0, 1, At, B1); PG8_BAR; PG8_SCHED;
            PG8_LDA(At, 1, 1); PG8_STAGE(PG8_SB(1, 0), b3, voffA); PG8_STAGE(PG8_SB(1, 1), b3 + hstep, voffA); PG8_STAGE(PG8_SA(1, 0), a3, voffA);
            PG8_WAIT_V(8); PG8_WAIT_L(0); PG8_BAR; PG8_MMA(1, 0, At, B0); PG8_MMA(1, 1, At, B1); PG8_BAR; PG8_SCHED;
        }
        if constexpr (ALIGN_EPI) { if (wr == 0) PG8_BAR; }
        E(acc, cur, wr, wc, fr, fq);
        if (!has_next) break;
#pragma unroll
        for (int a = 0; a < 2; ++a)
#pragma unroll
            for (int b = 0; b < 2; ++b)
#pragma unroll
                for (int m = 0; m < 4; ++m)
#pragma unroll
                    for (int n = 0; n < 2; ++n) acc[a][b][m][n] = (f32x4){0.f, 0.f, 0.f, 0.f};
        cur = nxt; cA = nA; cB = nB; ++ui;
        if constexpr (ALIGN_EPI) { if (wr == 1) PG8_BAR; }
    }
    PG8_WAIT_V(0);
    if constexpr (!ALIGN_EPI) { if (wr == 0) PG8_BAR; }
    PG8_BAR;
#undef PG8_SA
#undef PG8_SB
#undef PG8_STAGE
#undef PG8_LDA
#undef PG8_LDB
#undef PG8_MMA
#undef PG8_WAIT_V
#undef PG8_WAIT_L
#undef PG8_BAR
#undef PG8_SCHED
}
}
using pg8::Unit;


template <int LAYER> struct EpiIn {
    const float* ssq; const float* shw; int N; bf16_t* P; const float* gq; const float* gk;
    __device__ __forceinline__ void operator()(const f32x4 (&acc)[2][2][4][2], const Unit& u, int wr, int wc, int fr, int fq) const {
        const int b = u.pm >> 3;
        bf16_t* base; int ld, col0, mode;
        if (LAYER == 0) { const int region = u.pn >> 1; base = P + (size_t)region * M * 512; ld = 512; col0 = (u.pn & 1) * 256; mode = region == 2 ? 1 : (region == 3 ? 2 : 0); }
        else {
            if (u.pn < 4) { base = P; ld = 1024; col0 = u.pn * 256; mode = 1; }
            else if (u.pn == 4) { base = P + (size_t)M * 1024; ld = 256; col0 = 0; mode = 2; }
            else { base = P + (size_t)M * 1024 + (size_t)M * 256; ld = 256; col0 = 0; mode = 0; }
        }
        const float* bias = shw + (size_t)b * N + u.pn * 256 + wc * 32 + 4 * fq;
        f32x4 bv[2][2];
#pragma unroll
        for (int bj = 0; bj < 2; ++bj)
#pragma unroll
            for (int n = 0; n < 2; ++n) bv[bj][n] = *(const f32x4*)(bias + bj * 128 + n * 16);
        if (mode == 0) {
#pragma unroll
            for (int ai = 0; ai < 2; ++ai)
#pragma unroll
                for (int m = 0; m < 4; ++m) {
                    const int row = u.pm * 256 + ai * 128 + wr * 64 + m * 16 + fr;
                    const float rs = rsqrtf(ssq[row] * (1.0f / 1024.0f) + EPS);
                    bf16_t* rp = base + (size_t)row * ld + col0 + wc * 32 + 4 * fq;
#pragma unroll
                    for (int bj = 0; bj < 2; ++bj)
#pragma unroll
                        for (int n = 0; n < 2; ++n) { const f32x4 v = acc[ai][bj][m][n] * rs + bv[bj][n]; u32x2 w; w.x = pk2(v[0], v[1]); w.y = pk2(v[2], v[3]); *(u32x2*)(rp + bj * 128 + n * 16) = w; }
                }
        } else {
            const float* gn = (mode == 1) ? gq : gk; const float sc = (mode == 1) ? QSCALE : 1.0f;
            f32x4 gv[2][2];
#pragma unroll
            for (int bj = 0; bj < 2; ++bj)
#pragma unroll
                for (int n = 0; n < 2; ++n) gv[bj][n] = *(const f32x4*)(gn + 32 * bj + 16 * n + 4 * fq) * sc;
#pragma unroll
            for (int ai = 0; ai < 2; ++ai)
#pragma unroll
                for (int m = 0; m < 4; ++m) {
                    const int row = u.pm * 256 + ai * 128 + wr * 64 + m * 16 + fr;
                    const float rs = rsqrtf(ssq[row] * (1.0f / 1024.0f) + EPS);
                    f32x4 v[2][2]; float ss = 0.f;
#pragma unroll
                    for (int bj = 0; bj < 2; ++bj)
#pragma unroll
                        for (int n = 0; n < 2; ++n) { v[bj][n] = acc[ai][bj][m][n] * rs + bv[bj][n]; const f32x4 q = v[bj][n] * v[bj][n]; ss += (q[0] + q[1]) + (q[2] + q[3]); }
                    ss += __shfl_xor(ss, 16); ss += __shfl_xor(ss, 32);
                    const float hr = rsqrtf(ss * (1.0f / 64.0f) + EPS);
                    bf16_t* rp = base + (size_t)row * ld + col0 + 64 * wc + 4 * fq;
#pragma unroll
                    for (int bj = 0; bj < 2; ++bj)
#pragma unroll
                        for (int n = 0; n < 2; ++n) { const f32x4 o = v[bj][n] * hr * gv[bj][n]; u32x2 w; w.x = pk2(o[0], o[1]); w.y = pk2(o[2], o[3]); *(u32x2*)(rp + 32 * bj + 16 * n) = w; }
                }
        }
    }
};

template <bool LAST> struct EpiRes {
    const float* xin; float* xout; const float* gate; const float* ng; const float* nsc; bf16_t* xg; float* ssq;
    __device__ __forceinline__ void operator()(const f32x4 (&acc)[2][2][4][2], const Unit& u, int wr, int wc, int fr, int fq) const {
        const int b = u.pm >> 3;
        const int col = u.pn * 256 + wc * 32 + 4 * fq;
        f32x4 gt[2][2], gm[2][2];
#pragma unroll
        for (int bj = 0; bj < 2; ++bj)
#pragma unroll
            for (int n = 0; n < 2; ++n) {
                gt[bj][n] = *(const f32x4*)(gate + (size_t)b * 6144 + col + bj * 128 + n * 16);
                if (!LAST) gm[bj][n] = *(const f32x4*)(ng + col + bj * 128 + n * 16) * (*(const f32x4*)(nsc + (size_t)b * 6144 + col + bj * 128 + n * 16) + 1.0f);
            }
#pragma unroll
        for (int ai = 0; ai < 2; ++ai)
#pragma unroll
            for (int m = 0; m < 4; ++m) {
                const int row = u.pm * 256 + ai * 128 + wr * 64 + m * 16 + fr;
                const size_t off = (size_t)row * 1024 + col;
                float s = 0.f;
#pragma unroll
                for (int bj = 0; bj < 2; ++bj)
#pragma unroll
                    for (int n = 0; n < 2; ++n) {
                        const f32x4 xi = *(const f32x4*)(xin + off + bj * 128 + n * 16);
                        const f32x4 v = xi + gt[bj][n] * acc[ai][bj][m][n];
                        *(f32x4*)(xout + off + bj * 128 + n * 16) = v;
                        if (!LAST) {
                            const f32x4 q = v * v; s += (q[0] + q[1]) + (q[2] + q[3]);
                            const f32x4 o = v * gm[bj][n]; u32x2 w; w.x = pk2(o[0], o[1]); w.y = pk2(o[2], o[3]); *(u32x2*)(xg + off + bj * 128 + n * 16) = w;
                        }
                    }
                if (!LAST) { s += __shfl_xor(s, 16); s += __shfl_xor(s, 32); if (fq == 0) unsafeAtomicAdd(ssq + row, s); }
            }
    }
};

__device__ __forceinline__ f32x4 silu4(f32x4 a) {
    f32x4 r;
#pragma unroll
    for (int e = 0; e < 4; ++e) r[e] = a[e] * __builtin_amdgcn_rcpf(1.0f + __builtin_amdgcn_exp2f(-a[e] * LOG2E));
    return r;
}
__device__ __forceinline__ f32x4 shfl4(f32x4 v, int src) { f32x4 r; r[0] = __shfl(v[0], src); r[1] = __shfl(v[1], src); r[2] = __shfl(v[2], src); r[3] = __shfl(v[3], src); return r; }
struct EpiGU {
    const float* ssq; const float* shw; const float* cw; const float* cbias; bf16_t* act; float* halo; float* fixp; float* fixu;
    __device__ __forceinline__ void operator()(const f32x4 (&acc)[2][2][4][2], const Unit& u, int wr, int wc, int fr, int fq) const {
        const int b = u.pm >> 3;
        const int lane = fq * 16 + fr;
        const int src1 = (lane & 48) | ((fr + 15) & 15), src2 = (lane & 48) | ((fr + 14) & 15);
        const int fcol = u.pn * 128 + wc * 32 + 4 * fq;
        const float* bias = shw + (size_t)b * 5632 + u.pn * 256 + wc * 32 + 4 * fq;
#pragma unroll
        for (int n = 0; n < 2; ++n) {
            const f32x4 bg = *(const f32x4*)(bias + n * 16), bu = *(const f32x4*)(bias + 128 + n * 16);
            const f32x4 w0 = *(const f32x4*)(cw + fcol + n * 16), w1 = *(const f32x4*)(cw + FF + fcol + n * 16), w2 = *(const f32x4*)(cw + 2 * FF + fcol + n * 16);
            const f32x4 cb = *(const f32x4*)(cbias + fcol + n * 16);
#pragma unroll
            for (int ai = 0; ai < 2; ++ai) {
                const int gs = u.pm * 4 + ai * 2 + wr;
                f32x4 gprev = (f32x4){0.f, 0.f, 0.f, 0.f};
#pragma unroll
                for (int m = 0; m < 4; ++m) {
                    const int row = gs * 64 + m * 16 + fr;
                    const float rs = rsqrtf(ssq[row] * (1.0f / 1024.0f) + EPS);
                    const f32x4 g = acc[ai][0][m][n] * rs + bg;
                    const f32x4 up = acc[ai][1][m][n] * rs + bu;
                    const f32x4 c1 = shfl4(g, src1), c2 = shfl4(g, src2), p1 = shfl4(gprev, src1), p2 = shfl4(gprev, src2);
                    const f32x4 g1 = fr >= 1 ? c1 : p1;
                    const f32x4 g2 = fr >= 2 ? c2 : p2;
                    if (m == 0 && fr < 2) {
                        f32x4 pp = w2 * g + cb; if (fr == 1) pp = pp + w1 * g1;
                        const size_t fo = ((size_t)gs * 2 + fr) * FF + fcol + n * 16;
                        *(f32x4*)(fixp + fo) = pp; *(f32x4*)(fixu + fo) = up;
                    } else {
                        const f32x4 a = w2 * g + w1 * g1 + w0 * g2 + cb;
                        const f32x4 o = silu4(a) * up;
                        u32x2 w; w.x = pk2(o[0], o[1]); w.y = pk2(o[2], o[3]);
                        *(u32x2*)(act + (size_t)row * FF + fcol + n * 16) = w;
                    }
                    if (m == 3 && fr >= 14) *(f32x4*)(halo + ((size_t)gs * 2 + (fr - 14)) * FF + fcol + n * 16) = g;
                    gprev = g;
                }
            }
        }
    }
};

#define MFMA32(a, b, c) __builtin_amdgcn_mfma_f32_32x32x16_bf16((a), (b), (c), 0, 0, 0)
__device__ __forceinline__ int crow(int i, int h) { return (i & 3) + 8 * (i >> 2) + 4 * h; }
__device__ __forceinline__ bf16x8 pack8(float a0, float a1, float a2, float a3, float a4, float a5, float a6, float a7) {
    u32x4 p; p.x = pk2(a0, a1); p.y = pk2(a2, a3); p.z = pk2(a4, a5); p.w = pk2(a6, a7); return __builtin_bit_cast(bf16x8, p);
}
__device__ __forceinline__ bf16x8 tr8(const LAS unsigned char* p_lo, int hi_off) {
    const s16x4 lo = __builtin_amdgcn_ds_read_tr16_b64_v4i16((LAS s16x4*)p_lo);
    const s16x4 hi = __builtin_amdgcn_ds_read_tr16_b64_v4i16((LAS s16x4*)(p_lo + hi_off));
    return __builtin_shufflevector(lo, hi, 0, 1, 2, 3, 4, 5, 6, 7);
}

constexpr int KSTR = 144, VSTR = 192, KBUF = 64 * KSTR, VBUF = 64 * VSTR, SB_VOFF = 2 * KBUF, SB_FLAG = SB_VOFF + 2 * VBUF;
__device__ __forceinline__ void sb_unit(LAS unsigned char* lds, const bf16_t* Q, const bf16_t* K, const bf16_t* V, bf16_t* Y, int b, int h, int qb, int tid, int wid, int lane) {
    const int r = lane & 31, hh = lane >> 5;
    const int q0 = qb * 256, qw0 = q0 + 32 * wid, qblk = qw0 >> 5;
    const size_t rowbase = (size_t)b * SEQ;
    bf16x8 qf[4];
    { const bf16_t* qp = Q + (rowbase + qw0 + r) * 512 + h * 64 + 8 * hh;
#pragma unroll
      for (int s = 0; s < 4; ++s) qf[s] = *(const bf16x8*)(qp + 16 * s); }
    f32x16 O0, O1;
#pragma unroll
    for (int i = 0; i < 16; ++i) { O0[i] = 0.f; O1[i] = 0.f; }
    float carry = 0.f;
    const int nkt = 4 * qb + 4;
    const int srow = tid >> 3, spc = tid & 7;
    const bf16_t* kg = K + (rowbase + srow) * 512 + h * 64 + spc * 8;
    const bf16_t* vg = V + (rowbase + srow) * 512 + h * 64 + spc * 8;
    LAS unsigned* flags = (LAS unsigned*)(lds + SB_FLAG);
    __syncthreads();
    u32x4 kreg = *(const u32x4*)(kg + (size_t)(nkt - 1) * 64 * 512), vreg = *(const u32x4*)(vg + (size_t)(nkt - 1) * 64 * 512);
    *(LAS u32x4*)(lds + srow * KSTR + spc * 16) = kreg; *(LAS u32x4*)(lds + SB_VOFF + srow * VSTR + spc * 16) = vreg;
    __syncthreads();
    int cur = 0;
    const int q4 = (lane & 15) >> 2, p4 = lane & 3, blk = (lane >> 4) & 1;
    const int vlane_off = (4 * hh + q4) * VSTR + 8 * (4 * blk + p4);
    for (int kt = nkt - 1; kt >= 0; --kt) {
        if (kt > 0) { kreg = *(const u32x4*)(kg + (size_t)(kt - 1) * 64 * 512); vreg = *(const u32x4*)(vg + (size_t)(kt - 1) * 64 * 512); }
        const LAS unsigned char* kb_ = lds + cur * KBUF; const LAS unsigned char* vb_ = lds + SB_VOFF + cur * VBUF;
        bool wdone = __all(carry >= 160.0f);
        if (!wdone) {
#pragma unroll
            for (int kb = 1; kb >= 0; --kb) {
                const int kb32 = 2 * kt + kb;
                if (kb32 <= qblk) {
                    const bool diag = (kb32 == qblk);
                    f32x16 z;
#pragma unroll
                    for (int i = 0; i < 16; ++i) z[i] = 0.f;
#pragma unroll
                    for (int s = 0; s < 4; ++s) { const bf16x8 a = *(const LAS bf16x8*)(kb_ + (32 * kb + r) * KSTR + 32 * s + 16 * hh); z = MFMA32(a, qf[s], z); }
                    float sp[16];
#pragma unroll
                    for (int i = 0; i < 16; ++i) {
                        const float e = __builtin_amdgcn_exp2f(z[i]);
                        float v = __builtin_amdgcn_logf(1.0f + e);
                        if (diag && !(crow(i, hh) < r)) v = 0.f;
                        sp[i] = v;
                    }
                    float G[4], Gp[4];
#pragma unroll
                    for (int g = 0; g < 4; ++g) { G[g] = (sp[4 * g] + sp[4 * g + 1]) + (sp[4 * g + 2] + sp[4 * g + 3]); Gp[g] = __shfl_xor(G[g], 32); }
                    float suf = carry; float w[16];
#pragma unroll
                    for (int g = 3; g >= 0; --g) {
                        float run = suf + (hh == 0 ? Gp[g] : 0.f);
#pragma unroll
                        for (int i = 4 * g + 3; i >= 4 * g; --i) {
                            run += sp[i];
                            float wv = __builtin_amdgcn_exp2f(z[i] - run);
                            if (diag && !(crow(i, hh) < r)) wv = 0.f;
                            w[i] = wv;
                        }
                        suf += G[g] + Gp[g];
                    }
                    carry = suf;
#pragma unroll
                    for (int s = 0; s < 2; ++s) {
                        const bf16x8 pf = pack8(w[8 * s], w[8 * s + 1], w[8 * s + 2], w[8 * s + 3], w[8 * s + 4], w[8 * s + 5], w[8 * s + 6], w[8 * s + 7]);
                        const LAS unsigned char* vp = vb_ + (32 * kb + 16 * s) * VSTR + vlane_off;
                        const bf16x8 a0 = tr8(vp, 8 * VSTR), a1 = tr8(vp + 64, 8 * VSTR);
                        O0 = MFMA32(a0, pf, O0); O1 = MFMA32(a1, pf, O1);
                    }
                }
            }
            wdone = __all(carry >= 160.0f);
        }
        if (kt > 0) { *(LAS u32x4*)(lds + (cur ^ 1) * KBUF + srow * KSTR + spc * 16) = kreg; *(LAS u32x4*)(lds + SB_VOFF + (cur ^ 1) * VBUF + srow * VSTR + spc * 16) = vreg; }
        if (lane == 0) flags[(kt & 1) * 8 + wid] = wdone ? 1u : 0u;
        __syncthreads();
        unsigned alld = 1u;
#pragma unroll
        for (int w8 = 0; w8 < 8; ++w8) alld &= flags[(kt & 1) * 8 + w8];
        if (alld) break;
        cur ^= 1;
    }
    bf16_t* yp = Y + (rowbase + qw0 + r) * 1024 + 512 + h * 64 + 4 * hh;
#pragma unroll
    for (int g = 0; g < 4; ++g) {
        u32x2 w0; w0.x = pk2(O0[4 * g], O0[4 * g + 1]); w0.y = pk2(O0[4 * g + 2], O0[4 * g + 3]); *(u32x2*)(yp + 8 * g) = w0;
        u32x2 w1; w1.x = pk2(O1[4 * g], O1[4 * g + 1]); w1.y = pk2(O1[4 * g + 2], O1[4 * g + 3]); *(u32x2*)(yp + 32 + 8 * g) = w1;
    }
}

constexpr int SW_VOFF = 192 * KSTR;
__device__ __forceinline__ void swa_unit(LAS unsigned char* lds, const bf16_t* Q, const bf16_t* K, const bf16_t* V, const float* sinks, bf16_t* Y, int b, int kvh, int qc, int tid, int wid, int lane) {
    const int r = lane & 31, hh = lane >> 5;
    const int head = 4 * kvh + (wid >> 1), qsub = wid & 1;
    const int qw0 = 64 * qc + 32 * qsub;
    const size_t rowbase = (size_t)b * SEQ;
    const int kbase = 64 * qc - 128;
    __syncthreads();
#pragma unroll
    for (int it = 0; it < 3; ++it) {
        const int idx = tid + it * 512, srow = idx >> 3, spc = idx & 7, kpos = kbase + srow;
        u32x4 kv = (u32x4){0u, 0u, 0u, 0u}, vv = (u32x4){0u, 0u, 0u, 0u};
        if (kpos >= 0) { kv = *(const u32x4*)(K + (rowbase + kpos) * 256 + kvh * 64 + spc * 8); vv = *(const u32x4*)(V + (rowbase + kpos) * 256 + kvh * 64 + spc * 8); }
        *(LAS u32x4*)(lds + srow * KSTR + spc * 16) = kv; *(LAS u32x4*)(lds + SW_VOFF + srow * VSTR + spc * 16) = vv;
    }
    bf16x8 qf[4];
    { const bf16_t* qp = Q + (rowbase + qw0 + r) * 1024 + head * 64 + 8 * hh;
#pragma unroll
      for (int s = 0; s < 4; ++s) qf[s] = *(const bf16x8*)(qp + 16 * s); }
    __syncthreads();
    f32x16 O0, O1;
#pragma unroll
    for (int i = 0; i < 16; ++i) { O0[i] = 0.f; O1[i] = 0.f; }
    float mrun = sinks[head] * LOG2E, lsum = (hh == 0) ? 1.0f : 0.0f;
    const int q4 = (lane & 15) >> 2, p4 = lane & 3, blk = (lane >> 4) & 1;
    const int vlane_off = (4 * hh + q4) * VSTR + 8 * (4 * blk + p4);
#pragma unroll
    for (int j = 0; j < 5; ++j) {
        const int rb = qsub + j;
        const int key0 = kbase + 32 * rb;
        if (key0 >= 0) {
            f32x16 z;
#pragma unroll
            for (int i = 0; i < 16; ++i) z[i] = 0.f;
#pragma unroll
            for (int s = 0; s < 4; ++s) { const bf16x8 a = *(const LAS bf16x8*)(lds + (32 * rb + r) * KSTR + 32 * s + 16 * hh); z = MFMA32(a, qf[s], z); }
            float bm = -3.0e38f;
#pragma unroll
            for (int i = 0; i < 16; ++i) {
                bool valid = true;
                if (j == 0) valid = (crow(i, hh) > r);
                if (j == 4) valid = (crow(i, hh) <= r);
                if (!valid) z[i] = -3.0e38f;
                bm = fmaxf(bm, z[i]);
            }
            bm = fmaxf(bm, __shfl_xor(bm, 32));
            const float mnew = fmaxf(mrun, bm);
            const float alpha = __builtin_amdgcn_exp2f(mrun - mnew);
            mrun = mnew;
            float w[16]; float ps = 0.f;
#pragma unroll
            for (int i = 0; i < 16; ++i) { w[i] = __builtin_amdgcn_exp2f(z[i] - mnew); ps += w[i]; }
            lsum = lsum * alpha + ps;
#pragma unroll
            for (int i = 0; i < 16; ++i) { O0[i] *= alpha; O1[i] *= alpha; }
#pragma unroll
            for (int s = 0; s < 2; ++s) {
                const bf16x8 pf = pack8(w[8 * s], w[8 * s + 1], w[8 * s + 2], w[8 * s + 3], w[8 * s + 4], w[8 * s + 5], w[8 * s + 6], w[8 * s + 7]);
                const LAS unsigned char* vp = lds + SW_VOFF + (32 * rb + 16 * s) * VSTR + vlane_off;
                const bf16x8 a0 = tr8(vp, 8 * VSTR), a1 = tr8(vp + 64, 8 * VSTR);
                O0 = MFMA32(a0, pf, O0); O1 = MFMA32(a1, pf, O1);
            }
        }
    }
    lsum += __shfl_xor(lsum, 32);
    const float inv = 1.0f / lsum;
    bf16_t* yp = Y + (rowbase + qw0 + r) * 1024 + head * 64 + 4 * hh;
#pragma unroll
    for (int g = 0; g < 4; ++g) {
        u32x2 w0; w0.x = pk2(O0[4 * g] * inv, O0[4 * g + 1] * inv); w0.y = pk2(O0[4 * g + 2] * inv, O0[4 * g + 3] * inv); *(u32x2*)(yp + 8 * g) = w0;
        u32x2 w1; w1.x = pk2(O1[4 * g] * inv, O1[4 * g + 1] * inv); w1.y = pk2(O1[4 * g + 2] * inv, O1[4 * g + 3] * inv); *(u32x2*)(yp + 32 + 8 * g) = w1;
    }
}

constexpr int XCS = 68;
struct LruArgs { const bf16_t* XR; const bf16_t* GR; bf16_t* Y; const float* convw; const float* convb; const float* wa; const float* ba; const float* wx; const float* bx; const float* lam; };
__device__ __forceinline__ void lru_item(LAS unsigned char* lds, const LruArgs& A, int item, int tid, int wid, int lane) {
    const int b = item >> 4, n = (item >> 1) & 7, half = item & 1;
    const int r = lane & 31, hh = lane >> 5;
    const int co = lane & 7, tsub = lane >> 3;
    const size_t rowbase = (size_t)b * SEQ;
    LAS float* xcw = (LAS float*)(lds + wid * (32 * XCS * 4));
    LAS float* exch = (LAS float*)(lds + 8 * (32 * XCS * 4));
    float cw[4][8], cbv[8];
#pragma unroll
    for (int k = 0; k < 4; ++k)
#pragma unroll
        for (int j = 0; j < 8; ++j) cw[k][j] = A.convw[k * 512 + 64 * n + 8 * co + j];
#pragma unroll
    for (int j = 0; j < 8; ++j) cbv[j] = A.convb[64 * n + 8 * co + j];
    bf16x8 waf[4], wxf[4];
#pragma unroll
    for (int s = 0; s < 4; ++s) {
        float ta[8], tx[8];
#pragma unroll
        for (int j = 0; j < 8; ++j) { const int idx = (n * 64 + 16 * s + 8 * hh + j) * 64 + 32 * half + r; ta[j] = A.wa[idx]; tx[j] = A.wx[idx]; }
        waf[s] = pack8(ta[0], ta[1], ta[2], ta[3], ta[4], ta[5], ta[6], ta[7]);
        wxf[s] = pack8(tx[0], tx[1], tx[2], tx[3], tx[4], tx[5], tx[6], tx[7]);
    }
    const int c = 64 * n + 32 * half + r;
    const float ba_c = A.ba[c], bx_c = A.bx[c];
    const float lam_c = A.lam[c];
    const float spl2 = 8.0f * (fmaxf(-lam_c, 0.f) + log1pf(expf(-fabsf(lam_c)))) * LOG2E;
    __syncthreads();
    float hin = 0.f;
    for (int pass = 0; pass < 2; ++pass) {
        float hstate = hin, Aw = 1.0f;
        for (int blk = 0; blk < 8; ++blk) {
            const int tb = 256 * wid + 32 * blk;
#pragma unroll
            for (int p = 0; p < 4; ++p) {
                const int tl = 8 * p + tsub, t = tb + tl;
                float av[8];
#pragma unroll
                for (int j = 0; j < 8; ++j) av[j] = cbv[j];
#pragma unroll
                for (int k = 0; k < 4; ++k) {
                    const int tt = t - 3 + k;
                    if (tt >= 0) {
                        const u32x4 raw = *(const u32x4*)(A.XR + (rowbase + tt) * 512 + 64 * n + 8 * co);
                        av[0] += cw[k][0] * bflo(raw.x); av[1] += cw[k][1] * bfhi(raw.x); av[2] += cw[k][2] * bflo(raw.y); av[3] += cw[k][3] * bfhi(raw.y);
                        av[4] += cw[k][4] * bflo(raw.z); av[5] += cw[k][5] * bfhi(raw.z); av[6] += cw[k][6] * bflo(raw.w); av[7] += cw[k][7] * bfhi(raw.w);
                    }
                }
                *(LAS f32x4*)(xcw + tl * XCS + 8 * co) = (f32x4){av[0], av[1], av[2], av[3]};
                *(LAS f32x4*)(xcw + tl * XCS + 8 * co + 4) = (f32x4){av[4], av[5], av[6], av[7]};
            }
            LDS_WAIT();
            f32x16 R, I;
#pragma unroll
            for (int i = 0; i < 16; ++i) { R[i] = 0.f; I[i] = 0.f; }
#pragma unroll
            for (int s = 0; s < 4; ++s) {
                const f32x4 a0 = *(const LAS f32x4*)(xcw + r * XCS + 16 * s + 8 * hh), a1 = *(const LAS f32x4*)(xcw + r * XCS + 16 * s + 8 * hh + 4);
                const bf16x8 af = pack8(a0[0], a0[1], a0[2], a0[3], a1[0], a1[1], a1[2], a1[3]);
                R = MFMA32(af, waf[s], R); I = MFMA32(af, wxf[s], I);
            }
            float av_[16], uv_[16];
#pragma unroll
            for (int i = 0; i < 16; ++i) {
                const float xcf = xcw[crow(i, hh) * XCS + 32 * half + r];
                const float rr = __builtin_amdgcn_rcpf(1.0f + __builtin_amdgcn_exp2f(-(R[i] + ba_c) * LOG2E));
                const float ii = __builtin_amdgcn_rcpf(1.0f + __builtin_amdgcn_exp2f(-(I[i] + bx_c) * LOG2E));
                const float la2 = -rr * spl2;
                const float a = __builtin_amdgcn_exp2f(la2);
                const float y = la2 * (2.0f / LOG2E);
                const float om = (y > -0.25f) ? -y * (1.0f + y * (0.5f + y * ((1.0f / 6.0f) + y * ((1.0f / 24.0f) + y * (1.0f / 120.0f))))) : 1.0f - a * a;
                av_[i] = a; uv_[i] = sqrtf(om) * ii * xcf;
            }
            asm volatile("" ::: "memory");
            float Ag[4], Bg[4], pA[4], pB[4];
#pragma unroll
            for (int g = 0; g < 4; ++g) {
                Ag[g] = (av_[4 * g] * av_[4 * g + 1]) * (av_[4 * g + 2] * av_[4 * g + 3]);
                Bg[g] = ((uv_[4 * g] * av_[4 * g + 1] + uv_[4 * g + 1]) * av_[4 * g + 2] + uv_[4 * g + 2]) * av_[4 * g + 3] + uv_[4 * g + 3];
                pA[g] = __shfl_xor(Ag[g], 32); pB[g] = __shfl_xor(Bg[g], 32);
            }
            float hcur = hstate, start[4];
#pragma unroll
            for (int g = 0; g < 4; ++g) {
                const float A0 = hh == 0 ? Ag[g] : pA[g], B0 = hh == 0 ? Bg[g] : pB[g];
                const float A1 = hh == 0 ? pA[g] : Ag[g], B1 = hh == 0 ? pB[g] : Bg[g];
                const float s0 = hcur; hcur = A0 * hcur + B0;
                const float s1 = hcur; hcur = A1 * hcur + B1;
                start[g] = hh == 0 ? s0 : s1; Aw *= A0 * A1;
            }
            if (pass == 1) {
#pragma unroll
                for (int g = 0; g < 4; ++g) {
                    float hv = start[g];
#pragma unroll
                    for (int i = 4 * g; i < 4 * g + 4; ++i) {
                        hv = av_[i] * hv + uv_[i];
                        const size_t row = rowbase + tb + crow(i, hh);
                        const float gv = bflo((unsigned)A.GR[row * 512 + c]);
                        const float yy = 0.7978845608028654f * (gv + 0.044715f * gv * gv * gv);
                        const float ge = gv * __builtin_amdgcn_rcpf(1.0f + __builtin_amdgcn_exp2f(-2.0f * LOG2E * yy));
                        A.Y[row * 1024 + c] = (bf16_t)(pk2(hv * ge, 0.f) & 0xffffu);
                    }
                }
            }
            hstate = hcur;
        }
        if (pass == 0) {
            if (hh == 0) { exch[(wid * 32 + r) * 2] = Aw; exch[(wid * 32 + r) * 2 + 1] = hstate; }
            __syncthreads();
            hin = 0.f;
            for (int w8 = 0; w8 < wid; ++w8) hin = exch[(w8 * 32 + r) * 2] * hin + exch[(w8 * 32 + r) * 2 + 1];
        }
    }
}

__device__ __forceinline__ float wave_sum(float v) {
#pragma unroll
    for (int o = 1; o < 64; o <<= 1) v += __shfl_xor(v, o);
    return v;
}
__device__ __forceinline__ int headperm(int n) { return (n & ~255) | (((n >> 5) & 1) << 7) | (((n >> 6) & 3) << 5) | (n & 31); }
__device__ __forceinline__ void transpose_item(const float* W, int N, bf16_t* WT, int K, int dst_row0, int k0, int n0, LAS float* scr, int lane) {
#pragma unroll 8
    for (int i = 0; i < 32; ++i) { const int kk = 2 * i + (lane >> 5); scr[kk * 33 + (lane & 31)] = W[(size_t)(k0 + kk) * N + n0 + (lane & 31)]; }
    LDS_WAIT();
    const int c8 = lane & 7;
#pragma unroll
    for (int j = 0; j < 4; ++j) { const int n = (lane >> 3) + 8 * j; const LAS float* s = scr + (8 * c8) * 33 + n;
        u32x4 o; o.x = pk2(s[0 * 33], s[1 * 33]); o.y = pk2(s[2 * 33], s[3 * 33]); o.z = pk2(s[4 * 33], s[5 * 33]); o.w = pk2(s[6 * 33], s[7 * 33]);
        *(u32x4*)(WT + (size_t)(dst_row0 + n) * K + k0 + 8 * c8) = o; }
    LDS_WAIT();
}

struct Args { const float* in[27]; float* out; unsigned char* ws; };

__global__ void __launch_bounds__(512, 2) fwd_mega(Args args) {
    extern __shared__ __attribute__((aligned(16))) unsigned char lds_raw[];
    LAS unsigned char* lds = (LAS unsigned char*)lds_raw;
    cg::grid_group grid = cg::this_grid();
    const int G = gridDim.x, bid = blockIdx.x, NGW = G * 8;
    const int wid_s = __builtin_amdgcn_readfirstlane((int)threadIdx.x >> 6);
#define PHASE_IDS int lane_; asm volatile("v_mbcnt_lo_u32_b32 %0, -1, 0\n\tv_mbcnt_hi_u32_b32 %0, -1, %0" : "=v"(lane_)); const int lane = lane_ & 63; const int wid = wid_s; const int tid = wid * 64 + lane; const int gw = bid * 8 + wid; (void)gw;
    unsigned char* ws = args.ws;
    const float* x = args.in[0]; const float* cc = args.in[1]; const float* ada_w = args.in[2]; const float* ada_b = args.in[3];
    const float* norm_mix_g = args.in[4]; const float* norm_ffn_g = args.in[5];
    float* MOD = (float*)(ws + WS_MOD); float* SHW = (float*)(ws + WS_SHW);
    float* SSQ0 = (float*)(ws + WS_SSQ0); float* SSQ1 = (float*)(ws + WS_SSQ1); float* SSQ2 = (float*)(ws + WS_SSQ2); float* SSQ3 = (float*)(ws + WS_SSQ3);
    bf16_t* XG = (bf16_t*)(ws + WS_XG); bf16_t* PB = (bf16_t*)(ws + WS_P); bf16_t* YB = (bf16_t*)(ws + WS_Y); bf16_t* ACT = (bf16_t*)(ws + WS_ACT);
    float* HALO = (float*)(ws + WS_HALO); float* FIXP = (float*)(ws + WS_FIXP); float* FIXU = (float*)(ws + WS_FIXU);
    bf16_t* W_IN0 = (bf16_t*)(ws + WS_W_IN0); bf16_t* W_OUT0 = (bf16_t*)(ws + WS_W_OUT0); bf16_t* W_GU0 = (bf16_t*)(ws + WS_W_GU0); bf16_t* W_DN0 = (bf16_t*)(ws + WS_W_DN0);
    bf16_t* W_IN1 = (bf16_t*)(ws + WS_W_IN1); bf16_t* W_OUT1 = (bf16_t*)(ws + WS_W_OUT1); bf16_t* W_GU1 = (bf16_t*)(ws + WS_W_GU1); bf16_t* W_DN1 = (bf16_t*)(ws + WS_W_DN1);

    if (bid < 192) {
        PHASE_IDS
        const int l = bid / 96, chunk = bid % 96;
        LAS float* sl = (LAS float*)lds;
        LAS float* part = (LAS float*)(lds + 65536);
        for (int idx = tid; idx < 16384; idx += 512) { const float v = cc[idx]; sl[idx] = v / (1.0f + __expf(-v)); }
        __syncthreads();
        float acc[16];
#pragma unroll
        for (int bb = 0; bb < 16; ++bb) acc[bb] = 0.f;
        const float* Wp = ada_w + (size_t)l * 1024 * 6144 + chunk * 64 + lane;
        for (int k = 128 * wid; k < 128 * wid + 128; k += 4) {
            const float w0 = Wp[(size_t)k * 6144], w1 = Wp[(size_t)(k + 1) * 6144], w2 = Wp[(size_t)(k + 2) * 6144], w3 = Wp[(size_t)(k + 3) * 6144];
#pragma unroll
            for (int bb = 0; bb < 16; ++bb) { const f32x4 s = *(const LAS f32x4*)(sl + bb * 1024 + k); acc[bb] += (s[0] * w0 + s[1] * w1) + (s[2] * w2 + s[3] * w3); }
        }
#pragma unroll
        for (int bb = 0; bb < 16; ++bb) part[(wid * 16 + bb) * 64 + lane] = acc[bb];
        __syncthreads();
        for (int o = tid; o < 1024; o += 512) {
            const int bb = o >> 6, cl = o & 63; float s = ada_b[l * 6144 + chunk * 64 + cl];
#pragma unroll
            for (int w8 = 0; w8 < 8; ++w8) s += part[(w8 * 16 + bb) * 64 + cl];
            MOD[((size_t)l * 16 + bb) * 6144 + chunk * 64 + cl] = s;
        }
        __syncthreads();
    }
    {
        PHASE_IDS
        LAS float* scr = (LAS float*)(lds + wid * 16384);
        constexpr int NITEMS = 1280 + 512 + 3 * 1408 + 768 + 512 + 3 * 1408;
        for (int it = gw; it < NITEMS; it += NGW) {
            int rI = it; const float* W; int N, K; bf16_t* WT; int mapk;
            if (rI < 1280) { W = args.in[6]; N = 2560; K = 1024; WT = W_IN0; mapk = 1; }
            else if ((rI -= 1280) < 512) { W = args.in[16]; N = 1024; K = 1024; WT = W_OUT0; mapk = 0; }
            else if ((rI -= 512) < 1408) { W = args.in[22]; N = FF; K = 1024; WT = W_GU0; mapk = 3; }
            else if ((rI -= 1408) < 1408) { W = args.in[23]; N = FF; K = 1024; WT = W_GU0; mapk = 4; }
            else if ((rI -= 1408) < 1408) { W = args.in[26]; N = 1024; K = FF; WT = W_DN0; mapk = 0; }
            else if ((rI -= 1408) < 768) { W = args.in[17]; N = 1536; K = 1024; WT = W_IN1; mapk = 2; }
            else if ((rI -= 768) < 512) { W = args.in[21]; N = 1024; K = 1024; WT = W_OUT1; mapk = 0; }
            else if ((rI -= 512) < 1408) { W = args.in[22] + (size_t)1024 * FF; N = FF; K = 1024; WT = W_GU1; mapk = 3; }
            else if ((rI -= 1408) < 1408) { W = args.in[23] + (size_t)1024 * FF; N = FF; K = 1024; WT = W_GU1; mapk = 4; }
            else { rI -= 1408; W = args.in[26] + (size_t)FF * 1024; N = 1024; K = FF; WT = W_DN1; mapk = 0; }
            const int nblk = N / 32, kb = rI / nblk, nb = rI % nblk, k0 = 64 * kb, n0 = 32 * nb;
            int d0 = n0;
            if (mapk == 1) { const int region = n0 >> 9; if (region == 2 || region == 3) d0 = headperm(n0); }
            else if (mapk == 2) { if (n0 < 1280) d0 = headperm(n0); }
            else if (mapk == 3) d0 = 256 * (n0 >> 7) + (n0 & 127);
            else if (mapk == 4) d0 = 256 * (n0 >> 7) + 128 + (n0 & 127);
            transpose_item(W, N, WT, K, d0, k0, n0, scr, lane);
        }
    }
    grid.sync();

    {
    PHASE_IDS
    for (int m = gw; m < M; m += NGW) {
        const int bb = m >> 11;
        const f32x4* xr = (const f32x4*)(x + (size_t)m * 1024) + lane;
        const f32x4* gp = (const f32x4*)norm_mix_g + lane;
        const f32x4* sp = (const f32x4*)(MOD + (size_t)bb * 6144 + 1024) + lane;
        u32x2* op = (u32x2*)(XG + (size_t)m * 1024) + lane;
        float s = 0.f;
#pragma unroll
        for (int j = 0; j < 4; ++j) {
            const f32x4 v = xr[64 * j]; const f32x4 gm = gp[64 * j] * (sp[64 * j] + 1.0f);
            s += (v[0] * v[0] + v[1] * v[1]) + (v[2] * v[2] + v[3] * v[3]);
            const f32x4 o = v * gm; u32x2 w; w.x = pk2(o[0], o[1]); w.y = pk2(o[2], o[3]); op[64 * j] = w;
        }
        s = wave_sum(s);
        if (lane == 0) SSQ0[m] = s;
    }
    for (int gi = 0; gi < 4; ++gi) {
        const bf16_t* Wt; int N; const float* shp; float* outp;
        if (gi == 0) { Wt = W_IN0; N = 2560; shp = MOD; outp = SHW + SHW_IN0; }
        else if (gi == 1) { Wt = W_GU0; N = 5632; shp = MOD + 3 * 1024; outp = SHW + SHW_GU0; }
        else if (gi == 2) { Wt = W_IN1; N = 1536; shp = MOD + (size_t)16 * 6144; outp = SHW + SHW_IN1; }
        else { Wt = W_GU1; N = 5632; shp = MOD + (size_t)16 * 6144 + 3 * 1024; outp = SHW + SHW_GU1; }
        LAS float* shl = (LAS float*)lds;
        __syncthreads();
        for (int idx = tid; idx < 16384; idx += 512) shl[idx] = shp[(size_t)(idx >> 10) * 6144 + (idx & 1023)];
        __syncthreads();
        for (int p = gw; p < N; p += NGW) {
            asm volatile("" ::: "memory");
            const u32x4 r0 = *(const u32x4*)(Wt + (size_t)p * 1024 + 8 * lane), r1 = *(const u32x4*)(Wt + (size_t)p * 1024 + 512 + 8 * lane);
            float wv[16];
            wv[0] = bflo(r0.x); wv[1] = bfhi(r0.x); wv[2] = bflo(r0.y); wv[3] = bfhi(r0.y); wv[4] = bflo(r0.z); wv[5] = bfhi(r0.z); wv[6] = bflo(r0.w); wv[7] = bfhi(r0.w);
            wv[8] = bflo(r1.x); wv[9] = bfhi(r1.x); wv[10] = bflo(r1.y); wv[11] = bfhi(r1.y); wv[12] = bflo(r1.z); wv[13] = bfhi(r1.z); wv[14] = bflo(r1.w); wv[15] = bfhi(r1.w);
            float keep = 0.f;
#pragma unroll
            for (int bb = 0; bb < 16; ++bb) {
                const LAS float* sb_ = shl + bb * 1024 + 8 * lane;
                const f32x4 s0 = *(const LAS f32x4*)(sb_), s1 = *(const LAS f32x4*)(sb_ + 4), s2 = *(const LAS f32x4*)(sb_ + 512), s3 = *(const LAS f32x4*)(sb_ + 516);
                float d = (wv[0] * s0[0] + wv[1] * s0[1]) + (wv[2] * s0[2] + wv[3] * s0[3]) + (wv[4] * s1[0] + wv[5] * s1[1]) + (wv[6] * s1[2] + wv[7] * s1[3])
                        + (wv[8] * s2[0] + wv[9] * s2[1]) + (wv[10] * s2[2] + wv[11] * s2[3]) + (wv[12] * s3[0] + wv[13] * s3[1]) + (wv[14] * s3[2] + wv[15] * s3[3]);
                d = wave_sum(d);
                if (lane == bb) keep = d;
            }
            if (lane < 16) outp[(size_t)lane * N + p] = keep;
        }
    }
    }
    grid.sync();

    pg8::StaticOrder S;
    {
        PHASE_IDS
        pg8::Gemm g{XG, W_IN0, M, 2560, 1024}; S.init(M, 2560, G, bid);
        EpiIn<0> E{SSQ0, SHW + SHW_IN0, 2560, PB, args.in[14], args.in[15]};
        pg8::gemm_phase<EpiIn<0>>(lds, g, S, E, tid);
    }
    grid.sync();

    {
        const bf16_t* XR = PB; const bf16_t* GR = PB + (size_t)M * 512; const bf16_t* Qb = PB + (size_t)2 * M * 512; const bf16_t* Kb = PB + (size_t)3 * M * 512; const bf16_t* Vb = PB + (size_t)4 * M * 512;
        PHASE_IDS
        LruArgs LA{XR, GR, YB, args.in[7], args.in[8], args.in[9], args.in[10], args.in[11], args.in[12], args.in[13]};
        for (int item = bid; item < 256; item += G) lru_item(lds, LA, item, tid, wid, lane);
        for (int u = bid; u < 1024; u += G) {
            const int rr = u >> 8, i = u & 255, hi = i >> 7, bh = i & 127;
            int qb;
            if (rr == 0) qb = hi ? 6 : 7; else if (rr == 1) qb = hi ? 5 : 4; else if (rr == 2) qb = hi ? 2 : 3; else qb = hi ? 1 : 0;
            sb_unit(lds, Qb, Kb, Vb, YB, bh >> 3, bh & 7, qb, tid, wid, lane);
        }
    }
    grid.sync();

    {
        PHASE_IDS
        pg8::Gemm g{YB, W_OUT0, M, 1024, 1024}; S.init(M, 1024, G, bid);
        EpiRes<false> E{x, args.out, MOD + 2 * 1024, norm_ffn_g, MOD + 4 * 1024, XG, SSQ1};
        pg8::gemm_phase<EpiRes<false>>(lds, g, S, E, tid);
    }
    grid.sync();

    for (int layer = 0; layer < 2; ++layer) {
        if (layer == 1) {
            {
                PHASE_IDS
                pg8::Gemm g{XG, W_IN1, M, 1536, 1024}; S.init(M, 1536, G, bid);
                EpiIn<1> E{SSQ2, SHW + SHW_IN1, 1536, PB, args.in[18], args.in[19]};
                pg8::gemm_phase<EpiIn<1>>(lds, g, S, E, tid);
            }
            grid.sync();
            {
                const bf16_t* Qb = PB; const bf16_t* Kb = PB + (size_t)M * 1024; const bf16_t* Vb = Kb + (size_t)M * 256;
                PHASE_IDS
                for (int u = bid; u < 2048; u += G) { const int qc = u & 31, kvh = (u >> 5) & 3, bb = u >> 7; swa_unit(lds, Qb, Kb, Vb, args.in[20], YB, bb, kvh, qc, tid, wid, lane); }
            }
            grid.sync();
            {
                PHASE_IDS
                pg8::Gemm g{YB, W_OUT1, M, 1024, 1024}; S.init(M, 1024, G, bid);
                EpiRes<false> E{args.out, args.out, MOD + (size_t)16 * 6144 + 2 * 1024, norm_ffn_g + 1024, MOD + (size_t)16 * 6144 + 4 * 1024, XG, SSQ3};
                pg8::gemm_phase<EpiRes<false>>(lds, g, S, E, tid);
            }
            grid.sync();
        }
        {
            PHASE_IDS
            pg8::Gemm g{XG, layer ? W_GU1 : W_GU0, M, 5632, 1024}; S.init(M, 5632, G, bid);
            EpiGU E{layer ? SSQ3 : SSQ1, SHW + (layer ? SHW_GU1 : SHW_GU0), args.in[24] + (size_t)layer * 3 * FF, args.in[25] + (size_t)layer * FF, ACT, HALO, FIXP, FIXU};
            pg8::gemm_phase<EpiGU>(lds, g, S, E, tid);
        }
        grid.sync();
        {
            PHASE_IDS
            const float* cw = args.in[24] + (size_t)layer * 3 * FF;
            for (int idx = bid * 512 + tid; idx < 512 * 2 * 704; idx += G * 512) {
                const int c4 = idx % 704, sr = idx / 704, s = sr & 1, gs = sr >> 1;
                const size_t fo = ((size_t)gs * 2 + s) * FF + 4 * c4;
                f32x4 a = *(const f32x4*)(FIXP + fo); const f32x4 up = *(const f32x4*)(FIXU + fo);
                if ((gs & 31) != 0) {
                    const f32x4 h1 = *(const f32x4*)(HALO + ((size_t)(gs - 1) * 2 + 1) * FF + 4 * c4);
                    const f32x4 w0 = *(const f32x4*)(cw + 4 * c4);
                    if (s == 0) { const f32x4 h2 = *(const f32x4*)(HALO + ((size_t)(gs - 1) * 2) * FF + 4 * c4); const f32x4 w1 = *(const f32x4*)(cw + FF + 4 * c4); a = a + w1 * h1 + w0 * h2; }
                    else a = a + w0 * h1;
                }
                const f32x4 o = silu4(a) * up; u32x2 w; w.x = pk2(o[0], o[1]); w.y = pk2(o[2], o[3]);
                *(u32x2*)(ACT + (size_t)(gs * 64 + s) * FF + 4 * c4) = w;
            }
        }
        grid.sync();
        if (layer == 0) {
            PHASE_IDS
            pg8::Gemm g{ACT, W_DN0, M, 1024, FF}; S.init(M, 1024, G, bid);
            EpiRes<false> E{args.out, args.out, MOD + 5 * 1024, norm_mix_g + 1024, MOD + (size_t)16 * 6144 + 1 * 1024, XG, SSQ2};
            pg8::gemm_phase<EpiRes<false>>(lds, g, S, E, tid);
            grid.sync();
        } else {
            PHASE_IDS
            pg8::Gemm g{ACT, W_DN1, M, 1024, FF}; S.init(M, 1024, G, bid);
            EpiRes<true> E{args.out, args.out, MOD + (size_t)16 * 6144 + 5 * 1024, nullptr, nullptr, nullptr, nullptr};
            pg8::gemm_phase<EpiRes<true>>(lds, g, S, E, tid);
        }
    }
}

extern "C" void kernel_launch(void* const* d_in, const int* in_sizes, int n_in, void* d_out, int out_size, void* d_ws, size_t ws_size, hipStream_t stream) {
    static int grid = 0;
    if (grid == 0) {
        if (n_in != 27 || out_size != M * DM || ws_size < WS_END) { fprintf(stderr, "kernel_launch: unexpected shapes (n_in %d out %d ws %zu)\n", n_in, out_size, ws_size); grid = -1; return; }
        int dev = 0, cus = 0, per_cu = 0;
        (void)hipGetDevice(&dev);
        (void)hipDeviceGetAttribute(&cus, hipDeviceAttributeMultiprocessorCount, dev);
        (void)hipFuncSetAttribute((const void*)fwd_mega, hipFuncAttributeMaxDynamicSharedMemorySize, LDS_BYTES);
        (void)hipOccupancyMaxActiveBlocksPerMultiprocessor(&per_cu, (const void*)fwd_mega, 512, LDS_BYTES);
        (void)hipGetLastError();
        grid = cus;
        if (per_cu < 1) fprintf(stderr, "kernel_launch: occupancy query says %d blocks/CU\n", per_cu);
    }
    if (grid < 0) return;
    (void)hipMemsetAsync(d_ws, 0, WS_ZERO_BYTES, stream);
    Args a{};
    for (int i = 0; i < 27; ++i) a.in[i] = (const float*)d_in[i];
    a.out = (float*)d_out; a.ws = (unsigned char*)d_ws;
    void* kargs[] = {&a};
    hipError_t e = hipLaunchCooperativeKernel((const void*)fwd_mega, dim3(grid), dim3(512), kargs, LDS_BYTES, stream);
    if (e != hipSuccess) fprintf(stderr, "cooperative launch failed: %s (grid %d)\n", hipGetErrorString(e), grid);
}
```

```cpp
#include <hip/hip_runtime.h>
#include <hip/hip_cooperative_groups.h>
#include <cstdio>
#include <cstdint>
namespace cg = cooperative_groups;

#define LAS __attribute__((address_space(3)))
typedef unsigned short bf16_t;
typedef short bf16x8 __attribute__((ext_vector_type(8)));
typedef short s16x4 __attribute__((ext_vector_type(4)));
typedef float f32x4 __attribute__((ext_vector_type(4)));
typedef float f32x2 __attribute__((ext_vector_type(2)));
typedef float f32x16 __attribute__((ext_vector_type(16)));
typedef unsigned u32x4 __attribute__((ext_vector_type(4)));
typedef unsigned u32x2 __attribute__((ext_vector_type(2)));
typedef __bf16 bf2_t __attribute__((ext_vector_type(2)));

__device__ __forceinline__ unsigned pk2(float lo, float hi) { f32x2 v = {lo, hi}; bf2_t r = __builtin_convertvector(v, bf2_t); return __builtin_bit_cast(unsigned, r); }
__device__ __forceinline__ float bflo(unsigned u) { return __uint_as_float(u << 16); }
__device__ __forceinline__ float bfhi(unsigned u) { return __uint_as_float(u & 0xffff0000u); }
#define LDS_WAIT() asm volatile("s_waitcnt lgkmcnt(0)" ::: "memory")

constexpr int NB = 16, SEQ = 2048, DM = 1024, M = NB * SEQ, FF = 2816;
constexpr float EPS = 1e-6f;
constexpr float LOG2E = 1.4426950408889634f;
constexpr float QSCALE = 0.125f * LOG2E;

constexpr size_t MiB = 1u << 20;
constexpr size_t WS_SSQ1 = 0, WS_SSQ2 = 128 * 1024, WS_SSQ3 = 256 * 1024, WS_ZERO_BYTES = 512 * 1024;
constexpr size_t WS_BAR = 384 * 1024;
constexpr size_t WS_SSQ0 = 512 * 1024;
constexpr size_t WS_MOD = 1 * MiB;
constexpr size_t WS_SHW = 2 * MiB;
constexpr size_t SHW_IN0 = 0, SHW_GU0 = 16 * 2560, SHW_IN1 = SHW_GU0 + 16 * 5632, SHW_GU1 = SHW_IN1 + 16 * 1536;
constexpr size_t WS_HALO = 3 * MiB, WS_FIXP = 15 * MiB, WS_FIXU = 27 * MiB;
constexpr size_t WS_W_IN0 = 40 * MiB, WS_W_OUT0 = 45 * MiB, WS_W_GU0 = 47 * MiB, WS_W_DN0 = 58 * MiB;
constexpr size_t WS_W_IN1 = 64 * MiB, WS_W_OUT1 = 67 * MiB, WS_W_GU1 = 69 * MiB, WS_W_DN1 = 80 * MiB;
constexpr size_t WS_XG = 96 * MiB;
constexpr size_t WS_P = 160 * MiB;
constexpr size_t WS_Y = 320 * MiB;
constexpr size_t WS_ACT = 160 * MiB;
constexpr size_t WS_END = 384 * MiB;

constexpr int LDS_BYTES = 147456;
#ifndef DUP_MASK
#define DUP_MASK 0
#endif

namespace pg8 {
constexpr int BM = 256, BK = 64, HALF = 128, HTB = HALF * BK * 2, STAGE_BYTES = 8 * HTB, NXCD = 8, WGM = 8;
__host__ __device__ __forceinline__ int lds_byte(int r, int c) { const int st = (r >> 4) * 2 + (c >> 5), rr = r & 15, cc = c & 31, ob = rr * 64 + cc * 2; return st * 1024 + (ob ^ (((ob >> 9) & 1) << 5)); }
__host__ __device__ __forceinline__ void stage_rc(int b, int& R, int& C) { const int st = b / 1024, sb = b % 1024, swz = sb ^ (((sb >> 9) & 1) << 5); R = (st >> 1) * 16 + swz / 64; C = (st & 1) * 32 + (swz % 64) / 2; }
struct Unit { int pm, pn; };
struct Gemm { const bf16_t* A; const bf16_t* Bt; int M, N, K; };
struct StaticOrder {
    int nM, nN, nwg, G, c;
    __host__ __device__ void init(int M_, int N_, int G_, int c_) { nM = M_ / BM; nN = N_ / BM; nwg = nM * nN; G = G_; c = c_; }
    __host__ __device__ bool next(int i, Unit& u) const {
        const long L = (long)i * G + c; if (L >= nwg) return false;
        int wgid = (int)L; { const int q = nwg / NXCD, r = nwg % NXCD, xcd = wgid % NXCD, off = wgid / NXCD; wgid = (xcd < r ? xcd * (q + 1) : r * (q + 1) + (xcd - r) * q) + off; }
        const int nig = WGM * nN, gid = wgid / nig, fm = gid * WGM, gsz = (nM - fm) < WGM ? (nM - fm) : WGM;
        u.pm = fm + ((wgid % nig) % gsz); u.pn = (wgid % nig) / gsz; return true;
    }
};

template <class Epi, bool ALIGN_EPI = true, bool SP2 = true>
__device__ __forceinline__ void gemm_phase(LAS unsigned char* lds, const Gemm g, const StaticOrder& S, const Epi& E, const int tid) {
    const int wid = __builtin_amdgcn_readfirstlane(tid >> 6), lane = tid & 63, wr = wid >> 2, wc = wid & 3, fr = lane & 15, fq = lane >> 4;
    const int K = g.K, nt = K / BK;
    unsigned voffA[2];
#pragma unroll
    for (int i = 0; i < 2; ++i) { int R, C; stage_rc(tid * 16 + i * 8192, R, C); voffA[i] = (unsigned)(R * K + C) * 2u; }
    const size_t kstep = (size_t)(BK * 2);
    const size_t hstep = (size_t)HALF * K * 2;
    const size_t tstep = 2 * hstep;
    const unsigned ldsw = (unsigned)wid * 1024u;
    const int aoff = lds_byte(wr * 64 + fr, fq * 8), boff = lds_byte(wc * 32 + fr, fq * 8);
#define PG8_SA(b, h) (((b) * 2 + (h)) * HTB)
#define PG8_SB(b, h) ((4 + (b) * 2 + (h)) * HTB)
#define PG8_STAGE(bufoff, gbase, voff) do { _Pragma("unroll") for (int _i = 0; _i < 2; ++_i) \
        __builtin_amdgcn_global_load_lds((const unsigned*)((const char*)(gbase) + (voff)[_i]), (LAS unsigned*)(lds + (bufoff) + ldsw + _i * 8192), 16, 0, 0); } while (0)
#define PG8_LDA(dst, b, h) do { _Pragma("unroll") for (int m = 0; m < 4; ++m) _Pragma("unroll") for (int k = 0; k < 2; ++k) dst[m][k] = *(const LAS bf16x8*)(lds + PG8_SA(b, h) + aoff + m * 2048 + k * 1024); } while (0)
#define PG8_LDB(dst, b, h) do { _Pragma("unroll") for (int n = 0; n < 2; ++n) _Pragma("unroll") for (int k = 0; k < 2; ++k) dst[n][k] = *(const LAS bf16x8*)(lds + PG8_SB(b, h) + boff + n * 2048 + k * 1024); } while (0)
#define PG8_MMA(ai, bj, At, Bt) do { __builtin_amdgcn_s_setprio(1); _Pragma("unroll") for (int m = 0; m < 4; ++m) _Pragma("unroll") for (int n = 0; n < 2; ++n) _Pragma("unroll") for (int k = 0; k < 2; ++k) \
        acc[ai][bj][m][n] = __builtin_amdgcn_mfma_f32_16x16x32_bf16(Bt[n][k], At[m][k], acc[ai][bj][m][n], 0, 0, 0); __builtin_amdgcn_s_setprio(0); } while (0)
#define PG8_WAIT_V(n) asm volatile("s_waitcnt vmcnt(" #n ")" ::: "memory")
#define PG8_WAIT_L(n) asm volatile("s_waitcnt lgkmcnt(" #n ")" ::: "memory")
#define PG8_BAR __builtin_amdgcn_s_barrier()
#define PG8_SCHED __builtin_amdgcn_sched_barrier(0)
    Unit cur, nxt; int ui = 0;
    if (!S.next(0, cur)) return;
    f32x4 acc[2][2][4][2];
#pragma unroll
    for (int a = 0; a < 2; ++a)
#pragma unroll
        for (int b = 0; b < 2; ++b)
#pragma unroll
            for (int m = 0; m < 4; ++m)
#pragma unroll
                for (int n = 0; n < 2; ++n) acc[a][b][m][n] = (f32x4){0.f, 0.f, 0.f, 0.f};
    bf16x8 At[4][2], B0[2][2], B1[2][2];
    const char* cA = (const char*)g.A + (size_t)cur.pm * tstep; const char* cB = (const char*)g.Bt + (size_t)cur.pn * tstep;
    {
        PG8_STAGE(PG8_SB(0, 0), cB, voffA); PG8_STAGE(PG8_SB(0, 1), cB + hstep, voffA); PG8_STAGE(PG8_SA(0, 0), cA, voffA); PG8_STAGE(PG8_SA(0, 1), cA + hstep, voffA);
        if (wr == 1) PG8_BAR;
        PG8_WAIT_V(2); PG8_BAR;
        PG8_STAGE(PG8_SB(1, 0), cB + kstep, voffA); PG8_STAGE(PG8_SA(1, 0), cA + kstep, voffA); PG8_STAGE(PG8_SB(1, 1), cB + hstep + kstep, voffA);
        PG8_WAIT_V(6); PG8_BAR;
    }
    for (;;) {
        const bool has_next = S.next(ui + 1, nxt);
        const char* nA = has_next ? (const char*)g.A + (size_t)nxt.pm * tstep : cA; const char* nB = has_next ? (const char*)g.Bt + (size_t)nxt.pn * tstep : cB;
        for (int t = 0; t < nt; t += 2) {
            const bool last = (t == nt - 2);
            const char* a1 = cA + (size_t)(t + 1) * kstep;
            const char* a2 = last ? nA : cA + (size_t)(t + 2) * kstep; const char* b2 = last ? nB : cB + (size_t)(t + 2) * kstep;
            const char* a3 = a2 + kstep; const char* b3 = b2 + kstep;
            PG8_LDB(B0, 0, 0); PG8_LDB(B1, 0, 1); PG8_SCHED; PG8_LDA(At, 0, 0); PG8_STAGE(PG8_SA(1, 1), a1 + hstep, voffA);
            PG8_WAIT_V(8); PG8_WAIT_L(0); PG8_BAR; PG8_MMA(0, 0, At, B0); PG8_MMA(0, 1, At, B1); PG8_BAR; PG8_SCHED;
            PG8_LDA(At, 0, 1); PG8_STAGE(PG8_SB(0, 0), b2, voffA); PG8_STAGE(PG8_SB(0, 1), b2 + hstep, voffA); PG8_STAGE(PG8_SA(0, 0), a2, voffA);
            PG8_WAIT_V(8); PG8_WAIT_L(0); PG8_BAR; PG8_MMA(1, 0, At, B0); PG8_MMA(1, 1, At, B1); PG8_BAR; PG8_SCHED;
            PG8_LDB(B0, 1, 0); PG8_LDB(B1, 1, 1); PG8_SCHED; PG8_LDA(At, 1, 0); PG8_STAGE(PG8_SA(0, 1), a2 + hstep, voffA);
            PG8_WAIT_V(8); PG8_WAIT_L(0); PG8_BAR; PG8_MMA(0, 0, At, B0); PG8_MMA(0, 1, At, B1); PG8_BAR; PG8_SCHED;
            PG8_LDA(At, 1, 1); PG8_STAGE(PG8_SB(1, 0), b3, voffA); PG8_STAGE(PG8_SB(1, 1), b3 + hstep, voffA); PG8_STAGE(PG8_SA(1, 0), a3, voffA);
            PG8_WAIT_V(8); PG8_WAIT_L(0); PG8_BAR; PG8_MMA(1, 0, At, B0); PG8_MMA(1, 1, At, B1); PG8_BAR; PG8_SCHED;
        }
        if constexpr (ALIGN_EPI) { if (wr == 0) PG8_BAR; }
        E(acc, cur, wr, wc, fr, fq);
        if (!has_next) break;
#pragma unroll
        for (int a = 0; a < 2; ++a)
#pragma unroll
            for (int b = 0; b < 2; ++b)
#pragma unroll
                for (int m = 0; m < 4; ++m)
#pragma unroll
                    for (int n = 0; n < 2; ++n) acc[a][b][m][n] = (f32x4){0.f, 0.f, 0.f, 0.f};
        cur = nxt; cA = nA; cB = nB; ++ui;
        if constexpr (ALIGN_EPI) { if (wr == 1) PG8_BAR; }
    }
    PG8_WAIT_V(0);
    if constexpr (!ALIGN_EPI) { if (wr == 0) PG8_BAR; }
    PG8_BAR;
#undef PG8_SA
#undef PG8_SB
#undef PG8_STAGE
#undef PG8_LDA
#undef PG8_LDB
#undef PG8_MMA
#undef PG8_WAIT_V
#undef PG8_WAIT_L
#undef PG8_BAR
#undef PG8_SCHED
}
}
using pg8::Unit;


template <int LAYER> struct EpiIn {
    const float* ssq; const float* shw; int N; bf16_t* P; const float* gq; const float* gk;
    __device__ __forceinline__ void operator()(const f32x4 (&acc)[2][2][4][2], const Unit& u, int wr, int wc, int fr, int fq) const {
        const int b = u.pm >> 3;
        bf16_t* base; int ld, col0, mode;
        if (LAYER == 0) { const int region = u.pn >> 1; base = P + (size_t)region * M * 512; ld = 512; col0 = (u.pn & 1) * 256; mode = region == 2 ? 1 : (region == 3 ? 2 : 0); }
        else {
            if (u.pn < 4) { base = P; ld = 1024; col0 = u.pn * 256; mode = 1; }
            else if (u.pn == 4) { base = P + (size_t)M * 1024; ld = 256; col0 = 0; mode = 2; }
            else { base = P + (size_t)M * 1024 + (size_t)M * 256; ld = 256; col0 = 0; mode = 0; }
        }
        const float* bias = shw + (size_t)b * N + u.pn * 256 + wc * 32 + 4 * fq;
        f32x4 bv[2][2];
#pragma unroll
        for (int bj = 0; bj < 2; ++bj)
#pragma unroll
            for (int n = 0; n < 2; ++n) bv[bj][n] = *(const f32x4*)(bias + bj * 128 + n * 16);
        if (mode == 0) {
#pragma unroll
            for (int ai = 0; ai < 2; ++ai)
#pragma unroll
                for (int m = 0; m < 4; ++m) {
                    const int row = u.pm * 256 + ai * 128 + wr * 64 + m * 16 + fr;
                    const float rs = rsqrtf(ssq[row] * (1.0f / 1024.0f) + EPS);
                    bf16_t* rp = base + (size_t)row * ld + col0 + wc * 32 + 4 * fq;
#pragma unroll
                    for (int bj = 0; bj < 2; ++bj)
#pragma unroll
                        for (int n = 0; n < 2; ++n) { const f32x4 v = acc[ai][bj][m][n] * rs + bv[bj][n]; u32x2 w; w.x = pk2(v[0], v[1]); w.y = pk2(v[2], v[3]); *(u32x2*)(rp + bj * 128 + n * 16) = w; }
                }
        } else {
            const float* gn = (mode == 1) ? gq : gk; const float sc = (mode == 1) ? QSCALE : 1.0f;
            f32x4 gv[2][2];
#pragma unroll
            for (int bj = 0; bj < 2; ++bj)
#pragma unroll
                for (int n = 0; n < 2; ++n) gv[bj][n] = *(const f32x4*)(gn + 32 * bj + 16 * n + 4 * fq) * sc;
#pragma unroll
            for (int ai = 0; ai < 2; ++ai)
#pragma unroll
                for (int m = 0; m < 4; ++m) {
                    const int row = u.pm * 256 + ai * 128 + wr * 64 + m * 16 + fr;
                    const float rs = rsqrtf(ssq[row] * (1.0f / 1024.0f) + EPS);
                    f32x4 v[2][2]; float ss = 0.f;
#pragma unroll
                    for (int bj = 0; bj < 2; ++bj)
#pragma unroll
                        for (int n = 0; n < 2; ++n) { v[bj][n] = acc[ai][bj][m][n] * rs + bv[bj][n]; const f32x4 q = v[bj][n] * v[bj][n]; ss += (q[0] + q[1]) + (q[2] + q[3]); }
                    ss += __shfl_xor(ss, 16); ss += __shfl_xor(ss, 32);
                    const float hr = rsqrtf(ss * (1.0f / 64.0f) + EPS);
                    bf16_t* rp = base + (size_t)row * ld + col0 + 64 * wc + 4 * fq;
#pragma unroll
                    for (int bj = 0; bj < 2; ++bj)
#pragma unroll
                        for (int n = 0; n < 2; ++n) { const f32x4 o = v[bj][n] * hr * gv[bj][n]; u32x2 w; w.x = pk2(o[0], o[1]); w.y = pk2(o[2], o[3]); *(u32x2*)(rp + 32 * bj + 16 * n) = w; }
                }
        }
    }
};

template <bool LAST> struct EpiRes {
    const float* xin; float* xout; const float* gate; const float* ng; const float* nsc; bf16_t* xg; float* ssq;
    __device__ __forceinline__ void operator()(const f32x4 (&acc)[2][2][4][2], const Unit& u, int wr, int wc, int fr, int fq) const {
        const int b = u.pm >> 3;
        const int col = u.pn * 256 + wc * 32 + 4 * fq;
        f32x4 gt[2][2], gm[2][2];
#pragma unroll
        for (int bj = 0; bj < 2; ++bj)
#pragma unroll
            for (int n = 0; n < 2; ++n) {
                gt[bj][n] = *(const f32x4*)(gate + (size_t)b * 6144 + col + bj * 128 + n * 16);
                if (!LAST) gm[bj][n] = *(const f32x4*)(ng + col + bj * 128 + n * 16) * (*(const f32x4*)(nsc + (size_t)b * 6144 + col + bj * 128 + n * 16) + 1.0f);
            }
#pragma unroll
        for (int ai = 0; ai < 2; ++ai)
#pragma unroll
            for (int m = 0; m < 4; ++m) {
                const int row = u.pm * 256 + ai * 128 + wr * 64 + m * 16 + fr;
                const size_t off = (size_t)row * 1024 + col;
                float s = 0.f;
#pragma unroll
                for (int bj = 0; bj < 2; ++bj)
#pragma unroll
                    for (int n = 0; n < 2; ++n) {
                        const f32x4 xi = *(const f32x4*)(xin + off + bj * 128 + n * 16);
                        const f32x4 v = xi + gt[bj][n] * acc[ai][bj][m][n];
                        *(f32x4*)(xout + off + bj * 128 + n * 16) = v;
                        if (!LAST) {
                            const f32x4 q = v * v; s += (q[0] + q[1]) + (q[2] + q[3]);
                            const f32x4 o = v * gm[bj][n]; u32x2 w; w.x = pk2(o[0], o[1]); w.y = pk2(o[2], o[3]); *(u32x2*)(xg + off + bj * 128 + n * 16) = w;
                        }
                    }
                if (!LAST) { s += __shfl_xor(s, 16); s += __shfl_xor(s, 32); if (fq == 0) unsafeAtomicAdd(ssq + row, s); }
            }
    }
};

__device__ __forceinline__ f32x4 silu4(f32x4 a) {
    f32x4 r;
#pragma unroll
    for (int e = 0; e < 4; ++e) r[e] = a[e] * __builtin_amdgcn_rcpf(1.0f + __builtin_amdgcn_exp2f(-a[e] * LOG2E));
    return r;
}
template <int N_> __device__ __forceinline__ f32x4 ror4(f32x4 v) {
    f32x4 r;
#pragma unroll
    for (int e = 0; e < 4; ++e) r[e] = __int_as_float(__builtin_amdgcn_update_dpp(0, __float_as_int(v[e]), 0x120 + N_, 0xf, 0xf, false));
    return r;
}
struct EpiGU {
    const float* ssq; const float* shw; const float* cw; const float* cbias; bf16_t* act; float* halo; float* fixp; float* fixu;
    __device__ __forceinline__ void operator()(const f32x4 (&acc)[2][2][4][2], const Unit& u, int wr, int wc, int fr, int fq) const {
        const int b = u.pm >> 3;
        const int fcol = u.pn * 128 + wc * 32 + 4 * fq;
        const float* bias = shw + (size_t)b * 5632 + u.pn * 256 + wc * 32 + 4 * fq;
#pragma unroll
        for (int n = 0; n < 2; ++n) {
            const f32x4 bg = *(const f32x4*)(bias + n * 16), bu = *(const f32x4*)(bias + 128 + n * 16);
            const f32x4 w0 = *(const f32x4*)(cw + fcol + n * 16), w1 = *(const f32x4*)(cw + FF + fcol + n * 16), w2 = *(const f32x4*)(cw + 2 * FF + fcol + n * 16);
            const f32x4 cb = *(const f32x4*)(cbias + fcol + n * 16);
#pragma unroll
            for (int ai = 0; ai < 2; ++ai) {
                const int gs = u.pm * 4 + ai * 2 + wr;
                f32x4 p1 = (f32x4){0.f, 0.f, 0.f, 0.f}, p2 = p1;
#pragma unroll
                for (int m = 0; m < 4; ++m) {
                    const int row = gs * 64 + m * 16 + fr;
                    const float rs = rsqrtf(ssq[row] * (1.0f / 1024.0f) + EPS);
                    const f32x4 g = acc[ai][0][m][n] * rs + bg;
                    const f32x4 up = acc[ai][1][m][n] * rs + bu;
                    const f32x4 c1 = ror4<1>(g), c2 = ror4<2>(g);
                    const f32x4 g1 = fr >= 1 ? c1 : p1;
                    const f32x4 g2 = fr >= 2 ? c2 : p2;
                    if (m == 0 && fr < 2) {
                        f32x4 pp = w2 * g + cb; if (fr == 1) pp = pp + w1 * g1;
                        const size_t fo = ((size_t)gs * 2 + fr) * FF + fcol + n * 16;
                        *(f32x4*)(fixp + fo) = pp; *(f32x4*)(fixu + fo) = up;
                    } else {
                        const f32x4 a = w2 * g + w1 * g1 + w0 * g2 + cb;
                        const f32x4 o = silu4(a) * up;
                        u32x2 w; w.x = pk2(o[0], o[1]); w.y = pk2(o[2], o[3]);
                        *(u32x2*)(act + (size_t)row * FF + fcol + n * 16) = w;
                    }
                    if (m == 3 && fr >= 14) *(f32x4*)(halo + ((size_t)gs * 2 + (fr - 14)) * FF + fcol + n * 16) = g;
                    p1 = c1; p2 = c2;
                }
            }
        }
    }
};

#define MFMA32(a, b, c) __builtin_amdgcn_mfma_f32_32x32x16_bf16((a), (b), (c), 0, 0, 0)
__device__ __forceinline__ int crow(int i, int h) { return (i & 3) + 8 * (i >> 2) + 4 * h; }
__device__ __forceinline__ bf16x8 pack8(float a0, float a1, float a2, float a3, float a4, float a5, float a6, float a7) {
    u32x4 p; p.x = pk2(a0, a1); p.y = pk2(a2, a3); p.z = pk2(a4, a5); p.w = pk2(a6, a7); return __builtin_bit_cast(bf16x8, p);
}
__device__ __forceinline__ bf16x8 tr8(const LAS unsigned char* p_lo, int hi_off) {
    const s16x4 lo = __builtin_amdgcn_ds_read_tr16_b64_v4i16((LAS s16x4*)p_lo);
    const s16x4 hi = __builtin_amdgcn_ds_read_tr16_b64_v4i16((LAS s16x4*)(p_lo + hi_off));
    return __builtin_shufflevector(lo, hi, 0, 1, 2, 3, 4, 5, 6, 7);
}

constexpr int KSTR = 144, VSTR = 192, KBUF = 64 * KSTR, VBUF = 64 * VSTR, SB_VOFF = 2 * KBUF, SB_FLAG = SB_VOFF + 2 * VBUF;
__device__ __forceinline__ void sb_unit(LAS unsigned char* lds, const bf16_t* Q, const bf16_t* K, const bf16_t* V, bf16_t* Y, int b, int h, int qb, int tid, int wid, int lane) {
    const int r = lane & 31, hh = lane >> 5;
    const int q0 = qb * 256, qw0 = q0 + 32 * wid, qblk = qw0 >> 5;
    const size_t rowbase = (size_t)b * SEQ;
    bf16x8 qf[4];
    { const bf16_t* qp = Q + (rowbase + qw0 + r) * 512 + h * 64 + 8 * hh;
#pragma unroll
      for (int s = 0; s < 4; ++s) qf[s] = *(const bf16x8*)(qp + 16 * s); }
    f32x16 O0, O1;
#pragma unroll
    for (int i = 0; i < 16; ++i) { O0[i] = 0.f; O1[i] = 0.f; }
    float carry = 0.f;
    const int nkt = 4 * qb + 4;
    const int srow = tid >> 3, spc = tid & 7;
    const bf16_t* kg = K + (rowbase + srow) * 512 + h * 64 + spc * 8;
    const bf16_t* vg = V + (rowbase + srow) * 512 + h * 64 + spc * 8;
    LAS unsigned* flags = (LAS unsigned*)(lds + SB_FLAG);
    __syncthreads();
    u32x4 kreg = *(const u32x4*)(kg + (size_t)(nkt - 1) * 64 * 512), vreg = *(const u32x4*)(vg + (size_t)(nkt - 1) * 64 * 512);
    *(LAS u32x4*)(lds + srow * KSTR + spc * 16) = kreg; *(LAS u32x4*)(lds + SB_VOFF + srow * VSTR + spc * 16) = vreg;
    __syncthreads();
    int cur = 0;
    const int q4 = (lane & 15) >> 2, p4 = lane & 3, blk = (lane >> 4) & 1;
    const int vlane_off = (4 * hh + q4) * VSTR + 8 * (4 * blk + p4);
    for (int kt = nkt - 1; kt >= 0; --kt) {
        if (kt > 0) { kreg = *(const u32x4*)(kg + (size_t)(kt - 1) * 64 * 512); vreg = *(const u32x4*)(vg + (size_t)(kt - 1) * 64 * 512); }
        const LAS unsigned char* kb_ = lds + cur * KBUF; const LAS unsigned char* vb_ = lds + SB_VOFF + cur * VBUF;
        bool wdone = __all(carry >= 160.0f);
        if (!wdone) {
#pragma unroll
            for (int kb = 1; kb >= 0; --kb) {
                const int kb32 = 2 * kt + kb;
                if (kb32 <= qblk) {
                    const bool diag = (kb32 == qblk);
                    f32x16 z;
#pragma unroll
                    for (int i = 0; i < 16; ++i) z[i] = 0.f;
#pragma unroll
                    for (int s = 0; s < 4; ++s) { const bf16x8 a = *(const LAS bf16x8*)(kb_ + (32 * kb + r) * KSTR + 32 * s + 16 * hh); z = MFMA32(a, qf[s], z); }
                    float sp[16];
#pragma unroll
                    for (int i = 0; i < 16; ++i) {
                        const float e = __builtin_amdgcn_exp2f(z[i]);
                        float v = __builtin_amdgcn_logf(1.0f + e);
                        if (diag && !(crow(i, hh) < r)) v = 0.f;
                        sp[i] = v;
                    }
                    float G[4], Gp[4];
#pragma unroll
                    for (int g = 0; g < 4; ++g) { G[g] = (sp[4 * g] + sp[4 * g + 1]) + (sp[4 * g + 2] + sp[4 * g + 3]); Gp[g] = __shfl_xor(G[g], 32); }
                    float suf = carry; float w[16];
#pragma unroll
                    for (int g = 3; g >= 0; --g) {
                        float run = suf + (hh == 0 ? Gp[g] : 0.f);
#pragma unroll
                        for (int i = 4 * g + 3; i >= 4 * g; --i) {
                            run += sp[i];
                            float wv = __builtin_amdgcn_exp2f(z[i] - run);
                            if (diag && !(crow(i, hh) < r)) wv = 0.f;
                            w[i] = wv;
                        }
                        suf += G[g] + Gp[g];
                    }
                    carry = suf;
#pragma unroll
                    for (int s = 0; s < 2; ++s) {
                        const bf16x8 pf = pack8(w[8 * s], w[8 * s + 1], w[8 * s + 2], w[8 * s + 3], w[8 * s + 4], w[8 * s + 5], w[8 * s + 6], w[8 * s + 7]);
                        const LAS unsigned char* vp = vb_ + (32 * kb + 16 * s) * VSTR + vlane_off;
                        const bf16x8 a0 = tr8(vp, 8 * VSTR), a1 = tr8(vp + 64, 8 * VSTR);
                        O0 = MFMA32(a0, pf, O0); O1 = MFMA32(a1, pf, O1);
                    }
                }
            }
            wdone = __all(carry >= 160.0f);
        }
        if (kt > 0) { *(LAS u32x4*)(lds + (cur ^ 1) * KBUF + srow * KSTR + spc * 16) = kreg; *(LAS u32x4*)(lds + SB_VOFF + (cur ^ 1) * VBUF + srow * VSTR + spc * 16) = vreg; }
        if (lane == 0) flags[(kt & 1) * 8 + wid] = wdone ? 1u : 0u;
        __syncthreads();
        unsigned alld = 1u;
#pragma unroll
        for (int w8 = 0; w8 < 8; ++w8) alld &= flags[(kt & 1) * 8 + w8];
        if (alld) break;
        cur ^= 1;
    }
    bf16_t* yp = Y + (rowbase + qw0 + r) * 1024 + 512 + h * 64 + 4 * hh;
#pragma unroll
    for (int g = 0; g < 4; ++g) {
        u32x2 w0; w0.x = pk2(O0[4 * g], O0[4 * g + 1]); w0.y = pk2(O0[4 * g + 2], O0[4 * g + 3]); *(u32x2*)(yp + 8 * g) = w0;
        u32x2 w1; w1.x = pk2(O1[4 * g], O1[4 * g + 1]); w1.y = pk2(O1[4 * g + 2], O1[4 * g + 3]); *(u32x2*)(yp + 32 + 8 * g) = w1;
    }
}

constexpr int SW_VOFF = 192 * KSTR;
__device__ __forceinline__ void swa_unit(LAS unsigned char* lds, const bf16_t* Q, const bf16_t* K, const bf16_t* V, const float* sinks, bf16_t* Y, int b, int kvh, int qc, int tid, int wid, int lane) {
    const int r = lane & 31, hh = lane >> 5;
    const int head = 4 * kvh + (wid >> 1), qsub = wid & 1;
    const int qw0 = 64 * qc + 32 * qsub;
    const size_t rowbase = (size_t)b * SEQ;
    const int kbase = 64 * qc - 128;
    __syncthreads();
#pragma unroll
    for (int it = 0; it < 3; ++it) {
        const int idx = tid + it * 512, srow = idx >> 3, spc = idx & 7, kpos = kbase + srow;
        u32x4 kv = (u32x4){0u, 0u, 0u, 0u}, vv = (u32x4){0u, 0u, 0u, 0u};
        if (kpos >= 0) { kv = *(const u32x4*)(K + (rowbase + kpos) * 256 + kvh * 64 + spc * 8); vv = *(const u32x4*)(V + (rowbase + kpos) * 256 + kvh * 64 + spc * 8); }
        *(LAS u32x4*)(lds + srow * KSTR + spc * 16) = kv; *(LAS u32x4*)(lds + SW_VOFF + srow * VSTR + spc * 16) = vv;
    }
    bf16x8 qf[4];
    { const bf16_t* qp = Q + (rowbase + qw0 + r) * 1024 + head * 64 + 8 * hh;
#pragma unroll
      for (int s = 0; s < 4; ++s) qf[s] = *(const bf16x8*)(qp + 16 * s); }
    __syncthreads();
    f32x16 O0, O1;
#pragma unroll
    for (int i = 0; i < 16; ++i) { O0[i] = 0.f; O1[i] = 0.f; }
    float mrun = sinks[head] * LOG2E, lsum = (hh == 0) ? 1.0f : 0.0f;
    const int q4 = (lane & 15) >> 2, p4 = lane & 3, blk = (lane >> 4) & 1;
    const int vlane_off = (4 * hh + q4) * VSTR + 8 * (4 * blk + p4);
#pragma unroll
    for (int j = 0; j < 5; ++j) {
        const int rb = qsub + j;
        const int key0 = kbase + 32 * rb;
        if (key0 >= 0) {
            f32x16 z;
#pragma unroll
            for (int i = 0; i < 16; ++i) z[i] = 0.f;
#pragma unroll
            for (int s = 0; s < 4; ++s) { const bf16x8 a = *(const LAS bf16x8*)(lds + (32 * rb + r) * KSTR + 32 * s + 16 * hh); z = MFMA32(a, qf[s], z); }
            float bm = -3.0e38f;
#pragma unroll
            for (int i = 0; i < 16; ++i) {
                bool valid = true;
                if (j == 0) valid = (crow(i, hh) > r);
                if (j == 4) valid = (crow(i, hh) <= r);
                if (!valid) z[i] = -3.0e38f;
                bm = fmaxf(bm, z[i]);
            }
            bm = fmaxf(bm, __shfl_xor(bm, 32));
            const float mnew = fmaxf(mrun, bm);
            const float alpha = __builtin_amdgcn_exp2f(mrun - mnew);
            mrun = mnew;
            float w[16]; float ps = 0.f;
#pragma unroll
            for (int i = 0; i < 16; ++i) { w[i] = __builtin_amdgcn_exp2f(z[i] - mnew); ps += w[i]; }
            lsum = lsum * alpha + ps;
#pragma unroll
            for (int i = 0; i < 16; ++i) { O0[i] *= alpha; O1[i] *= alpha; }
#pragma unroll
            for (int s = 0; s < 2; ++s) {
                const bf16x8 pf = pack8(w[8 * s], w[8 * s + 1], w[8 * s + 2], w[8 * s + 3], w[8 * s + 4], w[8 * s + 5], w[8 * s + 6], w[8 * s + 7]);
                const LAS unsigned char* vp = lds + SW_VOFF + (32 * rb + 16 * s) * VSTR + vlane_off;
                const bf16x8 a0 = tr8(vp, 8 * VSTR), a1 = tr8(vp + 64, 8 * VSTR);
                O0 = MFMA32(a0, pf, O0); O1 = MFMA32(a1, pf, O1);
            }
        }
    }
    lsum += __shfl_xor(lsum, 32);
    const float inv = 1.0f / lsum;
    bf16_t* yp = Y + (rowbase + qw0 + r) * 1024 + head * 64 + 4 * hh;
#pragma unroll
    for (int g = 0; g < 4; ++g) {
        u32x2 w0; w0.x = pk2(O0[4 * g] * inv, O0[4 * g + 1] * inv); w0.y = pk2(O0[4 * g + 2] * inv, O0[4 * g + 3] * inv); *(u32x2*)(yp + 8 * g) = w0;
        u32x2 w1; w1.x = pk2(O1[4 * g] * inv, O1[4 * g + 1] * inv); w1.y = pk2(O1[4 * g + 2] * inv, O1[4 * g + 3] * inv); *(u32x2*)(yp + 32 + 8 * g) = w1;
    }
}

constexpr int XCS = 68;
struct LruArgs { const bf16_t* XR; const bf16_t* GR; bf16_t* Y; const float* convw; const float* convb; const float* wa; const float* ba; const float* wx; const float* bx; const float* lam; };
__device__ __forceinline__ void lru_item(LAS unsigned char* lds, const LruArgs& A, int item, int tid, int wid, int lane) {
    const int b = item >> 4, n = (item >> 1) & 7, half = item & 1;
    const int r = lane & 31, hh = lane >> 5;
    const int co = lane & 7, tsub = lane >> 3;
    const size_t rowbase = (size_t)b * SEQ;
    LAS float* xcw = (LAS float*)(lds + wid * (32 * XCS * 4));
    LAS float* exch = (LAS float*)(lds + 8 * (32 * XCS * 4));
    float cw[4][8], cbv[8];
#pragma unroll
    for (int k = 0; k < 4; ++k)
#pragma unroll
        for (int j = 0; j < 8; ++j) cw[k][j] = A.convw[k * 512 + 64 * n + 8 * co + j];
#pragma unroll
    for (int j = 0; j < 8; ++j) cbv[j] = A.convb[64 * n + 8 * co + j];
    bf16x8 waf[4], wxf[4];
#pragma unroll
    for (int s = 0; s < 4; ++s) {
        float ta[8], tx[8];
#pragma unroll
        for (int j = 0; j < 8; ++j) { const int idx = (n * 64 + 16 * s + 8 * hh + j) * 64 + 32 * half + r; ta[j] = A.wa[idx]; tx[j] = A.wx[idx]; }
        waf[s] = pack8(ta[0], ta[1], ta[2], ta[3], ta[4], ta[5], ta[6], ta[7]);
        wxf[s] = pack8(tx[0], tx[1], tx[2], tx[3], tx[4], tx[5], tx[6], tx[7]);
    }
    const int c = 64 * n + 32 * half + r;
    const float ba_c = A.ba[c], bx_c = A.bx[c];
    const float lam_c = A.lam[c];
    const float spl2 = 8.0f * (fmaxf(-lam_c, 0.f) + log1pf(expf(-fabsf(lam_c)))) * LOG2E;
    __syncthreads();
    float hin = 0.f;
    for (int pass = 0; pass < 2; ++pass) {
        float hstate = hin, Aw = 1.0f;
        for (int blk = 0; blk < 8; ++blk) {
            const int tb = 256 * wid + 32 * blk;
#pragma unroll
            for (int p = 0; p < 4; ++p) {
                const int tl = 8 * p + tsub, t = tb + tl;
                float av[8];
#pragma unroll
                for (int j = 0; j < 8; ++j) av[j] = cbv[j];
#pragma unroll
                for (int k = 0; k < 4; ++k) {
                    const int tt = t - 3 + k;
                    if (tt >= 0) {
                        const u32x4 raw = *(const u32x4*)(A.XR + (rowbase + tt) * 512 + 64 * n + 8 * co);
                        av[0] += cw[k][0] * bflo(raw.x); av[1] += cw[k][1] * bfhi(raw.x); av[2] += cw[k][2] * bflo(raw.y); av[3] += cw[k][3] * bfhi(raw.y);
                        av[4] += cw[k][4] * bflo(raw.z); av[5] += cw[k][5] * bfhi(raw.z); av[6] += cw[k][6] * bflo(raw.w); av[7] += cw[k][7] * bfhi(raw.w);
                    }
                }
                *(LAS f32x4*)(xcw + tl * XCS + 8 * co) = (f32x4){av[0], av[1], av[2], av[3]};
                *(LAS f32x4*)(xcw + tl * XCS + 8 * co + 4) = (f32x4){av[4], av[5], av[6], av[7]};
            }
            LDS_WAIT();
            f32x16 R, I;
#pragma unroll
            for (int i = 0; i < 16; ++i) { R[i] = 0.f; I[i] = 0.f; }
#pragma unroll
            for (int s = 0; s < 4; ++s) {
                const f32x4 a0 = *(const LAS f32x4*)(xcw + r * XCS + 16 * s + 8 * hh), a1 = *(const LAS f32x4*)(xcw + r * XCS + 16 * s + 8 * hh + 4);
                const bf16x8 af = pack8(a0[0], a0[1], a0[2], a0[3], a1[0], a1[1], a1[2], a1[3]);
                R = MFMA32(af, waf[s], R); I = MFMA32(af, wxf[s], I);
            }
            float av_[16], uv_[16];
#pragma unroll
            for (int i = 0; i < 16; ++i) {
                const float xcf = xcw[crow(i, hh) * XCS + 32 * half + r];
                const float rr = __builtin_amdgcn_rcpf(1.0f + __builtin_amdgcn_exp2f(-(R[i] + ba_c) * LOG2E));
                const float ii = __builtin_amdgcn_rcpf(1.0f + __builtin_amdgcn_exp2f(-(I[i] + bx_c) * LOG2E));
                const float la2 = -rr * spl2;
                const float a = __builtin_amdgcn_exp2f(la2);
                const float y = la2 * (2.0f / LOG2E);
                const float om = (y > -0.25f) ? -y * (1.0f + y * (0.5f + y * ((1.0f / 6.0f) + y * ((1.0f / 24.0f) + y * (1.0f / 120.0f))))) : 1.0f - a * a;
                av_[i] = a; uv_[i] = sqrtf(om) * ii * xcf;
            }
            asm volatile("" ::: "memory");
            float Ag[4], Bg[4], pA[4], pB[4];
#pragma unroll
            for (int g = 0; g < 4; ++g) {
                Ag[g] = (av_[4 * g] * av_[4 * g + 1]) * (av_[4 * g + 2] * av_[4 * g + 3]);
                Bg[g] = ((uv_[4 * g] * av_[4 * g + 1] + uv_[4 * g + 1]) * av_[4 * g + 2] + uv_[4 * g + 2]) * av_[4 * g + 3] + uv_[4 * g + 3];
                pA[g] = __shfl_xor(Ag[g], 32); pB[g] = __shfl_xor(Bg[g], 32);
            }
            float hcur = hstate, start[4];
#pragma unroll
            for (int g = 0; g < 4; ++g) {
                const float A0 = hh == 0 ? Ag[g] : pA[g], B0 = hh == 0 ? Bg[g] : pB[g];
                const float A1 = hh == 0 ? pA[g] : Ag[g], B1 = hh == 0 ? pB[g] : Bg[g];
                const float s0 = hcur; hcur = A0 * hcur + B0;
                const float s1 = hcur; hcur = A1 * hcur + B1;
                start[g] = hh == 0 ? s0 : s1; Aw *= A0 * A1;
            }
            if (pass == 1) {
#pragma unroll
                for (int g = 0; g < 4; ++g) {
                    float hv = start[g];
#pragma unroll
                    for (int i = 4 * g; i < 4 * g + 4; ++i) {
                        hv = av_[i] * hv + uv_[i];
                        const size_t row = rowbase + tb + crow(i, hh);
                        const float gv = bflo((unsigned)A.GR[row * 512 + c]);
                        const float yy = 0.7978845608028654f * (gv + 0.044715f * gv * gv * gv);
                        const float ge = gv * __builtin_amdgcn_rcpf(1.0f + __builtin_amdgcn_exp2f(-2.0f * LOG2E * yy));
                        A.Y[row * 1024 + c] = (bf16_t)(pk2(hv * ge, 0.f) & 0xffffu);
                    }
                }
            }
            hstate = hcur;
        }
        if (pass == 0) {
            if (hh == 0) { exch[(wid * 32 + r) * 2] = Aw; exch[(wid * 32 + r) * 2 + 1] = hstate; }
            __syncthreads();
            hin = 0.f;
            for (int w8 = 0; w8 < wid; ++w8) hin = exch[(w8 * 32 + r) * 2] * hin + exch[(w8 * 32 + r) * 2 + 1];
        }
    }
}

__device__ __forceinline__ float wave_sum(float v) {
#pragma unroll
    for (int o = 1; o < 64; o <<= 1) v += __shfl_xor(v, o);
    return v;
}
__device__ __forceinline__ int headperm(int n) { return (n & ~255) | (((n >> 5) & 1) << 7) | (((n >> 6) & 3) << 5) | (n & 31); }
__device__ __forceinline__ void transpose_item(const float* W, int N, bf16_t* WT, int K, int dst_row0, int k0, int n0, LAS float* scr, int lane) {
    float tv[32];
#pragma unroll
    for (int i = 0; i < 32; ++i) { const int kk = 2 * i + (lane >> 5); tv[i] = W[(size_t)(k0 + kk) * N + n0 + (lane & 31)]; }
#pragma unroll
    for (int i = 0; i < 32; ++i) { const int kk = 2 * i + (lane >> 5); scr[kk * 33 + (lane & 31)] = tv[i]; }
    LDS_WAIT();
    const int c8 = lane & 7;
#pragma unroll
    for (int j = 0; j < 4; ++j) { const int n = (lane >> 3) + 8 * j; const LAS float* s = scr + (8 * c8) * 33 + n;
        u32x4 o; o.x = pk2(s[0 * 33], s[1 * 33]); o.y = pk2(s[2 * 33], s[3 * 33]); o.z = pk2(s[4 * 33], s[5 * 33]); o.w = pk2(s[6 * 33], s[7 * 33]);
        *(u32x4*)(WT + (size_t)(dst_row0 + n) * K + k0 + 8 * c8) = o; }
    LDS_WAIT();
}


#define XB_TMO      128
#define XB_XCNT(j)  (256  + 64 * (j))
#define XB_XSUB(j)  (1280 + 64 * (j))
#define XB_XGEN(j)  (2304 + 64 * (j))
#define XB_TOP      3328
#define XB_TOPGEN   3392
#define XCD_BAR_WORDS 3456
#define XB_SPIN_CAP (1u << 20)
__device__ __forceinline__ unsigned xb_ld(unsigned* p)              { return __hip_atomic_load(p, __ATOMIC_RELAXED, __HIP_MEMORY_SCOPE_AGENT); }
__device__ __forceinline__ unsigned xb_add(unsigned* p, unsigned v) { return __hip_atomic_fetch_add(p, v, __ATOMIC_RELAXED, __HIP_MEMORY_SCOPE_AGENT); }
__device__ __forceinline__ unsigned xb_xcc_id() { return (unsigned)__builtin_amdgcn_s_getreg((3 << 11) | 20) & 0xFu; }
#define XB_SPIN(cond, bar) do { unsigned _sp = 0; while (cond) { __builtin_amdgcn_s_sleep(1); \
    if ((++_sp & 255u) == 0u) { if (xb_ld(&(bar)[XB_TMO])) break; if (_sp > XB_SPIN_CAP) { atomicAdd(&(bar)[XB_TMO], 1u); break; } } } } while (0)
struct XcdBarrier { unsigned* bar; unsigned x; volatile LAS unsigned* st; };
__device__ __forceinline__ void xcd_barrier_complete(unsigned* bar, unsigned x, unsigned& nloc, unsigned& nx) {
    const unsigned G = gridDim.x * gridDim.y * gridDim.z;
    unsigned sum, cnt, mine, sp = 0u;
    for (;;) {
        sum = 0u; cnt = 0u; mine = 0u;
#pragma unroll
        for (unsigned j = 0; j < 16; ++j) { const unsigned c = xb_ld(&bar[XB_XCNT(j)]); sum += c; cnt += (c > 0u) ? 1u : 0u; mine = (j == x) ? c : mine; }
        if (sum == G) break;
        __builtin_amdgcn_s_sleep(1);
        if ((++sp & 255u) == 0u) { if (xb_ld(&bar[XB_TMO])) break; if (sp > XB_SPIN_CAP) { atomicAdd(&bar[XB_TMO], 1u); break; } }
    }
    nloc = mine > 0u ? mine : 1u; nx = cnt > 0u ? cnt : 1u;
}
__device__ __forceinline__ void xcd_barrier(const XcdBarrier& b, const bool leader) {
    asm volatile("s_waitcnt vmcnt(0)" ::: "memory");
    __syncthreads();
    if (leader) {
        unsigned* bar = b.bar;
        __builtin_amdgcn_s_waitcnt(0);
        unsigned nloc = b.st[0], nx = b.st[1];
        if (nloc == 0u) { xcd_barrier_complete(bar, b.x, nloc, nx); b.st[0] = nloc; b.st[1] = nx; }
        const unsigned old = xb_add(&bar[XB_XSUB(b.x)], 1u);
        const unsigned gen = old / nloc;
        if (old + 1u == (gen + 1u) * nloc) {
            __builtin_amdgcn_fence(__ATOMIC_RELEASE, "agent");
            asm volatile("s_waitcnt vmcnt(0)" ::: "memory");
            const unsigned og = xb_add(&bar[XB_TOP], 1u);
            const unsigned tg = og / nx;
            if (og + 1u == (tg + 1u) * nx) xb_add(&bar[XB_TOPGEN], 1u);
            else XB_SPIN(xb_ld(&bar[XB_TOPGEN]) == tg, bar);
            __builtin_amdgcn_fence(__ATOMIC_ACQUIRE, "agent");
            xb_add(&bar[XB_XGEN(b.x)], 1u);
            asm volatile("s_waitcnt vmcnt(0)" ::: "memory");
        } else {
            XB_SPIN(xb_ld(&bar[XB_XGEN(b.x)]) == gen, bar);
            __builtin_amdgcn_fence(__ATOMIC_ACQUIRE, "agent");
            asm volatile("s_waitcnt vmcnt(0)" ::: "memory");
        }
    }
    __syncthreads();
}

struct Args { const float* in[27]; float* out; unsigned char* ws; };

__global__ void __launch_bounds__(512, 2) fwd_mega(Args args) {
    extern __shared__ __attribute__((aligned(16))) unsigned char lds_raw[];
    LAS unsigned char* lds = (LAS unsigned char*)lds_raw;
    cg::grid_group grid = cg::this_grid();
#define GSYNC_CG() do { grid.sync(); } while (0)
#define GSYNC() do { int l_; asm volatile("v_mbcnt_lo_u32_b32 %0, -1, 0\n\tv_mbcnt_hi_u32_b32 %0, -1, %0" : "=v"(l_)); xcd_barrier(xbar, wid_s == 0 && l_ == 0); } while (0)
    const int G = gridDim.x, bid = blockIdx.x, NGW = G * 8;
    const int wid_s = __builtin_amdgcn_readfirstlane((int)threadIdx.x >> 6);
    XcdBarrier xbar;
    {
        volatile LAS unsigned* st = (volatile LAS unsigned*)(lds + 139264);
        if (threadIdx.x < 4) st[threadIdx.x] = 0u;
        __syncthreads();
        xbar.bar = (unsigned*)(args.ws + WS_BAR); xbar.x = xb_xcc_id(); xbar.st = st;
        if (threadIdx.x == 0) (void)xb_add(&xbar.bar[XB_XCNT(xbar.x)], 1u);
    }
#define PHASE_IDS int lane_; asm volatile("v_mbcnt_lo_u32_b32 %0, -1, 0\n\tv_mbcnt_hi_u32_b32 %0, -1, %0" : "=v"(lane_)); const int lane = lane_ & 63; const int wid = wid_s; const int tid = wid * 64 + lane; const int gw = bid * 8 + wid; (void)gw;
    unsigned char* ws = args.ws;
    const float* x = args.in[0]; const float* cc = args.in[1]; const float* ada_w = args.in[2]; const float* ada_b = args.in[3];
    const float* norm_mix_g = args.in[4]; const float* norm_ffn_g = args.in[5];
    float* MOD = (float*)(ws + WS_MOD); float* SHW = (float*)(ws + WS_SHW);
    float* SSQ0 = (float*)(ws + WS_SSQ0); float* SSQ1 = (float*)(ws + WS_SSQ1); float* SSQ2 = (float*)(ws + WS_SSQ2); float* SSQ3 = (float*)(ws + WS_SSQ3);
    bf16_t* XG = (bf16_t*)(ws + WS_XG); bf16_t* PB = (bf16_t*)(ws + WS_P); bf16_t* YB = (bf16_t*)(ws + WS_Y); bf16_t* ACT = (bf16_t*)(ws + WS_ACT);
    float* HALO = (float*)(ws + WS_HALO); float* FIXP = (float*)(ws + WS_FIXP); float* FIXU = (float*)(ws + WS_FIXU);
    bf16_t* W_IN0 = (bf16_t*)(ws + WS_W_IN0); bf16_t* W_OUT0 = (bf16_t*)(ws + WS_W_OUT0); bf16_t* W_GU0 = (bf16_t*)(ws + WS_W_GU0); bf16_t* W_DN0 = (bf16_t*)(ws + WS_W_DN0);
    bf16_t* W_IN1 = (bf16_t*)(ws + WS_W_IN1); bf16_t* W_OUT1 = (bf16_t*)(ws + WS_W_OUT1); bf16_t* W_GU1 = (bf16_t*)(ws + WS_W_GU1); bf16_t* W_DN1 = (bf16_t*)(ws + WS_W_DN1);

    for (int item = bid; item < 256; item += G) {
        PHASE_IDS
        const int l = item >> 7, chunk = item & 127;
        LAS float* sl = (LAS float*)lds;
        LAS float* part = (LAS float*)(lds + 65536);
        __syncthreads();
        for (int idx = tid; idx < 16384; idx += 512) { const float v = cc[idx]; sl[idx] = v / (1.0f + __expf(-v)); }
        __syncthreads();
        float acc[16];
#pragma unroll
        for (int bb = 0; bb < 16; ++bb) acc[bb] = 0.f;
        const int colc = chunk * 48 + (lane < 48 ? lane : 47);
        const float* Wp = ada_w + (size_t)l * 1024 * 6144 + colc;
        for (int k = 128 * wid; k < 128 * wid + 128; k += 16) {
            float wv[16];
#pragma unroll
            for (int j = 0; j < 16; ++j) wv[j] = Wp[(size_t)(k + j) * 6144];
#pragma unroll
            for (int j4 = 0; j4 < 4; ++j4)
#pragma unroll
                for (int bb = 0; bb < 16; ++bb) { const f32x4 s4 = *(const LAS f32x4*)(sl + bb * 1024 + k + 4 * j4); acc[bb] += (s4[0] * wv[4 * j4] + s4[1] * wv[4 * j4 + 1]) + (s4[2] * wv[4 * j4 + 2] + s4[3] * wv[4 * j4 + 3]); }
        }
#pragma unroll
        for (int bb = 0; bb < 16; ++bb) part[(wid * 16 + bb) * 64 + lane] = acc[bb];
        __syncthreads();
        for (int o = tid; o < 1024; o += 512) {
            const int bb = o >> 6, cl = o & 63;
            if (cl < 48) {
                float sacc = ada_b[l * 6144 + chunk * 48 + cl];
#pragma unroll
                for (int w8 = 0; w8 < 8; ++w8) sacc += part[(w8 * 16 + bb) * 64 + cl];
                MOD[((size_t)l * 16 + bb) * 6144 + chunk * 48 + cl] = sacc;
            }
        }
        __syncthreads();
    }
    {
        PHASE_IDS
        LAS float* scr = (LAS float*)(lds + wid * 16384);
        constexpr int NITEMS = 1280 + 512 + 3 * 1408 + 768 + 512 + 3 * 1408;
        for (int it = gw; it < NITEMS; it += NGW) {
            int rI = it; const float* W; int N, K; bf16_t* WT; int mapk;
            if (rI < 1280) { W = args.in[6]; N = 2560; K = 1024; WT = W_IN0; mapk = 1; }
            else if ((rI -= 1280) < 512) { W = args.in[16]; N = 1024; K = 1024; WT = W_OUT0; mapk = 0; }
            else if ((rI -= 512) < 1408) { W = args.in[22]; N = FF; K = 1024; WT = W_GU0; mapk = 3; }
            else if ((rI -= 1408) < 1408) { W = args.in[23]; N = FF; K = 1024; WT = W_GU0; mapk = 4; }
            else if ((rI -= 1408) < 1408) { W = args.in[26]; N = 1024; K = FF; WT = W_DN0; mapk = 0; }
            else if ((rI -= 1408) < 768) { W = args.in[17]; N = 1536; K = 1024; WT = W_IN1; mapk = 2; }
            else if ((rI -= 768) < 512) { W = args.in[21]; N = 1024; K = 1024; WT = W_OUT1; mapk = 0; }
            else if ((rI -= 512) < 1408) { W = args.in[22] + (size_t)1024 * FF; N = FF; K = 1024; WT = W_GU1; mapk = 3; }
            else if ((rI -= 1408) < 1408) { W = args.in[23] + (size_t)1024 * FF; N = FF; K = 1024; WT = W_GU1; mapk = 4; }
            else { rI -= 1408; W = args.in[26] + (size_t)FF * 1024; N = 1024; K = FF; WT = W_DN1; mapk = 0; }
            const int nblk = N / 32, kb = rI / nblk, nb = rI % nblk, k0 = 64 * kb, n0 = 32 * nb;
            int d0 = n0;
            if (mapk == 1) { const int region = n0 >> 9; if (region == 2 || region == 3) d0 = headperm(n0); }
            else if (mapk == 2) { if (n0 < 1280) d0 = headperm(n0); }
            else if (mapk == 3) d0 = 256 * (n0 >> 7) + (n0 & 127);
            else if (mapk == 4) d0 = 256 * (n0 >> 7) + 128 + (n0 & 127);
            transpose_item(W, N, WT, K, d0, k0, n0, scr, lane);
        }
    }
    GSYNC_CG();

    {
    PHASE_IDS
    for (int m0 = gw; m0 < M; m0 += 2 * NGW) {
        const int m1 = (m0 + NGW < M) ? m0 + NGW : m0;
        f32x4 v[2][4], gm[2][4];
#pragma unroll
        for (int rr = 0; rr < 2; ++rr) {
            const int m = rr ? m1 : m0; const int bb = m >> 11;
            const f32x4* xr = (const f32x4*)(x + (size_t)m * 1024) + lane;
            const f32x4* gp = (const f32x4*)norm_mix_g + lane;
            const f32x4* sp = (const f32x4*)(MOD + (size_t)bb * 6144 + 1024) + lane;
#pragma unroll
            for (int j = 0; j < 4; ++j) { v[rr][j] = xr[64 * j]; gm[rr][j] = gp[64 * j] * (sp[64 * j] + 1.0f); }
        }
#pragma unroll
        for (int rr = 0; rr < 2; ++rr) {
            const int m = rr ? m1 : m0;
            u32x2* op = (u32x2*)(XG + (size_t)m * 1024) + lane;
            float sacc = 0.f;
#pragma unroll
            for (int j = 0; j < 4; ++j) {
                const f32x4 q = v[rr][j] * v[rr][j]; sacc += (q[0] + q[1]) + (q[2] + q[3]);
                const f32x4 o = v[rr][j] * gm[rr][j]; u32x2 w; w.x = pk2(o[0], o[1]); w.y = pk2(o[2], o[3]); op[64 * j] = w;
            }
            sacc = wave_sum(sacc);
            if (lane == 0) SSQ0[m] = sacc;
        }
    }
    for (int gi = 0; gi < 4; ++gi) {
        const bf16_t* Wt; int N; const float* shp; float* outp;
        if (gi == 0) { Wt = W_IN0; N = 2560; shp = MOD; outp = SHW + SHW_IN0; }
        else if (gi == 1) { Wt = W_GU0; N = 5632; shp = MOD + 3 * 1024; outp = SHW + SHW_GU0; }
        else if (gi == 2) { Wt = W_IN1; N = 1536; shp = MOD + (size_t)16 * 6144; outp = SHW + SHW_IN1; }
        else { Wt = W_GU1; N = 5632; shp = MOD + (size_t)16 * 6144 + 3 * 1024; outp = SHW + SHW_GU1; }
        LAS float* shl = (LAS float*)lds;
        __syncthreads();
        for (int idx = tid; idx < 16384; idx += 512) shl[idx] = shp[(size_t)(idx >> 10) * 6144 + (idx & 1023)];
        __syncthreads();
        for (int p = gw; p < N; p += NGW) {
            asm volatile("" ::: "memory");
            const u32x4 r0 = *(const u32x4*)(Wt + (size_t)p * 1024 + 8 * lane), r1 = *(const u32x4*)(Wt + (size_t)p * 1024 + 512 + 8 * lane);
            float wv[16];
            wv[0] = bflo(r0.x); wv[1] = bfhi(r0.x); wv[2] = bflo(r0.y); wv[3] = bfhi(r0.y); wv[4] = bflo(r0.z); wv[5] = bfhi(r0.z); wv[6] = bflo(r0.w); wv[7] = bfhi(r0.w);
            wv[8] = bflo(r1.x); wv[9] = bfhi(r1.x); wv[10] = bflo(r1.y); wv[11] = bfhi(r1.y); wv[12] = bflo(r1.z); wv[13] = bfhi(r1.z); wv[14] = bflo(r1.w); wv[15] = bfhi(r1.w);
            float d[16];
#pragma unroll
            for (int bb = 0; bb < 16; ++bb) {
                const LAS float* sb_ = shl + bb * 1024 + 8 * lane;
                const f32x4 s0 = *(const LAS f32x4*)(sb_), s1 = *(const LAS f32x4*)(sb_ + 4), s2 = *(const LAS f32x4*)(sb_ + 512), s3 = *(const LAS f32x4*)(sb_ + 516);
                d[bb] = (wv[0] * s0[0] + wv[1] * s0[1]) + (wv[2] * s0[2] + wv[3] * s0[3]) + (wv[4] * s1[0] + wv[5] * s1[1]) + (wv[6] * s1[2] + wv[7] * s1[3])
                      + (wv[8] * s2[0] + wv[9] * s2[1]) + (wv[10] * s2[2] + wv[11] * s2[3]) + (wv[12] * s3[0] + wv[13] * s3[1]) + (wv[14] * s3[2] + wv[15] * s3[3]);
            }
            const bool h5 = (lane & 32) != 0, h4 = (lane & 16) != 0, h3 = (lane & 8) != 0, h2 = (lane & 4) != 0;
            float e8[8], e4[4], e2[2];
#pragma unroll
            for (int j = 0; j < 8; ++j) { const float snd = h5 ? d[j] : d[j + 8], kp = h5 ? d[j + 8] : d[j]; e8[j] = kp + __shfl_xor(snd, 32); }
#pragma unroll
            for (int j = 0; j < 4; ++j) { const float snd = h4 ? e8[j] : e8[j + 4], kp = h4 ? e8[j + 4] : e8[j]; e4[j] = kp + __shfl_xor(snd, 16); }
#pragma unroll
            for (int j = 0; j < 2; ++j) { const float snd = h3 ? e4[j] : e4[j + 2], kp = h3 ? e4[j + 2] : e4[j]; e2[j] = kp + __shfl_xor(snd, 8); }
            float tot; { const float snd = h2 ? e2[0] : e2[1], kp = h2 ? e2[1] : e2[0]; tot = kp + __shfl_xor(snd, 4); }
            tot += __shfl_xor(tot, 2); tot += __shfl_xor(tot, 1);
            const int bsel = (h5 ? 8 : 0) + (h4 ? 4 : 0) + (h3 ? 2 : 0) + (h2 ? 1 : 0);
            if ((lane & 3) == 0) outp[(size_t)bsel * N + p] = tot;
        }
    }
    }
    GSYNC();

    pg8::StaticOrder S;
    {
        PHASE_IDS
        pg8::Gemm g{XG, W_IN0, M, 2560, 1024}; S.init(M, 2560, G, bid);
        EpiIn<0> E{SSQ0, SHW + SHW_IN0, 2560, PB, args.in[14], args.in[15]};
        pg8::gemm_phase<EpiIn<0>>(lds, g, S, E, tid);
    }
    GSYNC();

    {
        const bf16_t* XR = PB; const bf16_t* GR = PB + (size_t)M * 512; const bf16_t* Qb = PB + (size_t)2 * M * 512; const bf16_t* Kb = PB + (size_t)3 * M * 512; const bf16_t* Vb = PB + (size_t)4 * M * 512;
        PHASE_IDS
        LruArgs LA{XR, GR, YB, args.in[7], args.in[8], args.in[9], args.in[10], args.in[11], args.in[12], args.in[13]};
        for (int rep = 0; rep < ((DUP_MASK & 1) ? 2 : 1); ++rep) {
        for (int item = bid; item < 256; item += G) lru_item(lds, LA, item, tid, wid, lane);
        for (int u = bid; u < 1024; u += G) {
            const int rr = u >> 8, i = u & 255, hi = i >> 7, bh = i & 127;
            int qb;
            if (rr == 0) qb = hi ? 6 : 7; else if (rr == 1) qb = hi ? 5 : 4; else if (rr == 2) qb = hi ? 2 : 3; else qb = hi ? 1 : 0;
            sb_unit(lds, Qb, Kb, Vb, YB, bh >> 3, bh & 7, qb, tid, wid, lane);
        }
        }
    }
    GSYNC();

    {
        PHASE_IDS
        pg8::Gemm g{YB, W_OUT0, M, 1024, 1024}; S.init(M, 1024, G, bid);
        EpiRes<false> E{x, args.out, MOD + 2 * 1024, norm_ffn_g, MOD + 4 * 1024, XG, SSQ1};
        pg8::gemm_phase<EpiRes<false>>(lds, g, S, E, tid);
    }
    GSYNC();

    for (int layer = 0; layer < 2; ++layer) {
        if (layer == 1) {
            {
                PHASE_IDS
                pg8::Gemm g{XG, W_IN1, M, 1536, 1024}; S.init(M, 1536, G, bid);
                EpiIn<1> E{SSQ2, SHW + SHW_IN1, 1536, PB, args.in[18], args.in[19]};
                pg8::gemm_phase<EpiIn<1>>(lds, g, S, E, tid);
            }
            GSYNC();
            {
                const bf16_t* Qb = PB; const bf16_t* Kb = PB + (size_t)M * 1024; const bf16_t* Vb = Kb + (size_t)M * 256;
                PHASE_IDS
                for (int u = bid; u < 2048; u += G) { const int qc = u & 31, kvh = (u >> 5) & 3, bb = u >> 7; swa_unit(lds, Qb, Kb, Vb, args.in[20], YB, bb, kvh, qc, tid, wid, lane); }
            }
            GSYNC();
            {
                PHASE_IDS
                pg8::Gemm g{YB, W_OUT1, M, 1024, 1024}; S.init(M, 1024, G, bid);
                EpiRes<false> E{args.out, args.out, MOD + (size_t)16 * 6144 + 2 * 1024, norm_ffn_g + 1024, MOD + (size_t)16 * 6144 + 4 * 1024, XG, SSQ3};
                pg8::gemm_phase<EpiRes<false>>(lds, g, S, E, tid);
            }
            GSYNC();
        }
        {
            PHASE_IDS
            pg8::Gemm g{XG, layer ? W_GU1 : W_GU0, M, 5632, 1024}; S.init(M, 5632, G, bid);
            EpiGU E{layer ? SSQ3 : SSQ1, SHW + (layer ? SHW_GU1 : SHW_GU0), args.in[24] + (size_t)layer * 3 * FF, args.in[25] + (size_t)layer * FF, ACT, HALO, FIXP, FIXU};
            for (int rep = 0; rep < ((DUP_MASK & 2) ? 2 : 1); ++rep) pg8::gemm_phase<EpiGU>(lds, g, S, E, tid);
        }
        GSYNC();
        {
            PHASE_IDS
            const float* cw = args.in[24] + (size_t)layer * 3 * FF;
            for (int idx = bid * 512 + tid; idx < 512 * 2 * 704; idx += G * 512) {
                const int c4 = idx % 704, sr = idx / 704, s = sr & 1, gs = sr >> 1;
                const size_t fo = ((size_t)gs * 2 + s) * FF + 4 * c4;
                f32x4 a = *(const f32x4*)(FIXP + fo); const f32x4 up = *(const f32x4*)(FIXU + fo);
                if ((gs & 31) != 0) {
                    const f32x4 h1 = *(const f32x4*)(HALO + ((size_t)(gs - 1) * 2 + 1) * FF + 4 * c4);
                    const f32x4 w0 = *(const f32x4*)(cw + 4 * c4);
                    if (s == 0) { const f32x4 h2 = *(const f32x4*)(HALO + ((size_t)(gs - 1) * 2) * FF + 4 * c4); const f32x4 w1 = *(const f32x4*)(cw + FF + 4 * c4); a = a + w1 * h1 + w0 * h2; }
                    else a = a + w0 * h1;
                }
                const f32x4 o = silu4(a) * up; u32x2 w; w.x = pk2(o[0], o[1]); w.y = pk2(o[2], o[3]);
                *(u32x2*)(ACT + (size_t)(gs * 64 + s) * FF + 4 * c4) = w;
            }
        }
        GSYNC();
        if (layer == 0) {
            PHASE_IDS
            pg8::Gemm g{ACT, W_DN0, M, 1024, FF}; S.init(M, 1024, G, bid);
            EpiRes<false> E{args.out, args.out, MOD + 5 * 1024, norm_mix_g + 1024, MOD + (size_t)16 * 6144 + 1 * 1024, XG, SSQ2};
            pg8::gemm_phase<EpiRes<false>>(lds, g, S, E, tid);
            GSYNC();
        } else {
            PHASE_IDS
            pg8::Gemm g{ACT, W_DN1, M, 1024, FF}; S.init(M, 1024, G, bid);
            EpiRes<true> E{args.out, args.out, MOD + (size_t)16 * 6144 + 5 * 1024, nullptr, nullptr, nullptr, nullptr};
            pg8::gemm_phase<EpiRes<true>>(lds, g, S, E, tid);
        }
    }
}

extern "C" void kernel_launch(void* const* d_in, const int* in_sizes, int n_in, void* d_out, int out_size, void* d_ws, size_t ws_size, hipStream_t stream) {
    static int grid = 0;
    if (grid == 0) {
        if (n_in != 27 || out_size != M * DM || ws_size < WS_END) { fprintf(stderr, "kernel_launch: unexpected shapes (n_in %d out %d ws %zu)\n", n_in, out_size, ws_size); grid = -1; return; }
        int dev = 0, cus = 0, per_cu = 0;
        (void)hipGetDevice(&dev);
        (void)hipDeviceGetAttribute(&cus, hipDeviceAttributeMultiprocessorCount, dev);
        (void)hipFuncSetAttribute((const void*)fwd_mega, hipFuncAttributeMaxDynamicSharedMemorySize, LDS_BYTES);
        (void)hipOccupancyMaxActiveBlocksPerMultiprocessor(&per_cu, (const void*)fwd_mega, 512, LDS_BYTES);
        (void)hipGetLastError();
        grid = cus;
        if (per_cu < 1) fprintf(stderr, "kernel_launch: occupancy query says %d blocks/CU\n", per_cu);
    }
    if (grid < 0) return;
    (void)hipMemsetAsync(d_ws, 0, WS_ZERO_BYTES, stream);
    Args a{};
    for (int i = 0; i < 27; ++i) a.in[i] = (const float*)d_in[i];
    a.out = (float*)d_out; a.ws = (unsigned char*)d_ws;
    void* kargs[] = {&a};
    hipError_t e = hipLaunchCooperativeKernel((const void*)fwd_mega, dim3(grid), dim3(512), kargs, LDS_BYTES, stream);
    if (e != hipSuccess) fprintf(stderr, "cooperative launch failed: %s (grid %d)\n", hipGetErrorString(e), grid);
}
```

```cpp
#include <hip/hip_runtime.h>
#include <hip/hip_cooperative_groups.h>
#include <cstdio>
#include <cstdint>
namespace cg = cooperative_groups;

#define LAS __attribute__((address_space(3)))
typedef unsigned short bf16_t;
typedef short bf16x8 __attribute__((ext_vector_type(8)));
typedef short s16x4 __attribute__((ext_vector_type(4)));
typedef float f32x4 __attribute__((ext_vector_type(4)));
typedef float f32x2 __attribute__((ext_vector_type(2)));
typedef float f32x16 __attribute__((ext_vector_type(16)));
typedef unsigned u32x4 __attribute__((ext_vector_type(4)));
typedef unsigned u32x2 __attribute__((ext_vector_type(2)));
typedef __bf16 bf2_t __attribute__((ext_vector_type(2)));

__device__ __forceinline__ unsigned pk2(float lo, float hi) { f32x2 v = {lo, hi}; bf2_t r = __builtin_convertvector(v, bf2_t); return __builtin_bit_cast(unsigned, r); }
__device__ __forceinline__ float bflo(unsigned u) { return __uint_as_float(u << 16); }
__device__ __forceinline__ float bfhi(unsigned u) { return __uint_as_float(u & 0xffff0000u); }
#define LDS_WAIT() asm volatile("s_waitcnt lgkmcnt(0)" ::: "memory")
__device__ __forceinline__ float sx(float v, int mask, int lane) { return __int_as_float(__builtin_amdgcn_ds_bpermute((lane ^ mask) << 2, __float_as_int(v))); }

constexpr int NB = 16, SEQ = 2048, DM = 1024, M = NB * SEQ, FF = 2816;
constexpr float EPS = 1e-6f;
constexpr float LOG2E = 1.4426950408889634f;
constexpr float QSCALE = 0.125f * LOG2E;

constexpr size_t MiB = 1u << 20;
constexpr size_t WS_SSQ1 = 0, WS_SSQ2 = 128 * 1024, WS_SSQ3 = 256 * 1024, WS_ZERO_BYTES = 512 * 1024;
constexpr size_t WS_BAR = 384 * 1024;
constexpr size_t WS_SSQ0 = 512 * 1024;
constexpr size_t WS_MOD = 1 * MiB;
constexpr size_t WS_SHW = 2 * MiB;
constexpr size_t SHW_IN0 = 0, SHW_GU0 = 16 * 2560, SHW_IN1 = SHW_GU0 + 16 * 5632, SHW_GU1 = SHW_IN1 + 16 * 1536;
constexpr size_t WS_HALO = 3 * MiB, WS_FIXP = 15 * MiB, WS_FIXU = 27 * MiB;
constexpr size_t WS_W_IN0 = 40 * MiB, WS_W_OUT0 = 45 * MiB, WS_W_GU0 = 47 * MiB, WS_W_DN0 = 58 * MiB;
constexpr size_t WS_W_IN1 = 64 * MiB, WS_W_OUT1 = 67 * MiB, WS_W_GU1 = 69 * MiB, WS_W_DN1 = 80 * MiB;
constexpr size_t WS_XG = 96 * MiB;
constexpr size_t WS_P = 160 * MiB;
constexpr size_t WS_Y = 320 * MiB;
constexpr size_t WS_ACT = 160 * MiB;
constexpr size_t WS_XS = 384 * MiB;
constexpr size_t WS_END = 448 * MiB;

constexpr int LDS_BYTES = 147456;
#ifndef DUP_MASK
#define DUP_MASK 0
#endif

namespace pg8 {
constexpr int BM = 256, BK = 64, HALF = 128, HTB = HALF * BK * 2, STAGE_BYTES = 8 * HTB, NXCD = 8, WGM = 8;
__host__ __device__ __forceinline__ int lds_byte(int r, int c) { const int st = (r >> 4) * 2 + (c >> 5), rr = r & 15, cc = c & 31, ob = rr * 64 + cc * 2; return st * 1024 + (ob ^ (((ob >> 9) & 1) << 5)); }
__host__ __device__ __forceinline__ void stage_rc(int b, int& R, int& C) { const int st = b / 1024, sb = b % 1024, swz = sb ^ (((sb >> 9) & 1) << 5); R = (st >> 1) * 16 + swz / 64; C = (st & 1) * 32 + (swz % 64) / 2; }
struct Unit { int pm, pn; };
struct Gemm { const bf16_t* A; const bf16_t* Bt; int M, N, K; };
struct StaticOrder {
    int nM, nN, nwg, G, c;
    __host__ __device__ void init(int M_, int N_, int G_, int c_) { nM = M_ / BM; nN = N_ / BM; nwg = nM * nN; G = G_; c = c_; }
    __host__ __device__ bool next(int i, Unit& u) const {
        const long L = (long)i * G + c; if (L >= nwg) return false;
        int wgid = (int)L; { const int q = nwg / NXCD, r = nwg % NXCD, xcd = wgid % NXCD, off = wgid / NXCD; wgid = (xcd < r ? xcd * (q + 1) : r * (q + 1) + (xcd - r) * q) + off; }
        const int nig = WGM * nN, gid = wgid / nig, fm = gid * WGM, gsz = (nM - fm) < WGM ? (nM - fm) : WGM;
        u.pm = fm + ((wgid % nig) % gsz); u.pn = (wgid % nig) / gsz; return true;
    }
};

template <class Epi, bool ALIGN_EPI = true, bool SP2 = true>
__device__ __forceinline__ void gemm_phase(LAS unsigned char* lds, const Gemm g, const StaticOrder& S, const Epi& E, const int tid) {
    const int wid = __builtin_amdgcn_readfirstlane(tid >> 6), lane = tid & 63, wr = wid >> 2, wc = wid & 3, fr = lane & 15, fq = lane >> 4;
    const int K = g.K, nt = K / BK;
    unsigned voffA[2];
#pragma unroll
    for (int i = 0; i < 2; ++i) { int R, C; stage_rc(tid * 16 + i * 8192, R, C); voffA[i] = (unsigned)(R * K + C) * 2u; }
    const size_t kstep = (size_t)(BK * 2);
    const size_t hstep = (size_t)HALF * K * 2;
    const size_t tstep = 2 * hstep;
    const unsigned ldsw = (unsigned)wid * 1024u;
    const int aoff = lds_byte(wr * 64 + fr, fq * 8), boff = lds_byte(wc * 32 + fr, fq * 8);
#define PG8_SA(b, h) (((b) * 2 + (h)) * HTB)
#define PG8_SB(b, h) ((4 + (b) * 2 + (h)) * HTB)
#define PG8_STAGE(bufoff, gbase, voff) do { _Pragma("unroll") for (int _i = 0; _i < 2; ++_i) \
        __builtin_amdgcn_global_load_lds((const unsigned*)((const char*)(gbase) + (voff)[_i]), (LAS unsigned*)(lds + (bufoff) + ldsw + _i * 8192), 16, 0, 0); } while (0)
#define PG8_LDA(dst, b, h) do { _Pragma("unroll") for (int m = 0; m < 4; ++m) _Pragma("unroll") for (int k = 0; k < 2; ++k) dst[m][k] = *(const LAS bf16x8*)(lds + PG8_SA(b, h) + aoff + m * 2048 + k * 1024); } while (0)
#define PG8_LDB(dst, b, h) do { _Pragma("unroll") for (int n = 0; n < 2; ++n) _Pragma("unroll") for (int k = 0; k < 2; ++k) dst[n][k] = *(const LAS bf16x8*)(lds + PG8_SB(b, h) + boff + n * 2048 + k * 1024); } while (0)
#define PG8_MMA(ai, bj, At, Bt) do { __builtin_amdgcn_s_setprio(1); _Pragma("unroll") for (int m = 0; m < 4; ++m) _Pragma("unroll") for (int n = 0; n < 2; ++n) _Pragma("unroll") for (int k = 0; k < 2; ++k) \
        acc[ai][bj][m][n] = __builtin_amdgcn_mfma_f32_16x16x32_bf16(Bt[n][k], At[m][k], acc[ai][bj][m][n], 0, 0, 0); __builtin_amdgcn_s_setprio(0); } while (0)
#define PG8_WAIT_V(n) asm volatile("s_waitcnt vmcnt(" #n ")" ::: "memory")
#define PG8_WAIT_L(n) asm volatile("s_waitcnt lgkmcnt(" #n ")" ::: "memory")
#define PG8_BAR __builtin_amdgcn_s_barrier()
#define PG8_SCHED __builtin_amdgcn_sched_barrier(0)
    Unit cur, nxt; int ui = 0;
    if (!S.next(0, cur)) return;
    f32x4 acc[2][2][4][2];
#pragma unroll
    for (int a = 0; a < 2; ++a)
#pragma unroll
        for (int b = 0; b < 2; ++b)
#pragma unroll
            for (int m = 0; m < 4; ++m)
#pragma unroll
                for (int n = 0; n < 2; ++n) acc[a][b][m][n] = (f32x4){0.f, 0.f, 0.f, 0.f};
    bf16x8 At[4][2], B0[2][2], B1[2][2];
    const char* cA = (const char*)g.A + (size_t)cur.pm * tstep; const char* cB = (const char*)g.Bt + (size_t)cur.pn * tstep;
    {
        PG8_STAGE(PG8_SB(0, 0), cB, voffA); PG8_STAGE(PG8_SB(0, 1), cB + hstep, voffA); PG8_STAGE(PG8_SA(0, 0), cA, voffA); PG8_STAGE(PG8_SA(0, 1), cA + hstep, voffA);
        if (wr == 1) PG8_BAR;
        PG8_WAIT_V(2); PG8_BAR;
        PG8_STAGE(PG8_SB(1, 0), cB + kstep, voffA); PG8_STAGE(PG8_SA(1, 0), cA + kstep, voffA); PG8_STAGE(PG8_SB(1, 1), cB + hstep + kstep, voffA);
        PG8_WAIT_V(6); PG8_BAR;
    }
    for (;;) {
        const bool has_next = S.next(ui + 1, nxt);
        const char* nA = has_next ? (const char*)g.A + (size_t)nxt.pm * tstep : cA; const char* nB = has_next ? (const char*)g.Bt + (size_t)nxt.pn * tstep : cB;
        for (int t = 0; t < nt; t += 2) {
            const bool last = (t == nt - 2);
            const char* a1 = cA + (size_t)(t + 1) * kstep;
            const char* a2 = last ? nA : cA + (size_t)(t + 2) * kstep; const char* b2 = last ? nB : cB + (size_t)(t + 2) * kstep;
            const char* a3 = a2 + kstep; const char* b3 = b2 + kstep;
            PG8_LDB(B0, 0, 0); PG8_LDB(B1, 0, 1); PG8_SCHED; PG8_LDA(At, 0, 0); PG8_STAGE(PG8_SA(1, 1), a1 + hstep, voffA);
            PG8_WAIT_V(8); PG8_WAIT_L(0); PG8_BAR; PG8_MMA(0, 0, At, B0); PG8_MMA(0, 1, At, B1); PG8_BAR; PG8_SCHED;
            PG8_LDA(At, 0, 1); PG8_STAGE(PG8_SB(0, 0), b2, voffA); PG8_STAGE(PG8_SB(0, 1), b2 + hstep, voffA); PG8_STAGE(PG8_SA(0, 0), a2, voffA);
            PG8_WAIT_V(8); PG8_WAIT_L(0); PG8_BAR; PG8_MMA(1, 0, At, B0); PG8_MMA(1, 1, At, B1); PG8_BAR; PG8_SCHED;
            PG8_LDB(B0, 1, 0); PG8_LDB(B1, 1, 1); PG8_SCHED; PG8_LDA(At, 1, 0); PG8_STAGE(PG8_SA(0, 1), a2 + hstep, voffA);
            PG8_WAIT_V(8); PG8_WAIT_L(0); PG8_BAR; PG8_MMA(0, 0, At, B0); PG8_MMA(0, 1, At, B1); PG8_BAR; PG8_SCHED;
            PG8_LDA(At, 1, 1); PG8_STAGE(PG8_SB(1, 0), b3, voffA); PG8_STAGE(PG8_SB(1, 1), b3 + hstep, voffA); PG8_STAGE(PG8_SA(1, 0), a3, voffA);
            PG8_WAIT_V(8); PG8_WAIT_L(0); PG8_BAR; PG8_MMA(1, 0, At, B0); PG8_MMA(1, 1, At, B1); PG8_BAR; PG8_SCHED;
        }
        if constexpr (ALIGN_EPI) { if (wr == 0) PG8_BAR; }
        E(acc, cur, wr, wc, fr, fq);
        if (!has_next) break;
#pragma unroll
        for (int a = 0; a < 2; ++a)
#pragma unroll
            for (int b = 0; b < 2; ++b)
#pragma unroll
                for (int m = 0; m < 4; ++m)
#pragma unroll
                    for (int n = 0; n < 2; ++n) acc[a][b][m][n] = (f32x4){0.f, 0.f, 0.f, 0.f};
        cur = nxt; cA = nA; cB = nB; ++ui;
        if constexpr (ALIGN_EPI) { if (wr == 1) PG8_BAR; }
    }
    PG8_WAIT_V(0);
    if constexpr (!ALIGN_EPI) { if (wr == 0) PG8_BAR; }
    PG8_BAR;
#undef PG8_SA
#undef PG8_SB
#undef PG8_STAGE
#undef PG8_LDA
#undef PG8_LDB
#undef PG8_MMA
#undef PG8_WAIT_V
#undef PG8_WAIT_L
#undef PG8_BAR
#undef PG8_SCHED
}
}
using pg8::Unit;


#define GLD4(base, boff) (*(const f32x4*)((const char*)(base) + (unsigned)(boff)))
#define GST4(base, boff, v) (*(f32x4*)((char*)(base) + (unsigned)(boff)) = (v))
#define GST2(base, boff, v) (*(u32x2*)((char*)(base) + (unsigned)(boff)) = (v))
#define GLD1(base, boff) (*(const float*)((const char*)(base) + (unsigned)(boff)))

template <int LAYER> struct EpiIn {
    const float* ssq; const float* shw; int N; bf16_t* P; const float* gq; const float* gk;
    __device__ __forceinline__ void operator()(const f32x4 (&acc)[2][2][4][2], const Unit& u, int wr, int wc, int fr_in, int fq_in) const {
        int fr = fr_in, fq = fq_in; asm volatile("" : "+v"(fr), "+v"(fq));
        const int b = u.pm >> 3; const int lane_e = fq * 16 + fr;
        bf16_t* base; int ld, col0, mode;
        if (LAYER == 0) { const int region = u.pn >> 1; base = P + (size_t)region * M * 512; ld = 512; col0 = (u.pn & 1) * 256; mode = region == 2 ? 1 : (region == 3 ? 2 : 0); }
        else {
            if (u.pn < 4) { base = P; ld = 1024; col0 = u.pn * 256; mode = 1; }
            else if (u.pn == 4) { base = P + (size_t)M * 1024; ld = 256; col0 = 0; mode = 2; }
            else { base = P + (size_t)M * 1024 + (size_t)M * 256; ld = 256; col0 = 0; mode = 0; }
        }
        const float* bias = shw + (size_t)b * N + u.pn * 256;
        const unsigned boff = (unsigned)(wc * 32 + 4 * fq) * 4u;
        f32x4 bv[2][2];
#pragma unroll
        for (int bj = 0; bj < 2; ++bj)
#pragma unroll
            for (int n = 0; n < 2; ++n) bv[bj][n] = GLD4(bias, boff + (bj * 128 + n * 16) * 4);
        const int row0 = u.pm * 256 + wr * 64 + fr;
        float rsv[2][4];
#pragma unroll
        for (int ai = 0; ai < 2; ++ai)
#pragma unroll
            for (int m = 0; m < 4; ++m) rsv[ai][m] = GLD1(ssq, (unsigned)row0 * 4u + (ai * 128 + m * 16) * 4);
#pragma unroll
        for (int ai = 0; ai < 2; ++ai)
#pragma unroll
            for (int m = 0; m < 4; ++m) rsv[ai][m] = rsqrtf(rsv[ai][m] * (1.0f / 1024.0f) + EPS);
        const unsigned ldb = (unsigned)ld * 2u;
        if (mode == 0) {
            const unsigned o0 = (unsigned)row0 * ldb + (unsigned)(col0 + wc * 32 + 4 * fq) * 2u;
#pragma unroll
            for (int ai = 0; ai < 2; ++ai)
#pragma unroll
                for (int m = 0; m < 4; ++m) {
                    const float rs = rsv[ai][m];
                    const unsigned ro = o0 + (unsigned)(ai * 128 + m * 16) * ldb;
#pragma unroll
                    for (int bj = 0; bj < 2; ++bj)
#pragma unroll
                        for (int n = 0; n < 2; ++n) { const f32x4 v = acc[ai][bj][m][n] * rs + bv[bj][n]; u32x2 w; w.x = pk2(v[0], v[1]); w.y = pk2(v[2], v[3]); GST2(base, ro + (bj * 128 + n * 16) * 2, w); }
                }
        } else {
            const float* gn = (mode == 1) ? gq : gk; const float sc = (mode == 1) ? QSCALE : 1.0f;
            f32x4 gv[2][2];
#pragma unroll
            for (int bj = 0; bj < 2; ++bj)
#pragma unroll
                for (int n = 0; n < 2; ++n) gv[bj][n] = GLD4(gn, (unsigned)(4 * fq) * 4u + (32 * bj + 16 * n) * 4) * sc;
            const unsigned o0 = (unsigned)row0 * ldb + (unsigned)(col0 + 64 * wc + 4 * fq) * 2u;
#pragma unroll
            for (int ai = 0; ai < 2; ++ai)
#pragma unroll
                for (int m = 0; m < 4; ++m) {
                    const float rs = rsv[ai][m];
                    f32x4 v[2][2]; float ss = 0.f;
#pragma unroll
                    for (int bj = 0; bj < 2; ++bj)
#pragma unroll
                        for (int n = 0; n < 2; ++n) { v[bj][n] = acc[ai][bj][m][n] * rs + bv[bj][n]; const f32x4 q = v[bj][n] * v[bj][n]; ss += (q[0] + q[1]) + (q[2] + q[3]); }
                    ss += sx(ss, 16, lane_e); ss += sx(ss, 32, lane_e);
                    const float hr = rsqrtf(ss * (1.0f / 64.0f) + EPS);
                    const unsigned ro = o0 + (unsigned)(ai * 128 + m * 16) * ldb;
#pragma unroll
                    for (int bj = 0; bj < 2; ++bj)
#pragma unroll
                        for (int n = 0; n < 2; ++n) { const f32x4 o = v[bj][n] * hr * gv[bj][n]; u32x2 w; w.x = pk2(o[0], o[1]); w.y = pk2(o[2], o[3]); GST2(base, ro + (32 * bj + 16 * n) * 2, w); }
                }
        }
    }
};

#define GLD2(base, boff) (*(const u32x2*)((const char*)(base) + (unsigned)(boff)))
template <bool IN_F32, bool OUT_F32, bool LAST> struct EpiRes {
    const void* xin; void* xout; const float* gate; const float* ng; const float* nsc; bf16_t* xg; float* ssq;
    __device__ __forceinline__ void operator()(const f32x4 (&acc)[2][2][4][2], const Unit& u, int wr, int wc, int fr_in, int fq_in) const {
        int fr = fr_in, fq = fq_in; asm volatile("" : "+v"(fr), "+v"(fq));
        const int b = u.pm >> 3; const int lane_e = fq * 16 + fr; (void)lane_e;
        const int col = u.pn * 256 + wc * 32 + 4 * fq;
        const float* gtp = gate + (size_t)b * 6144; const float* nsp = LAST ? gate : nsc + (size_t)b * 6144;
        f32x4 gt[2][2], gm[2][2];
#pragma unroll
        for (int bj = 0; bj < 2; ++bj)
#pragma unroll
            for (int n = 0; n < 2; ++n) {
                const unsigned co = (unsigned)col * 4u + (bj * 128 + n * 16) * 4;
                gt[bj][n] = GLD4(gtp, co);
                if (!LAST) gm[bj][n] = GLD4(ng, co) * (GLD4(nsp, co) + 1.0f);
            }
        const int row0 = u.pm * 256 + wr * 64 + fr;
        const unsigned e0 = (unsigned)row0 * 1024u + (unsigned)col;
#pragma unroll
        for (int hb = 0; hb < 4; ++hb) {
            const int ai = hb >> 1;
            f32x4 xi[2][2][2];
#pragma unroll
            for (int mm = 0; mm < 2; ++mm)
#pragma unroll
                for (int bj = 0; bj < 2; ++bj)
#pragma unroll
                    for (int n = 0; n < 2; ++n) {
                        const unsigned eo = e0 + (unsigned)((ai * 128 + ((hb & 1) * 2 + mm) * 16) * 1024 + bj * 128 + n * 16);
                        if (IN_F32) xi[mm][bj][n] = GLD4(xin, eo * 4u);
                        else { const u32x2 r2 = GLD2(xin, eo * 2u); xi[mm][bj][n] = (f32x4){bflo(r2.x), bfhi(r2.x), bflo(r2.y), bfhi(r2.y)}; }
                    }
#pragma unroll
            for (int mm = 0; mm < 2; ++mm) {
                const int m = (hb & 1) * 2 + mm;
                const unsigned ro = e0 + (unsigned)((ai * 128 + m * 16) * 1024);
                float s = 0.f;
#pragma unroll
                for (int bj = 0; bj < 2; ++bj)
#pragma unroll
                    for (int n = 0; n < 2; ++n) {
                        const f32x4 v = xi[mm][bj][n] + gt[bj][n] * acc[ai][bj][m][n];
                        const unsigned eo = ro + (unsigned)(bj * 128 + n * 16);
                        if (OUT_F32) GST4(xout, eo * 4u, v);
                        else { u32x2 w; w.x = pk2(v[0], v[1]); w.y = pk2(v[2], v[3]); GST2(xout, eo * 2u, w); }
                        if (!LAST) {
                            const f32x4 q = v * v; s += (q[0] + q[1]) + (q[2] + q[3]);
                            const f32x4 o = v * gm[bj][n]; u32x2 w; w.x = pk2(o[0], o[1]); w.y = pk2(o[2], o[3]); GST2(xg, eo * 2u, w);
                        }
                    }
                if (!LAST) { s += sx(s, 16, lane_e); s += sx(s, 32, lane_e); if (fq == 0) unsafeAtomicAdd(ssq + (row0 + ai * 128 + m * 16), s); }
            }
        }
    }
};

__device__ __forceinline__ f32x4 silu4(f32x4 a) {
    f32x4 r;
#pragma unroll
    for (int e = 0; e < 4; ++e) r[e] = a[e] * __builtin_amdgcn_rcpf(1.0f + __builtin_amdgcn_exp2f(-a[e] * LOG2E));
    return r;
}
template <int N_> __device__ __forceinline__ f32x4 ror4(f32x4 v) {
    f32x4 r;
#pragma unroll
    for (int e = 0; e < 4; ++e) r[e] = __int_as_float(__builtin_amdgcn_update_dpp(0, __float_as_int(v[e]), 0x120 + N_, 0xf, 0xf, false));
    return r;
}
struct EpiGU {
    const float* ssq; const float* shw; const float* cw; const float* cbias; bf16_t* act; float* halo; float* fixp; float* fixu;
    __device__ __forceinline__ void operator()(const f32x4 (&acc)[2][2][4][2], const Unit& u, int wr, int wc, int fr_in, int fq_in) const {
        int fr = fr_in, fq = fq_in; asm volatile("" : "+v"(fr), "+v"(fq));
        const int b = u.pm >> 3;
        const int fcol = u.pn * 128 + wc * 32 + 4 * fq;
        const float* bias = shw + (size_t)b * 5632 + u.pn * 256;
        const unsigned boff = (unsigned)(wc * 32 + 4 * fq) * 4u;
        const int row0 = u.pm * 256 + wr * 64 + fr;
        float rsv[2][4];
#pragma unroll
        for (int ai = 0; ai < 2; ++ai)
#pragma unroll
            for (int m = 0; m < 4; ++m) rsv[ai][m] = GLD1(ssq, (unsigned)row0 * 4u + (ai * 128 + m * 16) * 4);
#pragma unroll
        for (int ai = 0; ai < 2; ++ai)
#pragma unroll
            for (int m = 0; m < 4; ++m) rsv[ai][m] = rsqrtf(rsv[ai][m] * (1.0f / 1024.0f) + EPS);
        const unsigned aoff0 = ((unsigned)row0 * (unsigned)FF + (unsigned)fcol) * 2u;
#pragma unroll
        for (int n = 0; n < 2; ++n) {
            const f32x4 bg = GLD4(bias, boff + n * 64), bu = GLD4(bias, boff + 512 + n * 64);
            const unsigned co = (unsigned)fcol * 4u + n * 64;
            const f32x4 w0 = GLD4(cw, co), w1 = GLD4(cw, co + FF * 4), w2 = GLD4(cw, co + 2 * FF * 4);
            const f32x4 cb = GLD4(cbias, co);
#pragma unroll
            for (int ai = 0; ai < 2; ++ai) {
                const int gs = u.pm * 4 + ai * 2 + wr;
                f32x4 p1 = (f32x4){0.f, 0.f, 0.f, 0.f}, p2 = p1;
#pragma unroll
                for (int m = 0; m < 4; ++m) {
                    const float rs = rsv[ai][m];
                    const f32x4 g = acc[ai][0][m][n] * rs + bg;
                    const f32x4 up = acc[ai][1][m][n] * rs + bu;
                    const f32x4 c1 = ror4<1>(g), c2 = ror4<2>(g);
                    const f32x4 g1 = fr >= 1 ? c1 : p1;
                    const f32x4 g2 = fr >= 2 ? c2 : p2;
                    if (m == 0 && fr < 2) {
                        f32x4 pp = w2 * g + cb; if (fr == 1) pp = pp + w1 * g1;
                        const unsigned fo = ((unsigned)(gs * 2 + fr) * (unsigned)FF + (unsigned)fcol) * 4u + n * 64;
                        GST4(fixp, fo, pp); GST4(fixu, fo, up);
                    } else {
                        const f32x4 a = w2 * g + w1 * g1 + w0 * g2 + cb;
                        const f32x4 o = silu4(a) * up;
                        u32x2 w; w.x = pk2(o[0], o[1]); w.y = pk2(o[2], o[3]);
                        GST2(act, aoff0 + (unsigned)((ai * 128 + m * 16) * FF) * 2u + n * 32, w);
                    }
                    if (m == 3 && fr >= 14) GST4(halo, ((unsigned)(gs * 2 + (fr - 14)) * (unsigned)FF + (unsigned)fcol) * 4u + n * 64, g);
                    p1 = c1; p2 = c2;
                }
            }
        }
    }
};

#define MFMA32(a, b, c) __builtin_amdgcn_mfma_f32_32x32x16_bf16((a), (b), (c), 0, 0, 0)
__device__ __forceinline__ int crow(int i, int h) { return (i & 3) + 8 * (i >> 2) + 4 * h; }
__device__ __forceinline__ bf16x8 pack8(float a0, float a1, float a2, float a3, float a4, float a5, float a6, float a7) {
    u32x4 p; p.x = pk2(a0, a1); p.y = pk2(a2, a3); p.z = pk2(a4, a5); p.w = pk2(a6, a7); return __builtin_bit_cast(bf16x8, p);
}
__device__ __forceinline__ bf16x8 tr8(const LAS unsigned char* p_lo, int hi_off) {
    const s16x4 lo = __builtin_amdgcn_ds_read_tr16_b64_v4i16((LAS s16x4*)p_lo);
    const s16x4 hi = __builtin_amdgcn_ds_read_tr16_b64_v4i16((LAS s16x4*)(p_lo + hi_off));
    return __builtin_shufflevector(lo, hi, 0, 1, 2, 3, 4, 5, 6, 7);
}

constexpr int KSTR = 144, VSTR = 192, KBUF = 64 * KSTR, VBUF = 64 * VSTR, SB_VOFF = 2 * KBUF, SB_FLAG = SB_VOFF + 2 * VBUF;
__device__ __forceinline__ void sb_unit(LAS unsigned char* lds, const bf16_t* Q, const bf16_t* K, const bf16_t* V, bf16_t* Y, int b, int h, int qb, int tid, int wid, int lane) {
    const int r = lane & 31, hh = lane >> 5;
    const int q0 = qb * 256, qw0 = q0 + 32 * wid, qblk = qw0 >> 5;
    const size_t rowbase = (size_t)b * SEQ;
    bf16x8 qf[4];
    { const bf16_t* qp = Q + (rowbase + qw0 + r) * 512 + h * 64 + 8 * hh;
#pragma unroll
      for (int s = 0; s < 4; ++s) qf[s] = *(const bf16x8*)(qp + 16 * s); }
    f32x16 O0, O1;
#pragma unroll
    for (int i = 0; i < 16; ++i) { O0[i] = 0.f; O1[i] = 0.f; }
    float carry = 0.f;
    const int nkt = 4 * qb + 4;
    const int srow = tid >> 3, spc = tid & 7;
    const bf16_t* kg = K + (rowbase + srow) * 512 + h * 64 + spc * 8;
    const bf16_t* vg = V + (rowbase + srow) * 512 + h * 64 + spc * 8;
    LAS unsigned* flags = (LAS unsigned*)(lds + SB_FLAG);
    __syncthreads();
    u32x4 kreg = *(const u32x4*)(kg + (size_t)(nkt - 1) * 64 * 512), vreg = *(const u32x4*)(vg + (size_t)(nkt - 1) * 64 * 512);
    *(LAS u32x4*)(lds + srow * KSTR + spc * 16) = kreg; *(LAS u32x4*)(lds + SB_VOFF + srow * VSTR + spc * 16) = vreg;
    __syncthreads();
    int cur = 0;
    const int q4 = (lane & 15) >> 2, p4 = lane & 3, blk = (lane >> 4) & 1;
    const int vlane_off = (4 * hh + q4) * VSTR + 8 * (4 * blk + p4);
    for (int kt = nkt - 1; kt >= 0; --kt) {
        if (kt > 0) { kreg = *(const u32x4*)(kg + (size_t)(kt - 1) * 64 * 512); vreg = *(const u32x4*)(vg + (size_t)(kt - 1) * 64 * 512); }
        const LAS unsigned char* kb_ = lds + cur * KBUF; const LAS unsigned char* vb_ = lds + SB_VOFF + cur * VBUF;
        bool wdone = __all(carry >= 160.0f);
        if (!wdone) {
#pragma unroll
            for (int kb = 1; kb >= 0; --kb) {
                const int kb32 = 2 * kt + kb;
                if (kb32 <= qblk) {
                    const bool diag = (kb32 == qblk);
                    f32x16 z;
#pragma unroll
                    for (int i = 0; i < 16; ++i) z[i] = 0.f;
#pragma unroll
                    for (int s = 0; s < 4; ++s) { const bf16x8 a = *(const LAS bf16x8*)(kb_ + (32 * kb + r) * KSTR + 32 * s + 16 * hh); z = MFMA32(a, qf[s], z); }
                    float sp[16];
#pragma unroll
                    for (int i = 0; i < 16; ++i) {
                        const float e = __builtin_amdgcn_exp2f(z[i]);
                        float v = __builtin_amdgcn_logf(1.0f + e);
                        if (diag && !(crow(i, hh) < r)) v = 0.f;
                        sp[i] = v;
                    }
                    float G[4], Gp[4];
#pragma unroll
                    for (int g = 0; g < 4; ++g) { G[g] = (sp[4 * g] + sp[4 * g + 1]) + (sp[4 * g + 2] + sp[4 * g + 3]); Gp[g] = sx(G[g], 32, lane); }
                    float suf = carry; float w[16];
#pragma unroll
                    for (int g = 3; g >= 0; --g) {
                        float run = suf + (hh == 0 ? Gp[g] : 0.f);
#pragma unroll
                        for (int i = 4 * g + 3; i >= 4 * g; --i) {
                            run += sp[i];
                            float wv = __builtin_amdgcn_exp2f(z[i] - run);
                            if (diag && !(crow(i, hh) < r)) wv = 0.f;
                            w[i] = wv;
                        }
                        suf += G[g] + Gp[g];
                    }
                    carry = suf;
#pragma unroll
                    for (int s = 0; s < 2; ++s) {
                        const bf16x8 pf = pack8(w[8 * s], w[8 * s + 1], w[8 * s + 2], w[8 * s + 3], w[8 * s + 4], w[8 * s + 5], w[8 * s + 6], w[8 * s + 7]);
                        const LAS unsigned char* vp = vb_ + (32 * kb + 16 * s) * VSTR + vlane_off;
                        const bf16x8 a0 = tr8(vp, 8 * VSTR), a1 = tr8(vp + 64, 8 * VSTR);
                        O0 = MFMA32(a0, pf, O0); O1 = MFMA32(a1, pf, O1);
                    }
                }
            }
            wdone = __all(carry >= 160.0f);
        }
        if (kt > 0) { *(LAS u32x4*)(lds + (cur ^ 1) * KBUF + srow * KSTR + spc * 16) = kreg; *(LAS u32x4*)(lds + SB_VOFF + (cur ^ 1) * VBUF + srow * VSTR + spc * 16) = vreg; }
        if (lane == 0) flags[(kt & 1) * 8 + wid] = wdone ? 1u : 0u;
        __syncthreads();
        unsigned alld = 1u;
#pragma unroll
        for (int w8 = 0; w8 < 8; ++w8) alld &= flags[(kt & 1) * 8 + w8];
        if (alld) break;
        cur ^= 1;
    }
    bf16_t* yp = Y + (rowbase + qw0 + r) * 1024 + 512 + h * 64 + 4 * hh;
#pragma unroll
    for (int g = 0; g < 4; ++g) {
        u32x2 w0; w0.x = pk2(O0[4 * g], O0[4 * g + 1]); w0.y = pk2(O0[4 * g + 2], O0[4 * g + 3]); *(u32x2*)(yp + 8 * g) = w0;
        u32x2 w1; w1.x = pk2(O1[4 * g], O1[4 * g + 1]); w1.y = pk2(O1[4 * g + 2], O1[4 * g + 3]); *(u32x2*)(yp + 32 + 8 * g) = w1;
    }
}

constexpr int SW_VOFF = 192 * KSTR;
__device__ __forceinline__ void swa_unit(LAS unsigned char* lds, const bf16_t* Q, const bf16_t* K, const bf16_t* V, const float* sinks, bf16_t* Y, int b, int kvh, int qc, int tid, int wid, int lane) {
    const int r = lane & 31, hh = lane >> 5;
    const int head = 4 * kvh + (wid >> 1), qsub = wid & 1;
    const int qw0 = 64 * qc + 32 * qsub;
    const size_t rowbase = (size_t)b * SEQ;
    const int kbase = 64 * qc - 128;
    __syncthreads();
#pragma unroll
    for (int it = 0; it < 3; ++it) {
        const int idx = tid + it * 512, srow = idx >> 3, spc = idx & 7, kpos = kbase + srow;
        u32x4 kv = (u32x4){0u, 0u, 0u, 0u}, vv = (u32x4){0u, 0u, 0u, 0u};
        if (kpos >= 0) { kv = *(const u32x4*)(K + (rowbase + kpos) * 256 + kvh * 64 + spc * 8); vv = *(const u32x4*)(V + (rowbase + kpos) * 256 + kvh * 64 + spc * 8); }
        *(LAS u32x4*)(lds + srow * KSTR + spc * 16) = kv; *(LAS u32x4*)(lds + SW_VOFF + srow * VSTR + spc * 16) = vv;
    }
    bf16x8 qf[4];
    { const bf16_t* qp = Q + (rowbase + qw0 + r) * 1024 + head * 64 + 8 * hh;
#pragma unroll
      for (int s = 0; s < 4; ++s) qf[s] = *(const bf16x8*)(qp + 16 * s); }
    __syncthreads();
    f32x16 O0, O1;
#pragma unroll
    for (int i = 0; i < 16; ++i) { O0[i] = 0.f; O1[i] = 0.f; }
    float mrun = sinks[head] * LOG2E, lsum = (hh == 0) ? 1.0f : 0.0f;
    const int q4 = (lane & 15) >> 2, p4 = lane & 3, blk = (lane >> 4) & 1;
    const int vlane_off = (4 * hh + q4) * VSTR + 8 * (4 * blk + p4);
#pragma unroll
    for (int j = 0; j < 5; ++j) {
        const int rb = qsub + j;
        const int key0 = kbase + 32 * rb;
        if (key0 >= 0) {
            f32x16 z;
#pragma unroll
            for (int i = 0; i < 16; ++i) z[i] = 0.f;
#pragma unroll
            for (int s = 0; s < 4; ++s) { const bf16x8 a = *(const LAS bf16x8*)(lds + (32 * rb + r) * KSTR + 32 * s + 16 * hh); z = MFMA32(a, qf[s], z); }
            float bm = -3.0e38f;
#pragma unroll
            for (int i = 0; i < 16; ++i) {
                bool valid = true;
                if (j == 0) valid = (crow(i, hh) > r);
                if (j == 4) valid = (crow(i, hh) <= r);
                if (!valid) z[i] = -3.0e38f;
                bm = fmaxf(bm, z[i]);
            }
            bm = fmaxf(bm, sx(bm, 32, lane));
            const float mnew = fmaxf(mrun, bm);
            const float alpha = __builtin_amdgcn_exp2f(mrun - mnew);
            mrun = mnew;
            float w[16]; float ps = 0.f;
#pragma unroll
            for (int i = 0; i < 16; ++i) { w[i] = __builtin_amdgcn_exp2f(z[i] - mnew); ps += w[i]; }
            lsum = lsum * alpha + ps;
#pragma unroll
            for (int i = 0; i < 16; ++i) { O0[i] *= alpha; O1[i] *= alpha; }
#pragma unroll
            for (int s = 0; s < 2; ++s) {
                const bf16x8 pf = pack8(w[8 * s], w[8 * s + 1], w[8 * s + 2], w[8 * s + 3], w[8 * s + 4], w[8 * s + 5], w[8 * s + 6], w[8 * s + 7]);
                const LAS unsigned char* vp = lds + SW_VOFF + (32 * rb + 16 * s) * VSTR + vlane_off;
                const bf16x8 a0 = tr8(vp, 8 * VSTR), a1 = tr8(vp + 64, 8 * VSTR);
                O0 = MFMA32(a0, pf, O0); O1 = MFMA32(a1, pf, O1);
            }
        }
    }
    lsum += sx(lsum, 32, lane);
    const float inv = 1.0f / lsum;
    bf16_t* yp = Y + (rowbase + qw0 + r) * 1024 + head * 64 + 4 * hh;
#pragma unroll
    for (int g = 0; g < 4; ++g) {
        u32x2 w0; w0.x = pk2(O0[4 * g] * inv, O0[4 * g + 1] * inv); w0.y = pk2(O0[4 * g + 2] * inv, O0[4 * g + 3] * inv); *(u32x2*)(yp + 8 * g) = w0;
        u32x2 w1; w1.x = pk2(O1[4 * g] * inv, O1[4 * g + 1] * inv); w1.y = pk2(O1[4 * g + 2] * inv, O1[4 * g + 3] * inv); *(u32x2*)(yp + 32 + 8 * g) = w1;
    }
}

constexpr int XCS = 68;
struct LruArgs { const bf16_t* XR; const bf16_t* GR; bf16_t* Y; const float* convw; const float* convb; const float* wa; const float* ba; const float* wx; const float* bx; const float* lam; };
__device__ __forceinline__ void lru_item(LAS unsigned char* lds, const LruArgs& A, int item, int tid, int wid, int lane) {
    const int b = item >> 4, n = (item >> 1) & 7, half = item & 1;
    const int r = lane & 31, hh = lane >> 5;
    const int co = lane & 7, tsub = lane >> 3;
    const size_t rowbase = (size_t)b * SEQ;
    LAS float* xcw = (LAS float*)(lds + wid * (32 * XCS * 4));
    LAS float* exch = (LAS float*)(lds + 8 * (32 * XCS * 4));
    float cw[4][8], cbv[8];
#pragma unroll
    for (int k = 0; k < 4; ++k)
#pragma unroll
        for (int j = 0; j < 8; ++j) cw[k][j] = A.convw[k * 512 + 64 * n + 8 * co + j];
#pragma unroll
    for (int j = 0; j < 8; ++j) cbv[j] = A.convb[64 * n + 8 * co + j];
    bf16x8 waf[4], wxf[4];
#pragma unroll
    for (int s = 0; s < 4; ++s) {
        float ta[8], tx[8];
#pragma unroll
        for (int j = 0; j < 8; ++j) { const int idx = (n * 64 + 16 * s + 8 * hh + j) * 64 + 32 * half + r; ta[j] = A.wa[idx]; tx[j] = A.wx[idx]; }
        waf[s] = pack8(ta[0], ta[1], ta[2], ta[3], ta[4], ta[5], ta[6], ta[7]);
        wxf[s] = pack8(tx[0], tx[1], tx[2], tx[3], tx[4], tx[5], tx[6], tx[7]);
    }
    const int c = 64 * n + 32 * half + r;
    const float ba_c = A.ba[c], bx_c = A.bx[c];
    const float lam_c = A.lam[c];
    const float spl2 = 8.0f * (fmaxf(-lam_c, 0.f) + log1pf(expf(-fabsf(lam_c)))) * LOG2E;
    __syncthreads();
    float hin = 0.f;
    for (int pass = 0; pass < 2; ++pass) {
        float hstate = hin, Aw = 1.0f;
        for (int blk = 0; blk < 8; ++blk) {
            const int tb = 256 * wid + 32 * blk;
#pragma unroll
            for (int p = 0; p < 4; ++p) {
                const int tl = 8 * p + tsub, t = tb + tl;
                float av[8];
#pragma unroll
                for (int j = 0; j < 8; ++j) av[j] = cbv[j];
#pragma unroll
                for (int k = 0; k < 4; ++k) {
                    const int tt = t - 3 + k;
                    if (tt >= 0) {
                        const u32x4 raw = *(const u32x4*)(A.XR + (rowbase + tt) * 512 + 64 * n + 8 * co);
                        av[0] += cw[k][0] * bflo(raw.x); av[1] += cw[k][1] * bfhi(raw.x); av[2] += cw[k][2] * bflo(raw.y); av[3] += cw[k][3] * bfhi(raw.y);
                        av[4] += cw[k][4] * bflo(raw.z); av[5] += cw[k][5] * bfhi(raw.z); av[6] += cw[k][6] * bflo(raw.w); av[7] += cw[k][7] * bfhi(raw.w);
                    }
                }
                *(LAS f32x4*)(xcw + tl * XCS + 8 * co) = (f32x4){av[0], av[1], av[2], av[3]};
                *(LAS f32x4*)(xcw + tl * XCS + 8 * co + 4) = (f32x4){av[4], av[5], av[6], av[7]};
            }
            LDS_WAIT();
            f32x16 R, I;
#pragma unroll
            for (int i = 0; i < 16; ++i) { R[i] = 0.f; I[i] = 0.f; }
#pragma unroll
            for (int s = 0; s < 4; ++s) {
                const f32x4 a0 = *(const LAS f32x4*)(xcw + r * XCS + 16 * s + 8 * hh), a1 = *(const LAS f32x4*)(xcw + r * XCS + 16 * s + 8 * hh + 4);
                const bf16x8 af = pack8(a0[0], a0[1], a0[2], a0[3], a1[0], a1[1], a1[2], a1[3]);
                R = MFMA32(af, waf[s], R); I = MFMA32(af, wxf[s], I);
            }
            float av_[16], uv_[16];
#pragma unroll
            for (int i = 0; i < 16; ++i) {
                const float xcf = xcw[crow(i, hh) * XCS + 32 * half + r];
                const float rr = __builtin_amdgcn_rcpf(1.0f + __builtin_amdgcn_exp2f(-(R[i] + ba_c) * LOG2E));
                const float ii = __builtin_amdgcn_rcpf(1.0f + __builtin_amdgcn_exp2f(-(I[i] + bx_c) * LOG2E));
                const float la2 = -rr * spl2;
                const float a = __builtin_amdgcn_exp2f(la2);
                const float y = la2 * (2.0f / LOG2E);
                const float om = (y > -0.25f) ? -y * (1.0f + y * (0.5f + y * ((1.0f / 6.0f) + y * ((1.0f / 24.0f) + y * (1.0f / 120.0f))))) : 1.0f - a * a;
                av_[i] = a; uv_[i] = sqrtf(om) * ii * xcf;
            }
            asm volatile("" ::: "memory");
            float Ag[4], Bg[4], pA[4], pB[4];
#pragma unroll
            for (int g = 0; g < 4; ++g) {
                Ag[g] = (av_[4 * g] * av_[4 * g + 1]) * (av_[4 * g + 2] * av_[4 * g + 3]);
                Bg[g] = ((uv_[4 * g] * av_[4 * g + 1] + uv_[4 * g + 1]) * av_[4 * g + 2] + uv_[4 * g + 2]) * av_[4 * g + 3] + uv_[4 * g + 3];
                pA[g] = sx(Ag[g], 32, lane); pB[g] = sx(Bg[g], 32, lane);
            }
            float hcur = hstate, start[4];
#pragma unroll
            for (int g = 0; g < 4; ++g) {
                const float A0 = hh == 0 ? Ag[g] : pA[g], B0 = hh == 0 ? Bg[g] : pB[g];
                const float A1 = hh == 0 ? pA[g] : Ag[g], B1 = hh == 0 ? pB[g] : Bg[g];
                const float s0 = hcur; hcur = A0 * hcur + B0;
                const float s1 = hcur; hcur = A1 * hcur + B1;
                start[g] = hh == 0 ? s0 : s1; Aw *= A0 * A1;
            }
            if (pass == 1) {
#pragma unroll
                for (int g = 0; g < 4; ++g) {
                    float hv = start[g];
#pragma unroll
                    for (int i = 4 * g; i < 4 * g + 4; ++i) {
                        hv = av_[i] * hv + uv_[i];
                        const size_t row = rowbase + tb + crow(i, hh);
                        const float gv = bflo((unsigned)A.GR[row * 512 + c]);
                        const float yy = 0.7978845608028654f * (gv + 0.044715f * gv * gv * gv);
                        const float ge = gv * __builtin_amdgcn_rcpf(1.0f + __builtin_amdgcn_exp2f(-2.0f * LOG2E * yy));
                        A.Y[row * 1024 + c] = (bf16_t)(pk2(hv * ge, 0.f) & 0xffffu);
                    }
                }
            }
            hstate = hcur;
        }
        if (pass == 0) {
            if (hh == 0) { exch[(wid * 32 + r) * 2] = Aw; exch[(wid * 32 + r) * 2 + 1] = hstate; }
            __syncthreads();
            hin = 0.f;
            for (int w8 = 0; w8 < wid; ++w8) hin = exch[(w8 * 32 + r) * 2] * hin + exch[(w8 * 32 + r) * 2 + 1];
        }
    }
}

__device__ __forceinline__ float wave_sum(float v, int lane) {
#pragma unroll
    for (int o = 1; o < 64; o <<= 1) v += sx(v, o, lane);
    return v;
}
__device__ __forceinline__ int headperm(int n) { return (n & ~255) | (((n >> 5) & 1) << 7) | (((n >> 6) & 3) << 5) | (n & 31); }
__device__ __forceinline__ void transpose_item(const float* W, int N, bf16_t* WT, int K, int dst_row0, int k0, int n0, LAS float* scr, int lane) {
    float tv[32];
#pragma unroll
    for (int i = 0; i < 32; ++i) { const int kk = 2 * i + (lane >> 5); tv[i] = W[(size_t)(k0 + kk) * N + n0 + (lane & 31)]; }
#pragma unroll
    for (int i = 0; i < 32; ++i) { const int kk = 2 * i + (lane >> 5); scr[kk * 33 + (lane & 31)] = tv[i]; }
    LDS_WAIT();
    const int c8 = lane & 7;
#pragma unroll
    for (int j = 0; j < 4; ++j) { const int n = (lane >> 3) + 8 * j; const LAS float* s = scr + (8 * c8) * 33 + n;
        u32x4 o; o.x = pk2(s[0 * 33], s[1 * 33]); o.y = pk2(s[2 * 33], s[3 * 33]); o.z = pk2(s[4 * 33], s[5 * 33]); o.w = pk2(s[6 * 33], s[7 * 33]);
        *(u32x4*)(WT + (size_t)(dst_row0 + n) * K + k0 + 8 * c8) = o; }
    LDS_WAIT();
}


#define XB_TMO      128
#define XB_XCNT(j)  (256  + 64 * (j))
#define XB_XSUB(j)  (1280 + 64 * (j))
#define XB_XGEN(j)  (2304 + 64 * (j))
#define XB_TOP      3328
#define XB_TOPGEN   3392
#define XCD_BAR_WORDS 3456
#define XB_SPIN_CAP (1u << 20)
__device__ __forceinline__ unsigned xb_ld(unsigned* p)              { return __hip_atomic_load(p, __ATOMIC_RELAXED, __HIP_MEMORY_SCOPE_AGENT); }
__device__ __forceinline__ unsigned xb_add(unsigned* p, unsigned v) { return __hip_atomic_fetch_add(p, v, __ATOMIC_RELAXED, __HIP_MEMORY_SCOPE_AGENT); }
__device__ __forceinline__ unsigned xb_xcc_id() { return (unsigned)__builtin_amdgcn_s_getreg((3 << 11) | 20) & 0xFu; }
#define XB_SPIN(cond, bar) do { unsigned _sp = 0; while (cond) { __builtin_amdgcn_s_sleep(1); \
    if ((++_sp & 255u) == 0u) { if (xb_ld(&(bar)[XB_TMO])) break; if (_sp > XB_SPIN_CAP) { atomicAdd(&(bar)[XB_TMO], 1u); break; } } } } while (0)
struct XcdBarrier { unsigned* bar; unsigned x; volatile LAS unsigned* st; };
__device__ __forceinline__ void xcd_barrier_complete(unsigned* bar, unsigned x, unsigned& nloc, unsigned& nx) {
    const unsigned G = gridDim.x * gridDim.y * gridDim.z;
    unsigned sum, cnt, mine, sp = 0u;
    for (;;) {
        sum = 0u; cnt = 0u; mine = 0u;
#pragma unroll
        for (unsigned j = 0; j < 16; ++j) { const unsigned c = xb_ld(&bar[XB_XCNT(j)]); sum += c; cnt += (c > 0u) ? 1u : 0u; mine = (j == x) ? c : mine; }
        if (sum == G) break;
        __builtin_amdgcn_s_sleep(1);
        if ((++sp & 255u) == 0u) { if (xb_ld(&bar[XB_TMO])) break; if (sp > XB_SPIN_CAP) { atomicAdd(&bar[XB_TMO], 1u); break; } }
    }
    nloc = mine > 0u ? mine : 1u; nx = cnt > 0u ? cnt : 1u;
}
__device__ __forceinline__ void xcd_barrier(const XcdBarrier& b, const bool leader) {
    asm volatile("s_waitcnt vmcnt(0)" ::: "memory");
    __syncthreads();
    if (leader) {
        unsigned* bar = b.bar;
        __builtin_amdgcn_s_waitcnt(0);
        unsigned nloc = b.st[0], nx = b.st[1];
        if (nloc == 0u) { xcd_barrier_complete(bar, b.x, nloc, nx); b.st[0] = nloc; b.st[1] = nx; }
        const unsigned old = xb_add(&bar[XB_XSUB(b.x)], 1u);
        const unsigned gen = old / nloc;
        if (old + 1u == (gen + 1u) * nloc) {
            __builtin_amdgcn_fence(__ATOMIC_RELEASE, "agent");
            asm volatile("s_waitcnt vmcnt(0)" ::: "memory");
            const unsigned og = xb_add(&bar[XB_TOP], 1u);
            const unsigned tg = og / nx;
            if (og + 1u == (tg + 1u) * nx) xb_add(&bar[XB_TOPGEN], 1u);
            else XB_SPIN(xb_ld(&bar[XB_TOPGEN]) == tg, bar);
            __builtin_amdgcn_fence(__ATOMIC_ACQUIRE, "agent");
            xb_add(&bar[XB_XGEN(b.x)], 1u);
            asm volatile("s_waitcnt vmcnt(0)" ::: "memory");
        } else {
            XB_SPIN(xb_ld(&bar[XB_XGEN(b.x)]) == gen, bar);
            __builtin_amdgcn_fence(__ATOMIC_ACQUIRE, "agent");
            asm volatile("s_waitcnt vmcnt(0)" ::: "memory");
        }
    }
    __syncthreads();
}

struct Args { const float* in[27]; float* out; unsigned char* ws; };

__global__ void __launch_bounds__(512, 2) fwd_mega(Args args) {
    extern __shared__ __attribute__((aligned(16))) unsigned char lds_raw[];
    LAS unsigned char* lds = (LAS unsigned char*)lds_raw;
    cg::grid_group grid = cg::this_grid();
#define GSYNC_CG() do { if (args.ws == nullptr) grid.sync(); GSYNC(); } while (0)
#define GSYNC() do { int l_; asm volatile("v_mbcnt_lo_u32_b32 %0, -1, 0\n\tv_mbcnt_hi_u32_b32 %0, -1, %0" : "=v"(l_)); xcd_barrier(xbar, wid_s == 0 && l_ == 0); if (DUP_MASK & 4) xcd_barrier(xbar, wid_s == 0 && l_ == 0); } while (0)
    const int G = gridDim.x, bid = blockIdx.x, NGW = G * 8;
    const int wid_s = __builtin_amdgcn_readfirstlane((int)threadIdx.x >> 6);
    XcdBarrier xbar;
    {
        volatile LAS unsigned* st = (volatile LAS unsigned*)(lds + 139264);
        if (threadIdx.x < 4) st[threadIdx.x] = 0u;
        __syncthreads();
        xbar.bar = (unsigned*)(args.ws + WS_BAR); xbar.x = xb_xcc_id(); xbar.st = st;
        if (threadIdx.x == 0) (void)xb_add(&xbar.bar[XB_XCNT(xbar.x)], 1u);
    }
#define PHASE_IDS int lane_; asm volatile("v_mbcnt_lo_u32_b32 %0, -1, 0\n\tv_mbcnt_hi_u32_b32 %0, -1, %0" : "=v"(lane_)); const int lane = lane_ & 63; const int wid = wid_s; const int tid = wid * 64 + lane; const int gw = bid * 8 + wid; (void)gw;
    unsigned char* ws = args.ws;
    const float* x = args.in[0]; const float* cc = args.in[1]; const float* ada_w = args.in[2]; const float* ada_b = args.in[3];
    const float* norm_mix_g = args.in[4]; const float* norm_ffn_g = args.in[5];
    float* MOD = (float*)(ws + WS_MOD); float* SHW = (float*)(ws + WS_SHW);
    float* SSQ0 = (float*)(ws + WS_SSQ0); float* SSQ1 = (float*)(ws + WS_SSQ1); float* SSQ2 = (float*)(ws + WS_SSQ2); float* SSQ3 = (float*)(ws + WS_SSQ3);
    bf16_t* XG = (bf16_t*)(ws + WS_XG); bf16_t* PB = (bf16_t*)(ws + WS_P); bf16_t* YB = (bf16_t*)(ws + WS_Y); bf16_t* ACT = (bf16_t*)(ws + WS_ACT); bf16_t* XS = (bf16_t*)(ws + WS_XS);
    float* HALO = (float*)(ws + WS_HALO); float* FIXP = (float*)(ws + WS_FIXP); float* FIXU = (float*)(ws + WS_FIXU);
    bf16_t* W_IN0 = (bf16_t*)(ws + WS_W_IN0); bf16_t* W_OUT0 = (bf16_t*)(ws + WS_W_OUT0); bf16_t* W_GU0 = (bf16_t*)(ws + WS_W_GU0); bf16_t* W_DN0 = (bf16_t*)(ws + WS_W_DN0);
    bf16_t* W_IN1 = (bf16_t*)(ws + WS_W_IN1); bf16_t* W_OUT1 = (bf16_t*)(ws + WS_W_OUT1); bf16_t* W_GU1 = (bf16_t*)(ws + WS_W_GU1); bf16_t* W_DN1 = (bf16_t*)(ws + WS_W_DN1);

    for (int prep = 0; prep < ((DUP_MASK & 8) ? 2 : 1); ++prep) {
    for (int item = bid; item < 256; item += G) {
        PHASE_IDS
        const int l = item >> 7, chunk = item & 127;
        LAS float* sl = (LAS float*)lds;
        LAS float* part = (LAS float*)(lds + 65536);
        __syncthreads();
        for (int idx = tid; idx < 16384; idx += 512) { const float v = cc[idx]; sl[idx] = v / (1.0f + __expf(-v)); }
        __syncthreads();
        float acc[16];
#pragma unroll
        for (int bb = 0; bb < 16; ++bb) acc[bb] = 0.f;
        const int colc = chunk * 48 + (lane < 48 ? lane : 47);
        const float* Wp = ada_w + (size_t)l * 1024 * 6144 + colc;
        for (int k = 128 * wid; k < 128 * wid + 128; k += 16) {
            float wv[16];
#pragma unroll
            for (int j = 0; j < 16; ++j) wv[j] = Wp[(size_t)(k + j) * 6144];
#pragma unroll
            for (int j4 = 0; j4 < 4; ++j4)
#pragma unroll
                for (int bb = 0; bb < 16; ++bb) { const f32x4 s4 = *(const LAS f32x4*)(sl + bb * 1024 + k + 4 * j4); acc[bb] += (s4[0] * wv[4 * j4] + s4[1] * wv[4 * j4 + 1]) + (s4[2] * wv[4 * j4 + 2] + s4[3] * wv[4 * j4 + 3]); }
        }
#pragma unroll
        for (int bb = 0; bb < 16; ++bb) part[(wid * 16 + bb) * 64 + lane] = acc[bb];
        __syncthreads();
        for (int o = tid; o < 1024; o += 512) {
            const int bb = o >> 6, cl = o & 63;
            if (cl < 48) {
                float sacc = ada_b[l * 6144 + chunk * 48 + cl];
#pragma unroll
                for (int w8 = 0; w8 < 8; ++w8) sacc += part[(w8 * 16 + bb) * 64 + cl];
                MOD[((size_t)l * 16 + bb) * 6144 + chunk * 48 + cl] = sacc;
            }
        }
        __syncthreads();
    }
    {
        PHASE_IDS
        LAS float* scr = (LAS float*)(lds + wid * 16384);
        constexpr int NITEMS = 1280 + 512 + 3 * 1408 + 768 + 512 + 3 * 1408;
        for (int it = gw; it < NITEMS; it += NGW) {
            int rI = it; const float* W; int N, K; bf16_t* WT; int mapk;
            if (rI < 1280) { W = args.in[6]; N = 2560; K = 1024; WT = W_IN0; mapk = 1; }
            else if ((rI -= 1280) < 512) { W = args.in[16]; N = 1024; K = 1024; WT = W_OUT0; mapk = 0; }
            else if ((rI -= 512) < 1408) { W = args.in[22]; N = FF; K = 1024; WT = W_GU0; mapk = 3; }
            else if ((rI -= 1408) < 1408) { W = args.in[23]; N = FF; K = 1024; WT = W_GU0; mapk = 4; }
            else if ((rI -= 1408) < 1408) { W = args.in[26]; N = 1024; K = FF; WT = W_DN0; mapk = 0; }
            else if ((rI -= 1408) < 768) { W = args.in[17]; N = 1536; K = 1024; WT = W_IN1; mapk = 2; }
            else if ((rI -= 768) < 512) { W = args.in[21]; N = 1024; K = 1024; WT = W_OUT1; mapk = 0; }
            else if ((rI -= 512) < 1408) { W = args.in[22] + (size_t)1024 * FF; N = FF; K = 1024; WT = W_GU1; mapk = 3; }
            else if ((rI -= 1408) < 1408) { W = args.in[23] + (size_t)1024 * FF; N = FF; K = 1024; WT = W_GU1; mapk = 4; }
            else { rI -= 1408; W = args.in[26] + (size_t)FF * 1024; N = 1024; K = FF; WT = W_DN1; mapk = 0; }
            const int nblk = N / 32, kb = rI / nblk, nb = rI % nblk, k0 = 64 * kb, n0 = 32 * nb;
            int d0 = n0;
            if (mapk == 1) { const int region = n0 >> 9; if (region == 2 || region == 3) d0 = headperm(n0); }
            else if (mapk == 2) { if (n0 < 1280) d0 = headperm(n0); }
            else if (mapk == 3) d0 = 256 * (n0 >> 7) + (n0 & 127);
            else if (mapk == 4) d0 = 256 * (n0 >> 7) + 128 + (n0 & 127);
            transpose_item(W, N, WT, K, d0, k0, n0, scr, lane);
        }
    }
    GSYNC_CG();

    {
    PHASE_IDS
    for (int m0 = gw; m0 < M; m0 += 2 * NGW) {
        const int m1 = (m0 + NGW < M) ? m0 + NGW : m0;
        f32x4 v[2][4], gm[2][4];
#pragma unroll
        for (int rr = 0; rr < 2; ++rr) {
            const int m = rr ? m1 : m0; const int bb = m >> 11;
            const f32x4* xr = (const f32x4*)(x + (size_t)m * 1024) + lane;
            const f32x4* gp = (const f32x4*)norm_mix_g + lane;
            const f32x4* sp = (const f32x4*)(MOD + (size_t)bb * 6144 + 1024) + lane;
#pragma unroll
            for (int j = 0; j < 4; ++j) { v[rr][j] = xr[64 * j]; gm[rr][j] = gp[64 * j] * (sp[64 * j] + 1.0f); }
        }
#pragma unroll
        for (int rr = 0; rr < 2; ++rr) {
            const int m = rr ? m1 : m0;
            u32x2* op = (u32x2*)(XG + (size_t)m * 1024) + lane;
            float sacc = 0.f;
#pragma unroll
            for (int j = 0; j < 4; ++j) {
                const f32x4 q = v[rr][j] * v[rr][j]; sacc += (q[0] + q[1]) + (q[2] + q[3]);
                const f32x4 o = v[rr][j] * gm[rr][j]; u32x2 w; w.x = pk2(o[0], o[1]); w.y = pk2(o[2], o[3]); op[64 * j] = w;
            }
            sacc = wave_sum(sacc, lane);
            if (lane == 0) SSQ0[m] = sacc;
        }
    }
    for (int gi = 0; gi < 4; ++gi) {
        const bf16_t* Wt; int N; const float* shp; float* outp;
        if (gi == 0) { Wt = W_IN0; N = 2560; shp = MOD; outp = SHW + SHW_IN0; }
        else if (gi == 1) { Wt = W_GU0; N = 5632; shp = MOD + 3 * 1024; outp = SHW + SHW_GU0; }
        else if (gi == 2) { Wt = W_IN1; N = 1536; shp = MOD + (size_t)16 * 6144; outp = SHW + SHW_IN1; }
        else { Wt = W_GU1; N = 5632; shp = MOD + (size_t)16 * 6144 + 3 * 1024; outp = SHW + SHW_GU1; }
        LAS float* shl = (LAS float*)lds;
        __syncthreads();
        for (int idx = tid; idx < 16384; idx += 512) shl[idx] = shp[(size_t)(idx >> 10) * 6144 + (idx & 1023)];
        __syncthreads();
        for (int p = gw; p < N; p += NGW) {
            asm volatile("" ::: "memory");
            const u32x4 r0 = *(const u32x4*)(Wt + (size_t)p * 1024 + 8 * lane), r1 = *(const u32x4*)(Wt + (size_t)p * 1024 + 512 + 8 * lane);
            float wv[16];
            wv[0] = bflo(r0.x); wv[1] = bfhi(r0.x); wv[2] = bflo(r0.y); wv[3] = bfhi(r0.y); wv[4] = bflo(r0.z); wv[5] = bfhi(r0.z); wv[6] = bflo(r0.w); wv[7] = bfhi(r0.w);
            wv[8] = bflo(r1.x); wv[9] = bfhi(r1.x); wv[10] = bflo(r1.y); wv[11] = bfhi(r1.y); wv[12] = bflo(r1.z); wv[13] = bfhi(r1.z); wv[14] = bflo(r1.w); wv[15] = bfhi(r1.w);
            float d[16];
#pragma unroll
            for (int bb = 0; bb < 16; ++bb) {
                const LAS float* sb_ = shl + bb * 1024 + 8 * lane;
                const f32x4 s0 = *(const LAS f32x4*)(sb_), s1 = *(const LAS f32x4*)(sb_ + 4), s2 = *(const LAS f32x4*)(sb_ + 512), s3 = *(const LAS f32x4*)(sb_ + 516);
                d[bb] = (wv[0] * s0[0] + wv[1] * s0[1]) + (wv[2] * s0[2] + wv[3] * s0[3]) + (wv[4] * s1[0] + wv[5] * s1[1]) + (wv[6] * s1[2] + wv[7] * s1[3])
                      + (wv[8] * s2[0] + wv[9] * s2[1]) + (wv[10] * s2[2] + wv[11] * s2[3]) + (wv[12] * s3[0] + wv[13] * s3[1]) + (wv[14] * s3[2] + wv[15] * s3[3]);
            }
            const bool h5 = (lane & 32) != 0, h4 = (lane & 16) != 0, h3 = (lane & 8) != 0, h2 = (lane & 4) != 0;
            float e8[8], e4[4], e2[2];
#pragma unroll
            for (int j = 0; j < 8; ++j) { const float snd = h5 ? d[j] : d[j + 8], kp = h5 ? d[j + 8] : d[j]; e8[j] = kp + sx(snd, 32, lane); }
#pragma unroll
            for (int j = 0; j < 4; ++j) { const float snd = h4 ? e8[j] : e8[j + 4], kp = h4 ? e8[j + 4] : e8[j]; e4[j] = kp + sx(snd, 16, lane); }
#pragma unroll
            for (int j = 0; j < 2; ++j) { const float snd = h3 ? e4[j] : e4[j + 2], kp = h3 ? e4[j + 2] : e4[j]; e2[j] = kp + sx(snd, 8, lane); }
            float tot; { const float snd = h2 ? e2[0] : e2[1], kp = h2 ? e2[1] : e2[0]; tot = kp + sx(snd, 4, lane); }
            tot += sx(tot, 2, lane); tot += sx(tot, 1, lane);
            const int bsel = (h5 ? 8 : 0) + (h4 ? 4 : 0) + (h3 ? 2 : 0) + (h2 ? 1 : 0);
            if ((lane & 3) == 0) outp[(size_t)bsel * N + p] = tot;
        }
    }
    }
    GSYNC();

    }
    pg8::StaticOrder S;
    {
        PHASE_IDS
        pg8::Gemm g{XG, W_IN0, M, 2560, 1024}; S.init(M, 2560, G, bid);
        EpiIn<0> E{SSQ0, SHW + SHW_IN0, 2560, PB, args.in[14], args.in[15]};
        pg8::gemm_phase<EpiIn<0>>(lds, g, S, E, tid);
    }
#if (DUP_MASK & 32)
    {
        PHASE_IDS
        pg8::Gemm g{XG, W_IN0, M, 2560, 1024}; S.init(M, 2560, G, bid);
        EpiIn<0> E{SSQ0, SHW + SHW_IN0, 2560, PB, args.in[14], args.in[15]};
        pg8::gemm_phase<EpiIn<0>>(lds, g, S, E, tid);
    }
#endif
    GSYNC();

    {
        const bf16_t* XR = PB; const bf16_t* GR = PB + (size_t)M * 512; const bf16_t* Qb = PB + (size_t)2 * M * 512; const bf16_t* Kb = PB + (size_t)3 * M * 512; const bf16_t* Vb = PB + (size_t)4 * M * 512;
        PHASE_IDS
        LruArgs LA{XR, GR, YB, args.in[7], args.in[8], args.in[9], args.in[10], args.in[11], args.in[12], args.in[13]};
        for (int rep = 0; rep < ((DUP_MASK & 1) ? 2 : 1); ++rep) {
        for (int rep2 = 0; rep2 < ((DUP_MASK & 256) ? 2 : 1); ++rep2)
        for (int item = bid; item < 256; item += G) lru_item(lds, LA, item, tid, wid, lane);
        for (int u = bid; u < 1024; u += G) {
            const int rr = u >> 8, i = u & 255, hi = i >> 7, bh = i & 127;
            int qb;
            if (rr == 0) qb = hi ? 6 : 7; else if (rr == 1) qb = hi ? 5 : 4; else if (rr == 2) qb = hi ? 2 : 3; else qb = hi ? 1 : 0;
            sb_unit(lds, Qb, Kb, Vb, YB, bh >> 3, bh & 7, qb, tid, wid, lane);
        }
        }
    }
    GSYNC();

    {
        PHASE_IDS
        pg8::Gemm g{YB, W_OUT0, M, 1024, 1024}; S.init(M, 1024, G, bid);
        EpiRes<true, false, false> E{x, XS, MOD + 2 * 1024, norm_ffn_g, MOD + 4 * 1024, XG, SSQ1};
        pg8::gemm_phase<EpiRes<true, false, false>>(lds, g, S, E, tid);
    }
    GSYNC();

    for (int layer = 0; layer < 2; ++layer) {
        if (layer == 1) {
            {
                PHASE_IDS
                pg8::Gemm g{XG, W_IN1, M, 1536, 1024}; S.init(M, 1536, G, bid);
                EpiIn<1> E{SSQ2, SHW + SHW_IN1, 1536, PB, args.in[18], args.in[19]};
                pg8::gemm_phase<EpiIn<1>>(lds, g, S, E, tid);
            }
            GSYNC();
            {
                const bf16_t* Qb = PB; const bf16_t* Kb = PB + (size_t)M * 1024; const bf16_t* Vb = Kb + (size_t)M * 256;
                PHASE_IDS
                for (int rep = 0; rep < ((DUP_MASK & 16) ? 2 : 1); ++rep)
                for (int u = bid; u < 2048; u += G) { const int qc = u & 31, kvh = (u >> 5) & 3, bb = u >> 7; swa_unit(lds, Qb, Kb, Vb, args.in[20], YB, bb, kvh, qc, tid, wid, lane); }
            }
            GSYNC();
            {
                PHASE_IDS
                pg8::Gemm g{YB, W_OUT1, M, 1024, 1024}; S.init(M, 1024, G, bid);
                EpiRes<false, false, false> E{XS, XS, MOD + (size_t)16 * 6144 + 2 * 1024, norm_ffn_g + 1024, MOD + (size_t)16 * 6144 + 4 * 1024, XG, SSQ3};
                pg8::gemm_phase<EpiRes<false, false, false>>(lds, g, S, E, tid);
            }
            GSYNC();
        }
#if (DUP_MASK & 64)
        {
            PHASE_IDS
            pg8::Gemm g{XG, layer ? W_GU1 : W_GU0, M, 5632, 1024}; S.init(M, 5632, G, bid);
            EpiGU E{layer ? SSQ3 : SSQ1, SHW + (layer ? SHW_GU1 : SHW_GU0), args.in[24] + (size_t)layer * 3 * FF, args.in[25] + (size_t)layer * FF, ACT, HALO, FIXP, FIXU};
            pg8::gemm_phase<EpiGU>(lds, g, S, E, tid);
        }
#endif
        {
            PHASE_IDS
            pg8::Gemm g{XG, layer ? W_GU1 : W_GU0, M, 5632, 1024}; S.init(M, 5632, G, bid);
            EpiGU E{layer ? SSQ3 : SSQ1, SHW + (layer ? SHW_GU1 : SHW_GU0), args.in[24] + (size_t)layer * 3 * FF, args.in[25] + (size_t)layer * FF, ACT, HALO, FIXP, FIXU};
            pg8::gemm_phase<EpiGU>(lds, g, S, E, tid);
        }
        GSYNC();
        {
            PHASE_IDS
            const float* cw = args.in[24] + (size_t)layer * 3 * FF;
            for (int rep = 0; rep < ((DUP_MASK & 128) ? 2 : 1); ++rep)
            for (int idx = bid * 512 + tid; idx < 512 * 2 * 704; idx += G * 512) {
                const int c4 = idx % 704, sr = idx / 704, s = sr & 1, gs = sr >> 1;
                const size_t fo = ((size_t)gs * 2 + s) * FF + 4 * c4;
                f32x4 a = *(const f32x4*)(FIXP + fo); const f32x4 up = *(const f32x4*)(FIXU + fo);
                if ((gs & 31) != 0) {
                    const f32x4 h1 = *(const f32x4*)(HALO + ((size_t)(gs - 1) * 2 + 1) * FF + 4 * c4);
                    const f32x4 w0 = *(const f32x4*)(cw + 4 * c4);
                    if (s == 0) { const f32x4 h2 = *(const f32x4*)(HALO + ((size_t)(gs - 1) * 2) * FF + 4 * c4); const f32x4 w1 = *(const f32x4*)(cw + FF + 4 * c4); a = a + w1 * h1 + w0 * h2; }
                    else a = a + w0 * h1;
                }
                const f32x4 o = silu4(a) * up; u32x2 w; w.x = pk2(o[0], o[1]); w.y = pk2(o[2], o[3]);
                *(u32x2*)(ACT + (size_t)(gs * 64 + s) * FF + 4 * c4) = w;
            }
        }
        GSYNC();
        if (layer == 0) {
            PHASE_IDS
            pg8::Gemm g{ACT, W_DN0, M, 1024, FF}; S.init(M, 1024, G, bid);
            EpiRes<false, false, false> E{XS, XS, MOD + 5 * 1024, norm_mix_g + 1024, MOD + (size_t)16 * 6144 + 1 * 1024, XG, SSQ2};
            pg8::gemm_phase<EpiRes<false, false, false>>(lds, g, S, E, tid);
            GSYNC();
        } else {
            PHASE_IDS
            pg8::Gemm g{ACT, W_DN1, M, 1024, FF}; S.init(M, 1024, G, bid);
            EpiRes<false, true, true> E{XS, args.out, MOD + (size_t)16 * 6144 + 5 * 1024, nullptr, nullptr, nullptr, nullptr};
            pg8::gemm_phase<EpiRes<false, true, true>>(lds, g, S, E, tid);
        }
    }
}

extern "C" void kernel_launch(void* const* d_in, const int* in_sizes, int n_in, void* d_out, int out_size, void* d_ws, size_t ws_size, hipStream_t stream) {
    static int grid = 0;
    if (grid == 0) {
        if (n_in != 27 || out_size != M * DM || ws_size < WS_END) { fprintf(stderr, "kernel_launch: unexpected shapes (n_in %d out %d ws %zu)\n", n_in, out_size, ws_size); grid = -1; return; }
        int dev = 0, cus = 0, per_cu = 0;
        (void)hipGetDevice(&dev);
        (void)hipDeviceGetAttribute(&cus, hipDeviceAttributeMultiprocessorCount, dev);
        (void)hipFuncSetAttribute((const void*)fwd_mega, hipFuncAttributeMaxDynamicSharedMemorySize, LDS_BYTES);
        (void)hipOccupancyMaxActiveBlocksPerMultiprocessor(&per_cu, (const void*)fwd_mega, 512, LDS_BYTES);
        (void)hipGetLastError();
        grid = cus;
        if (per_cu < 1) fprintf(stderr, "kernel_launch: occupancy query says %d blocks/CU\n", per_cu);
    }
    if (grid < 0) return;
    (void)hipMemsetAsync(d_ws, 0, WS_ZERO_BYTES, stream);
    Args a{};
    for (int i = 0; i < 27; ++i) a.in[i] = (const float*)d_in[i];
    a.out = (float*)d_out; a.ws = (unsigned char*)d_ws;
    void* kargs[] = {&a};
    hipError_t e = hipLaunchCooperativeKernel((const void*)fwd_mega, dim3(grid), dim3(512), kargs, LDS_BYTES, stream);
    if (e != hipSuccess) fprintf(stderr, "cooperative launch failed: %s (grid %d)\n", hipGetErrorString(e), grid);
}
```

```cpp
#include <hip/hip_runtime.h>
#include <hip/hip_cooperative_groups.h>
#include <cstdio>
#include <cstdint>
namespace cg = cooperative_groups;

#define LAS __attribute__((address_space(3)))
typedef unsigned short bf16_t;
typedef short bf16x8 __attribute__((ext_vector_type(8)));
typedef short s16x4 __attribute__((ext_vector_type(4)));
typedef float f32x4 __attribute__((ext_vector_type(4)));
typedef float f32x2 __attribute__((ext_vector_type(2)));
typedef float f32x16 __attribute__((ext_vector_type(16)));
typedef unsigned u32x4 __attribute__((ext_vector_type(4)));
typedef unsigned u32x2 __attribute__((ext_vector_type(2)));
typedef __bf16 bf2_t __attribute__((ext_vector_type(2)));

__device__ __forceinline__ unsigned pk2(float lo, float hi) { f32x2 v = {lo, hi}; bf2_t r = __builtin_convertvector(v, bf2_t); return __builtin_bit_cast(unsigned, r); }
__device__ __forceinline__ float bflo(unsigned u) { return __uint_as_float(u << 16); }
__device__ __forceinline__ float bfhi(unsigned u) { return __uint_as_float(u & 0xffff0000u); }
#define LDS_WAIT() asm volatile("s_waitcnt lgkmcnt(0)" ::: "memory")
__device__ __forceinline__ float sx(float v, int mask, int lane) { return __int_as_float(__builtin_amdgcn_ds_bpermute((lane ^ mask) << 2, __float_as_int(v))); }

constexpr int NB = 16, SEQ = 2048, DM = 1024, M = NB * SEQ, FF = 2816;
constexpr float EPS = 1e-6f;
constexpr float LOG2E = 1.4426950408889634f;
constexpr float QSCALE = 0.125f * LOG2E;

constexpr size_t MiB = 1u << 20;
constexpr size_t WS_SSQ1 = 0, WS_SSQ2 = 128 * 1024, WS_SSQ3 = 256 * 1024, WS_ZERO_BYTES = 512 * 1024;
constexpr size_t WS_BAR = 384 * 1024;
constexpr size_t WS_SSQ0 = 512 * 1024;
constexpr size_t WS_MOD = 1 * MiB;
constexpr size_t WS_SHW = 2 * MiB;
constexpr size_t SHW_IN0 = 0, SHW_GU0 = 16 * 2560, SHW_IN1 = SHW_GU0 + 16 * 5632, SHW_GU1 = SHW_IN1 + 16 * 1536;
constexpr size_t WS_HALO = 3 * MiB, WS_FIXP = 15 * MiB, WS_FIXU = 27 * MiB;
constexpr size_t WS_W_IN0 = 40 * MiB, WS_W_OUT0 = 45 * MiB, WS_W_GU0 = 47 * MiB, WS_W_DN0 = 58 * MiB;
constexpr size_t WS_W_IN1 = 64 * MiB, WS_W_OUT1 = 67 * MiB, WS_W_GU1 = 69 * MiB, WS_W_DN1 = 80 * MiB;
constexpr size_t WS_XG = 96 * MiB;
constexpr size_t WS_P = 160 * MiB;
constexpr size_t WS_Y = 320 * MiB;
constexpr size_t WS_ACT = 160 * MiB;
constexpr size_t WS_XS = 384 * MiB;
constexpr size_t WS_END = 448 * MiB;

constexpr int LDS_BYTES = 147456;
#ifndef DUP_MASK
#define DUP_MASK 0
#endif

namespace pg8 {
constexpr int BM = 256, BK = 64, HALF = 128, HTB = HALF * BK * 2, STAGE_BYTES = 8 * HTB, NXCD = 8, WGM = 8;
__host__ __device__ __forceinline__ int lds_byte(int r, int c) { const int st = (r >> 4) * 2 + (c >> 5), rr = r & 15, cc = c & 31, ob = rr * 64 + cc * 2; return st * 1024 + (ob ^ (((ob >> 9) & 1) << 5)); }
__host__ __device__ __forceinline__ void stage_rc(int b, int& R, int& C) { const int st = b / 1024, sb = b % 1024, swz = sb ^ (((sb >> 9) & 1) << 5); R = (st >> 1) * 16 + swz / 64; C = (st & 1) * 32 + (swz % 64) / 2; }
struct Unit { int pm, pn; };
struct Gemm { const bf16_t* A; const bf16_t* Bt; int M, N, K; };
struct StaticOrder {
    int nM, nN, nwg, G, c;
    __host__ __device__ void init(int M_, int N_, int G_, int c_) { nM = M_ / BM; nN = N_ / BM; nwg = nM * nN; G = G_; c = c_; }
    __host__ __device__ bool next(int i, Unit& u) const {
        const long L = (long)i * G + c; if (L >= nwg) return false;
        int wgid = (int)L; { const int q = nwg / NXCD, r = nwg % NXCD, xcd = wgid % NXCD, off = wgid / NXCD; wgid = (xcd < r ? xcd * (q + 1) : r * (q + 1) + (xcd - r) * q) + off; }
        const int nig = WGM * nN, gid = wgid / nig, fm = gid * WGM, gsz = (nM - fm) < WGM ? (nM - fm) : WGM;
        u.pm = fm + ((wgid % nig) % gsz); u.pn = (wgid % nig) / gsz; return true;
    }
};

template <class Epi, bool ALIGN_EPI = true, bool SP2 = true>
__device__ __forceinline__ void gemm_phase(LAS unsigned char* lds, const Gemm g, const StaticOrder& S, const Epi& E, const int tid) {
    const int wid = __builtin_amdgcn_readfirstlane(tid >> 6), lane = tid & 63, wr = wid >> 2, wc = wid & 3, fr = lane & 15, fq = lane >> 4;
    const int K = g.K, nt = K / BK;
    unsigned voffA[2];
#pragma unroll
    for (int i = 0; i < 2; ++i) { int R, C; stage_rc(tid * 16 + i * 8192, R, C); voffA[i] = (unsigned)(R * K + C) * 2u; }
    const size_t kstep = (size_t)(BK * 2);
    const size_t hstep = (size_t)HALF * K * 2;
    const size_t tstep = 2 * hstep;
    const unsigned ldsw = (unsigned)wid * 1024u;
    const int aoff = lds_byte(wr * 64 + fr, fq * 8), boff = lds_byte(wc * 32 + fr, fq * 8);
#define PG8_SA(b, h) (((b) * 2 + (h)) * HTB)
#define PG8_SB(b, h) ((4 + (b) * 2 + (h)) * HTB)
#define PG8_STAGE(bufoff, gbase, voff) do { _Pragma("unroll") for (int _i = 0; _i < 2; ++_i) \
        __builtin_amdgcn_global_load_lds((const unsigned*)((const char*)(gbase) + (voff)[_i]), (LAS unsigned*)(lds + (bufoff) + ldsw + _i * 8192), 16, 0, 0); } while (0)
#define PG8_LDA(dst, b, h) do { _Pragma("unroll") for (int m = 0; m < 4; ++m) _Pragma("unroll") for (int k = 0; k < 2; ++k) dst[m][k] = *(const LAS bf16x8*)(lds + PG8_SA(b, h) + aoff + m * 2048 + k * 1024); } while (0)
#define PG8_LDB(dst, b, h) do { _Pragma("unroll") for (int n = 0; n < 2; ++n) _Pragma("unroll") for (int k = 0; k < 2; ++k) dst[n][k] = *(const LAS bf16x8*)(lds + PG8_SB(b, h) + boff + n * 2048 + k * 1024); } while (0)
#define PG8_MMA(ai, bj, At, Bt) do { __builtin_amdgcn_s_setprio(1); _Pragma("unroll") for (int m = 0; m < 4; ++m) _Pragma("unroll") for (int n = 0; n < 2; ++n) _Pragma("unroll") for (int k = 0; k < 2; ++k) \
        acc[ai][bj][m][n] = __builtin_amdgcn_mfma_f32_16x16x32_bf16(Bt[n][k], At[m][k], acc[ai][bj][m][n], 0, 0, 0); __builtin_amdgcn_s_setprio(0); } while (0)
#define PG8_WAIT_V(n) asm volatile("s_waitcnt vmcnt(" #n ")" ::: "memory")
#define PG8_WAIT_L(n) asm volatile("s_waitcnt lgkmcnt(" #n ")" ::: "memory")
#define PG8_BAR __builtin_amdgcn_s_barrier()
#define PG8_SCHED __builtin_amdgcn_sched_barrier(0)
    Unit cur, nxt; int ui = 0;
    if (!S.next(0, cur)) return;
    f32x4 acc[2][2][4][2];
#pragma unroll
    for (int a = 0; a < 2; ++a)
#pragma unroll
        for (int b = 0; b < 2; ++b)
#pragma unroll
            for (int m = 0; m < 4; ++m)
#pragma unroll
                for (int n = 0; n < 2; ++n) acc[a][b][m][n] = (f32x4){0.f, 0.f, 0.f, 0.f};
    bf16x8 At[4][2], B0[2][2], B1[2][2];
    const char* cA = (const char*)g.A + (size_t)cur.pm * tstep; const char* cB = (const char*)g.Bt + (size_t)cur.pn * tstep;
    {
        PG8_STAGE(PG8_SB(0, 0), cB, voffA); PG8_STAGE(PG8_SB(0, 1), cB + hstep, voffA); PG8_STAGE(PG8_SA(0, 0), cA, voffA); PG8_STAGE(PG8_SA(0, 1), cA + hstep, voffA);
        if (wr == 1) PG8_BAR;
        PG8_WAIT_V(2); PG8_BAR;
        PG8_STAGE(PG8_SB(1, 0), cB + kstep, voffA); PG8_STAGE(PG8_SA(1, 0), cA + kstep, voffA); PG8_STAGE(PG8_SB(1, 1), cB + hstep + kstep, voffA);
        PG8_WAIT_V(6); PG8_BAR;
    }
    for (;;) {
        const bool has_next = S.next(ui + 1, nxt);
        const char* nA = has_next ? (const char*)g.A + (size_t)nxt.pm * tstep : cA; const char* nB = has_next ? (const char*)g.Bt + (size_t)nxt.pn * tstep : cB;
        for (int t = 0; t < nt; t += 2) {
            const bool last = (t == nt - 2);
            const char* a1 = cA + (size_t)(t + 1) * kstep;
            const char* a2 = last ? nA : cA + (size_t)(t + 2) * kstep; const char* b2 = last ? nB : cB + (size_t)(t + 2) * kstep;
            const char* a3 = a2 + kstep; const char* b3 = b2 + kstep;
            PG8_LDB(B0, 0, 0); PG8_LDB(B1, 0, 1); PG8_SCHED; PG8_LDA(At, 0, 0); PG8_STAGE(PG8_SA(1, 1), a1 + hstep, voffA);
            PG8_WAIT_V(8); PG8_WAIT_L(0); PG8_BAR; PG8_MMA(0, 0, At, B0); PG8_MMA(0, 1, At, B1); PG8_BAR; PG8_SCHED;
            PG8_LDA(At, 0, 1); PG8_STAGE(PG8_SB(0, 0), b2, voffA); PG8_STAGE(PG8_SB(0, 1), b2 + hstep, voffA); PG8_STAGE(PG8_SA(0, 0), a2, voffA);
            PG8_WAIT_V(8); PG8_WAIT_L(0); PG8_BAR; PG8_MMA(1, 0, At, B0); PG8_MMA(1, 1, At, B1); PG8_BAR; PG8_SCHED;
            PG8_LDB(B0, 1, 0); PG8_LDB(B1, 1, 1); PG8_SCHED; PG8_LDA(At, 1, 0); PG8_STAGE(PG8_SA(0, 1), a2 + hstep, voffA);
            PG8_WAIT_V(8); PG8_WAIT_L(0); PG8_BAR; PG8_MMA(0, 0, At, B0); PG8_MMA(0, 1, At, B1); PG8_BAR; PG8_SCHED;
            PG8_LDA(At, 1, 1); PG8_STAGE(PG8_SB(1, 0), b3, voffA); PG8_STAGE(PG8_SB(1, 1), b3 + hstep, voffA); PG8_STAGE(PG8_SA(1, 0), a3, voffA);
            PG8_WAIT_V(8); PG8_WAIT_L(0); PG8_BAR; PG8_MMA(1, 0, At, B0); PG8_MMA(1, 1, At, B1); PG8_BAR; PG8_SCHED;
        }
        if constexpr (ALIGN_EPI) { if (wr == 0) PG8_BAR; }
        E(acc, cur, wr, wc, fr, fq);
        if (!has_next) break;
#pragma unroll
        for (int a = 0; a < 2; ++a)
#pragma unroll
            for (int b = 0; b < 2; ++b)
#pragma unroll
                for (int m = 0; m < 4; ++m)
#pragma unroll
                    for (int n = 0; n < 2; ++n) acc[a][b][m][n] = (f32x4){0.f, 0.f, 0.f, 0.f};
        cur = nxt; cA = nA; cB = nB; ++ui;
        if constexpr (ALIGN_EPI) { if (wr == 1) PG8_BAR; }
    }
    PG8_WAIT_V(0);
    if constexpr (!ALIGN_EPI) { if (wr == 0) PG8_BAR; }
    PG8_BAR;
#undef PG8_SA
#undef PG8_SB
#undef PG8_STAGE
#undef PG8_LDA
#undef PG8_LDB
#undef PG8_MMA
#undef PG8_WAIT_V
#undef PG8_WAIT_L
#undef PG8_BAR
#undef PG8_SCHED
}
}
using pg8::Unit;


#define GLD4(base, boff) (*(const f32x4*)((const char*)(base) + (unsigned)(boff)))
#define GST4(base, boff, v) (*(f32x4*)((char*)(base) + (unsigned)(boff)) = (v))
#define GST2(base, boff, v) (*(u32x2*)((char*)(base) + (unsigned)(boff)) = (v))
#define GLD1(base, boff) (*(const float*)((const char*)(base) + (unsigned)(boff)))

template <int LAYER> struct EpiIn {
    const float* ssq; const float* shw; int N; bf16_t* P; const float* gq; const float* gk;
    __device__ __forceinline__ void operator()(const f32x4 (&acc)[2][2][4][2], const Unit& u, int wr, int wc, int fr_in, int fq_in) const {
        int fr = fr_in, fq = fq_in; asm volatile("" : "+v"(fr), "+v"(fq));
        const int b = u.pm >> 3; const int lane_e = fq * 16 + fr;
        bf16_t* base; int ld, col0, mode;
        if (LAYER == 0) { const int region = u.pn >> 1; base = P + (size_t)region * M * 512; ld = 512; col0 = (u.pn & 1) * 256; mode = region == 2 ? 1 : (region == 3 ? 2 : 0); }
        else {
            if (u.pn < 4) { base = P; ld = 1024; col0 = u.pn * 256; mode = 1; }
            else if (u.pn == 4) { base = P + (size_t)M * 1024; ld = 256; col0 = 0; mode = 2; }
            else { base = P + (size_t)M * 1024 + (size_t)M * 256; ld = 256; col0 = 0; mode = 0; }
        }
        const float* bias = shw + (size_t)b * N + u.pn * 256;
        const unsigned boff = (unsigned)(wc * 32 + 4 * fq) * 4u;
        f32x4 bv[2][2];
#pragma unroll
        for (int bj = 0; bj < 2; ++bj)
#pragma unroll
            for (int n = 0; n < 2; ++n) bv[bj][n] = GLD4(bias, boff + (bj * 128 + n * 16) * 4);
        const int row0 = u.pm * 256 + wr * 64 + fr;
        float rsv[2][4];
#pragma unroll
        for (int ai = 0; ai < 2; ++ai)
#pragma unroll
            for (int m = 0; m < 4; ++m) rsv[ai][m] = GLD1(ssq, (unsigned)row0 * 4u + (ai * 128 + m * 16) * 4);
#pragma unroll
        for (int ai = 0; ai < 2; ++ai)
#pragma unroll
            for (int m = 0; m < 4; ++m) rsv[ai][m] = rsqrtf(rsv[ai][m] * (1.0f / 1024.0f) + EPS);
        const unsigned ldb = (unsigned)ld * 2u;
        if (mode == 0) {
            const unsigned o0 = (unsigned)row0 * ldb + (unsigned)(col0 + wc * 32 + 4 * fq) * 2u;
#pragma unroll
            for (int ai = 0; ai < 2; ++ai)
#pragma unroll
                for (int m = 0; m < 4; ++m) {
                    const float rs = rsv[ai][m];
                    const unsigned ro = o0 + (unsigned)(ai * 128 + m * 16) * ldb;
#pragma unroll
                    for (int bj = 0; bj < 2; ++bj)
#pragma unroll
                        for (int n = 0; n < 2; ++n) { const f32x4 v = acc[ai][bj][m][n] * rs + bv[bj][n]; u32x2 w; w.x = pk2(v[0], v[1]); w.y = pk2(v[2], v[3]); GST2(base, ro + (bj * 128 + n * 16) * 2, w); }
                }
        } else {
            const float* gn = (mode == 1) ? gq : gk; const float sc = (mode == 1) ? QSCALE : 1.0f;
            f32x4 gv[2][2];
#pragma unroll
            for (int bj = 0; bj < 2; ++bj)
#pragma unroll
                for (int n = 0; n < 2; ++n) gv[bj][n] = GLD4(gn, (unsigned)(4 * fq) * 4u + (32 * bj + 16 * n) * 4) * sc;
            const unsigned o0 = (unsigned)row0 * ldb + (unsigned)(col0 + 64 * wc + 4 * fq) * 2u;
#pragma unroll
            for (int ai = 0; ai < 2; ++ai)
#pragma unroll
                for (int m = 0; m < 4; ++m) {
                    const float rs = rsv[ai][m];
                    f32x4 v[2][2]; float ss = 0.f;
#pragma unroll
                    for (int bj = 0; bj < 2; ++bj)
#pragma unroll
                        for (int n = 0; n < 2; ++n) { v[bj][n] = acc[ai][bj][m][n] * rs + bv[bj][n]; const f32x4 q = v[bj][n] * v[bj][n]; ss += (q[0] + q[1]) + (q[2] + q[3]); }
                    ss += sx(ss, 16, lane_e); ss += sx(ss, 32, lane_e);
                    const float hr = rsqrtf(ss * (1.0f / 64.0f) + EPS);
                    const unsigned ro = o0 + (unsigned)(ai * 128 + m * 16) * ldb;
#pragma unroll
                    for (int bj = 0; bj < 2; ++bj)
#pragma unroll
                        for (int n = 0; n < 2; ++n) { const f32x4 o = v[bj][n] * hr * gv[bj][n]; u32x2 w; w.x = pk2(o[0], o[1]); w.y = pk2(o[2], o[3]); GST2(base, ro + (32 * bj + 16 * n) * 2, w); }
                }
        }
    }
};

#define GLD2(base, boff) (*(const u32x2*)((const char*)(base) + (unsigned)(boff)))
template <bool IN_F32, bool OUT_F32, bool LAST> struct EpiRes {
    const void* xin; void* xout; const float* gate; const float* ng; const float* nsc; bf16_t* xg; float* ssq;
    __device__ __forceinline__ void operator()(const f32x4 (&acc)[2][2][4][2], const Unit& u, int wr, int wc, int fr_in, int fq_in) const {
        int fr = fr_in, fq = fq_in; asm volatile("" : "+v"(fr), "+v"(fq));
        const int b = u.pm >> 3; const int lane_e = fq * 16 + fr; (void)lane_e;
        const int col = u.pn * 256 + wc * 32 + 4 * fq;
        const float* gtp = gate + (size_t)b * 6144; const float* nsp = LAST ? gate : nsc + (size_t)b * 6144;
        f32x4 gt[2][2], gm[2][2];
#pragma unroll
        for (int bj = 0; bj < 2; ++bj)
#pragma unroll
            for (int n = 0; n < 2; ++n) {
                const unsigned co = (unsigned)col * 4u + (bj * 128 + n * 16) * 4;
                gt[bj][n] = GLD4(gtp, co);
                if (!LAST) gm[bj][n] = GLD4(ng, co) * (GLD4(nsp, co) + 1.0f);
            }
        const int row0 = u.pm * 256 + wr * 64 + fr;
        const unsigned e0 = (unsigned)row0 * 1024u + (unsigned)col;
#pragma unroll
        for (int hb = 0; hb < 4; ++hb) {
            const int ai = hb >> 1;
            f32x4 xi[2][2][2];
#pragma unroll
            for (int mm = 0; mm < 2; ++mm)
#pragma unroll
                for (int bj = 0; bj < 2; ++bj)
#pragma unroll
                    for (int n = 0; n < 2; ++n) {
                        const unsigned eo = e0 + (unsigned)((ai * 128 + ((hb & 1) * 2 + mm) * 16) * 1024 + bj * 128 + n * 16);
                        if (IN_F32) xi[mm][bj][n] = GLD4(xin, eo * 4u);
                        else { const u32x2 r2 = GLD2(xin, eo * 2u); xi[mm][bj][n] = (f32x4){bflo(r2.x), bfhi(r2.x), bflo(r2.y), bfhi(r2.y)}; }
                    }
#pragma unroll
            for (int mm = 0; mm < 2; ++mm) {
                const int m = (hb & 1) * 2 + mm;
                const unsigned ro = e0 + (unsigned)((ai * 128 + m * 16) * 1024);
                float s = 0.f;
#pragma unroll
                for (int bj = 0; bj < 2; ++bj)
#pragma unroll
                    for (int n = 0; n < 2; ++n) {
                        const f32x4 v = xi[mm][bj][n] + gt[bj][n] * acc[ai][bj][m][n];
                        const unsigned eo = ro + (unsigned)(bj * 128 + n * 16);
                        if (OUT_F32) GST4(xout, eo * 4u, v);
                        else { u32x2 w; w.x = pk2(v[0], v[1]); w.y = pk2(v[2], v[3]); GST2(xout, eo * 2u, w); }
                        if (!LAST) {
                            const f32x4 q = v * v; s += (q[0] + q[1]) + (q[2] + q[3]);
                            const f32x4 o = v * gm[bj][n]; u32x2 w; w.x = pk2(o[0], o[1]); w.y = pk2(o[2], o[3]); GST2(xg, eo * 2u, w);
                        }
                    }
                if (!LAST) { s += sx(s, 16, lane_e); s += sx(s, 32, lane_e); if (fq == 0) unsafeAtomicAdd(ssq + (row0 + ai * 128 + m * 16), s); }
            }
        }
    }
};

__device__ __forceinline__ f32x4 silu4(f32x4 a) {
    f32x4 r;
#pragma unroll
    for (int e = 0; e < 4; ++e) r[e] = a[e] * __builtin_amdgcn_rcpf(1.0f + __builtin_amdgcn_exp2f(-a[e] * LOG2E));
    return r;
}
template <int N_> __device__ __forceinline__ f32x4 ror4(f32x4 v) {
    f32x4 r;
#pragma unroll
    for (int e = 0; e < 4; ++e) r[e] = __int_as_float(__builtin_amdgcn_update_dpp(0, __float_as_int(v[e]), 0x120 + N_, 0xf, 0xf, false));
    return r;
}
struct EpiGU {
    const float* ssq; const float* shw; const float* cw; const float* cbias; bf16_t* act; float* halo; float* fixp; float* fixu;
    __device__ __forceinline__ void operator()(const f32x4 (&acc)[2][2][4][2], const Unit& u, int wr, int wc, int fr_in, int fq_in) const {
        int fr = fr_in, fq = fq_in; asm volatile("" : "+v"(fr), "+v"(fq));
        const int b = u.pm >> 3;
        const int fcol = u.pn * 128 + wc * 32 + 4 * fq;
        const float* bias = shw + (size_t)b * 5632 + u.pn * 256;
        const unsigned boff = (unsigned)(wc * 32 + 4 * fq) * 4u;
        const int row0 = u.pm * 256 + wr * 64 + fr;
        float rsv[2][4];
#pragma unroll
        for (int ai = 0; ai < 2; ++ai)
#pragma unroll
            for (int m = 0; m < 4; ++m) rsv[ai][m] = GLD1(ssq, (unsigned)row0 * 4u + (ai * 128 + m * 16) * 4);
#pragma unroll
        for (int ai = 0; ai < 2; ++ai)
#pragma unroll
            for (int m = 0; m < 4; ++m) rsv[ai][m] = rsqrtf(rsv[ai][m] * (1.0f / 1024.0f) + EPS);
        const unsigned aoff0 = ((unsigned)row0 * (unsigned)FF + (unsigned)fcol) * 2u;
#pragma unroll
        for (int n = 0; n < 2; ++n) {
            const f32x4 bg = GLD4(bias, boff + n * 64), bu = GLD4(bias, boff + 512 + n * 64);
            const unsigned co = (unsigned)fcol * 4u + n * 64;
            const f32x4 w0 = GLD4(cw, co), w1 = GLD4(cw, co + FF * 4), w2 = GLD4(cw, co + 2 * FF * 4);
            const f32x4 cb = GLD4(cbias, co);
#pragma unroll
            for (int ai = 0; ai < 2; ++ai) {
                const int gs = u.pm * 4 + ai * 2 + wr;
                f32x4 p1 = (f32x4){0.f, 0.f, 0.f, 0.f}, p2 = p1;
#pragma unroll
                for (int m = 0; m < 4; ++m) {
                    const float rs = rsv[ai][m];
                    const f32x4 g = acc[ai][0][m][n] * rs + bg;
                    const f32x4 up = acc[ai][1][m][n] * rs + bu;
                    const f32x4 c1 = ror4<1>(g), c2 = ror4<2>(g);
                    const f32x4 g1 = fr >= 1 ? c1 : p1;
                    const f32x4 g2 = fr >= 2 ? c2 : p2;
                    if (m == 0 && fr < 2) {
                        f32x4 pp = w2 * g + cb; if (fr == 1) pp = pp + w1 * g1;
                        const unsigned fo = ((unsigned)(gs * 2 + fr) * (unsigned)FF + (unsigned)fcol) * 4u + n * 64;
                        GST4(fixp, fo, pp); GST4(fixu, fo, up);
                    } else {
                        const f32x4 a = w2 * g + w1 * g1 + w0 * g2 + cb;
                        const f32x4 o = silu4(a) * up;
                        u32x2 w; w.x = pk2(o[0], o[1]); w.y = pk2(o[2], o[3]);
                        GST2(act, aoff0 + (unsigned)((ai * 128 + m * 16) * FF) * 2u + n * 32, w);
                    }
                    if (m == 3 && fr >= 14) GST4(halo, ((unsigned)(gs * 2 + (fr - 14)) * (unsigned)FF + (unsigned)fcol) * 4u + n * 64, g);
                    p1 = c1; p2 = c2;
                }
            }
        }
    }
};

#define MFMA32(a, b, c) __builtin_amdgcn_mfma_f32_32x32x16_bf16((a), (b), (c), 0, 0, 0)
__device__ __forceinline__ int crow(int i, int h) { return (i & 3) + 8 * (i >> 2) + 4 * h; }
__device__ __forceinline__ bf16x8 pack8(float a0, float a1, float a2, float a3, float a4, float a5, float a6, float a7) {
    u32x4 p; p.x = pk2(a0, a1); p.y = pk2(a2, a3); p.z = pk2(a4, a5); p.w = pk2(a6, a7); return __builtin_bit_cast(bf16x8, p);
}
__device__ __forceinline__ bf16x8 tr8(const LAS unsigned char* p_lo, int hi_off) {
    const s16x4 lo = __builtin_amdgcn_ds_read_tr16_b64_v4i16((LAS s16x4*)p_lo);
    const s16x4 hi = __builtin_amdgcn_ds_read_tr16_b64_v4i16((LAS s16x4*)(p_lo + hi_off));
    return __builtin_shufflevector(lo, hi, 0, 1, 2, 3, 4, 5, 6, 7);
}

constexpr int KSTR = 144, VSTR = 192, KBUF = 64 * KSTR, VBUF = 64 * VSTR, SB_VOFF = 2 * KBUF, SB_FLAG = SB_VOFF + 2 * VBUF;
__device__ __forceinline__ void sb_unit(LAS unsigned char* lds, const bf16_t* Q, const bf16_t* K, const bf16_t* V, bf16_t* Y, int b, int h, int qb, int tid, int wid, int lane) {
    const int r = lane & 31, hh = lane >> 5;
    const int q0 = qb * 256, qw0 = q0 + 32 * wid, qblk = qw0 >> 5;
    const size_t rowbase = (size_t)b * SEQ;
    bf16x8 qf[4];
    { const bf16_t* qp = Q + (rowbase + qw0 + r) * 512 + h * 64 + 8 * hh;
#pragma unroll
      for (int s = 0; s < 4; ++s) qf[s] = *(const bf16x8*)(qp + 16 * s); }
    f32x16 O0, O1;
#pragma unroll
    for (int i = 0; i < 16; ++i) { O0[i] = 0.f; O1[i] = 0.f; }
    float carry = 0.f;
    const int nkt = 4 * qb + 4;
    const int srow = tid >> 3, spc = tid & 7;
    const bf16_t* kg = K + (rowbase + srow) * 512 + h * 64 + spc * 8;
    const bf16_t* vg = V + (rowbase + srow) * 512 + h * 64 + spc * 8;
    LAS unsigned* flags = (LAS unsigned*)(lds + SB_FLAG);
    __syncthreads();
    u32x4 kreg = *(const u32x4*)(kg + (size_t)(nkt - 1) * 64 * 512), vreg = *(const u32x4*)(vg + (size_t)(nkt - 1) * 64 * 512);
    *(LAS u32x4*)(lds + srow * KSTR + spc * 16) = kreg; *(LAS u32x4*)(lds + SB_VOFF + srow * VSTR + spc * 16) = vreg;
    __syncthreads();
    int cur = 0;
    const int q4 = (lane & 15) >> 2, p4 = lane & 3, blk = (lane >> 4) & 1;
    const int vlane_off = (4 * hh + q4) * VSTR + 8 * (4 * blk + p4);
    for (int kt = nkt - 1; kt >= 0; --kt) {
        if (kt > 0) { kreg = *(const u32x4*)(kg + (size_t)(kt - 1) * 64 * 512); vreg = *(const u32x4*)(vg + (size_t)(kt - 1) * 64 * 512); }
        const LAS unsigned char* kb_ = lds + cur * KBUF; const LAS unsigned char* vb_ = lds + SB_VOFF + cur * VBUF;
        bool wdone = __all(carry >= 160.0f);
        if (!wdone) {
#pragma unroll
            for (int kb = 1; kb >= 0; --kb) {
                const int kb32 = 2 * kt + kb;
                if (kb32 <= qblk) {
                    const bool diag = (kb32 == qblk);
                    f32x16 z;
#pragma unroll
                    for (int i = 0; i < 16; ++i) z[i] = 0.f;
#pragma unroll
                    for (int s = 0; s < 4; ++s) { const bf16x8 a = *(const LAS bf16x8*)(kb_ + (32 * kb + r) * KSTR + 32 * s + 16 * hh); z = MFMA32(a, qf[s], z); }
                    float sp[16];
#pragma unroll
                    for (int i = 0; i < 16; ++i) {
                        const float e = __builtin_amdgcn_exp2f(z[i]);
                        float v = __builtin_amdgcn_logf(1.0f + e);
                        if (diag && !(crow(i, hh) < r)) v = 0.f;
                        sp[i] = v;
                    }
                    float G[4], Gp[4];
#pragma unroll
                    for (int g = 0; g < 4; ++g) { G[g] = (sp[4 * g] + sp[4 * g + 1]) + (sp[4 * g + 2] + sp[4 * g + 3]); Gp[g] = sx(G[g], 32, lane); }
                    float suf = carry; float w[16];
#pragma unroll
                    for (int g = 3; g >= 0; --g) {
                        float run = suf + (hh == 0 ? Gp[g] : 0.f);
#pragma unroll
                        for (int i = 4 * g + 3; i >= 4 * g; --i) {
                            run += sp[i];
                            float wv = __builtin_amdgcn_exp2f(z[i] - run);
                            if (diag && !(crow(i, hh) < r)) wv = 0.f;
                            w[i] = wv;
                        }
                        suf += G[g] + Gp[g];
                    }
                    carry = suf;
#pragma unroll
                    for (int s = 0; s < 2; ++s) {
                        const bf16x8 pf = pack8(w[8 * s], w[8 * s + 1], w[8 * s + 2], w[8 * s + 3], w[8 * s + 4], w[8 * s + 5], w[8 * s + 6], w[8 * s + 7]);
                        const LAS unsigned char* vp = vb_ + (32 * kb + 16 * s) * VSTR + vlane_off;
                        const bf16x8 a0 = tr8(vp, 8 * VSTR), a1 = tr8(vp + 64, 8 * VSTR);
                        O0 = MFMA32(a0, pf, O0); O1 = MFMA32(a1, pf, O1);
                    }
                }
            }
            wdone = __all(carry >= 160.0f);
        }
        if (kt > 0) { *(LAS u32x4*)(lds + (cur ^ 1) * KBUF + srow * KSTR + spc * 16) = kreg; *(LAS u32x4*)(lds + SB_VOFF + (cur ^ 1) * VBUF + srow * VSTR + spc * 16) = vreg; }
        if (lane == 0) flags[(kt & 1) * 8 + wid] = wdone ? 1u : 0u;
        __syncthreads();
        unsigned alld = 1u;
#pragma unroll
        for (int w8 = 0; w8 < 8; ++w8) alld &= flags[(kt & 1) * 8 + w8];
        if (alld) break;
        cur ^= 1;
    }
    bf16_t* yp = Y + (rowbase + qw0 + r) * 1024 + 512 + h * 64 + 4 * hh;
#pragma unroll
    for (int g = 0; g < 4; ++g) {
        u32x2 w0; w0.x = pk2(O0[4 * g], O0[4 * g + 1]); w0.y = pk2(O0[4 * g + 2], O0[4 * g + 3]); *(u32x2*)(yp + 8 * g) = w0;
        u32x2 w1; w1.x = pk2(O1[4 * g], O1[4 * g + 1]); w1.y = pk2(O1[4 * g + 2], O1[4 * g + 3]); *(u32x2*)(yp + 32 + 8 * g) = w1;
    }
}

constexpr int SW_VOFF = 192 * KSTR;
__device__ __forceinline__ void swa_unit(LAS unsigned char* lds, const bf16_t* Q, const bf16_t* K, const bf16_t* V, const float* sinks, bf16_t* Y, int b, int kvh, int qc, int tid, int wid, int lane) {
    const int r = lane & 31, hh = lane >> 5;
    const int head = 4 * kvh + (wid >> 1), qsub = wid & 1;
    const int qw0 = 64 * qc + 32 * qsub;
    const size_t rowbase = (size_t)b * SEQ;
    const int kbase = 64 * qc - 128;
    __syncthreads();
#pragma unroll
    for (int it = 0; it < 3; ++it) {
        const int idx = tid + it * 512, srow = idx >> 3, spc = idx & 7, kpos = kbase + srow;
        u32x4 kv = (u32x4){0u, 0u, 0u, 0u}, vv = (u32x4){0u, 0u, 0u, 0u};
        if (kpos >= 0) { kv = *(const u32x4*)(K + (rowbase + kpos) * 256 + kvh * 64 + spc * 8); vv = *(const u32x4*)(V + (rowbase + kpos) * 256 + kvh * 64 + spc * 8); }
        *(LAS u32x4*)(lds + srow * KSTR + spc * 16) = kv; *(LAS u32x4*)(lds + SW_VOFF + srow * VSTR + spc * 16) = vv;
    }
    bf16x8 qf[4];
    { const bf16_t* qp = Q + (rowbase + qw0 + r) * 1024 + head * 64 + 8 * hh;
#pragma unroll
      for (int s = 0; s < 4; ++s) qf[s] = *(const bf16x8*)(qp + 16 * s); }
    __syncthreads();
    f32x16 O0, O1;
#pragma unroll
    for (int i = 0; i < 16; ++i) { O0[i] = 0.f; O1[i] = 0.f; }
    float mrun = sinks[head] * LOG2E, lsum = (hh == 0) ? 1.0f : 0.0f;
    const int q4 = (lane & 15) >> 2, p4 = lane & 3, blk = (lane >> 4) & 1;
    const int vlane_off = (4 * hh + q4) * VSTR + 8 * (4 * blk + p4);
#pragma unroll
    for (int j = 0; j < 5; ++j) {
        const int rb = qsub + j;
        const int key0 = kbase + 32 * rb;
        if (key0 >= 0) {
            f32x16 z;
#pragma unroll
            for (int i = 0; i < 16; ++i) z[i] = 0.f;
#pragma unroll
            for (int s = 0; s < 4; ++s) { const bf16x8 a = *(const LAS bf16x8*)(lds + (32 * rb + r) * KSTR + 32 * s + 16 * hh); z = MFMA32(a, qf[s], z); }
            float bm = -3.0e38f;
#pragma unroll
            for (int i = 0; i < 16; ++i) {
                bool valid = true;
                if (j == 0) valid = (crow(i, hh) > r);
                if (j == 4) valid = (crow(i, hh) <= r);
                if (!valid) z[i] = -3.0e38f;
                bm = fmaxf(bm, z[i]);
            }
            bm = fmaxf(bm, sx(bm, 32, lane));
            const float mnew = fmaxf(mrun, bm);
            const float alpha = __builtin_amdgcn_exp2f(mrun - mnew);
            mrun = mnew;
            float w[16]; float ps = 0.f;
#pragma unroll
            for (int i = 0; i < 16; ++i) { w[i] = __builtin_amdgcn_exp2f(z[i] - mnew); ps += w[i]; }
            lsum = lsum * alpha + ps;
#pragma unroll
            for (int i = 0; i < 16; ++i) { O0[i] *= alpha; O1[i] *= alpha; }
#pragma unroll
            for (int s = 0; s < 2; ++s) {
                const bf16x8 pf = pack8(w[8 * s], w[8 * s + 1], w[8 * s + 2], w[8 * s + 3], w[8 * s + 4], w[8 * s + 5], w[8 * s + 6], w[8 * s + 7]);
                const LAS unsigned char* vp = lds + SW_VOFF + (32 * rb + 16 * s) * VSTR + vlane_off;
                const bf16x8 a0 = tr8(vp, 8 * VSTR), a1 = tr8(vp + 64, 8 * VSTR);
                O0 = MFMA32(a0, pf, O0); O1 = MFMA32(a1, pf, O1);
            }
        }
    }
    lsum += sx(lsum, 32, lane);
    const float inv = 1.0f / lsum;
    bf16_t* yp = Y + (rowbase + qw0 + r) * 1024 + head * 64 + 4 * hh;
#pragma unroll
    for (int g = 0; g < 4; ++g) {
        u32x2 w0; w0.x = pk2(O0[4 * g] * inv, O0[4 * g + 1] * inv); w0.y = pk2(O0[4 * g + 2] * inv, O0[4 * g + 3] * inv); *(u32x2*)(yp + 8 * g) = w0;
        u32x2 w1; w1.x = pk2(O1[4 * g] * inv, O1[4 * g + 1] * inv); w1.y = pk2(O1[4 * g + 2] * inv, O1[4 * g + 3] * inv); *(u32x2*)(yp + 32 + 8 * g) = w1;
    }
}

constexpr int XCS = 68;
constexpr int LR_RAWSTR = 144, LR_GR = 37376, LR_XCW = 53760, LR_EXCH = 123392, LR_CW = 125440  , LR_WF = 126720  ;
struct LruArgs { const bf16_t* XR; const bf16_t* GR; bf16_t* Y; const float* convw; const float* convb; const float* wa; const float* ba; const float* wx; const float* bx; const float* lam; };
__device__ __forceinline__ void lru_item(LAS unsigned char* lds, const LruArgs& A, int item, int tid, int wid, int lane) {
    const int b = item >> 4, n = (item >> 1) & 7, half = item & 1;
    const int r = lane & 31, hh = lane >> 5;
    const int co = lane & 7, tsub = lane >> 3;
    const size_t rowbase = (size_t)b * SEQ;
    LAS float* xcw = (LAS float*)(lds + LR_XCW + wid * (32 * XCS * 4));
    LAS float* exch = (LAS float*)(lds + LR_EXCH);
    __syncthreads();
    {
        LAS float* cwl = (LAS float*)(lds + LR_CW);
#pragma unroll
        for (int k = 0; k < 4; ++k)
#pragma unroll
            for (int j = 0; j < 8; ++j) cwl[k * 64 + 8 * co + j] = A.convw[k * 512 + 64 * n + 8 * co + j];
#pragma unroll
        for (int j = 0; j < 8; ++j) cwl[256 + 8 * co + j] = A.convb[64 * n + 8 * co + j];
#pragma unroll
        for (int s = 0; s < 4; ++s) {
            float ta[8], tx[8];
#pragma unroll
            for (int j = 0; j < 8; ++j) { const int idx = (n * 64 + 16 * s + 8 * hh + j) * 64 + 32 * half + r; ta[j] = A.wa[idx]; tx[j] = A.wx[idx]; }
            *(LAS bf16x8*)(lds + LR_WF + (2 * s) * 1024 + lane * 16) = pack8(ta[0], ta[1], ta[2], ta[3], ta[4], ta[5], ta[6], ta[7]);
            *(LAS bf16x8*)(lds + LR_WF + (2 * s + 1) * 1024 + lane * 16) = pack8(tx[0], tx[1], tx[2], tx[3], tx[4], tx[5], tx[6], tx[7]);
        }
    }
    const int c = 64 * n + 32 * half + r;
    const float ba_c = A.ba[c], bx_c = A.bx[c];
    const float lam_c = A.lam[c];
    const float spl2 = 8.0f * (fmaxf(-lam_c, 0.f) + log1pf(expf(-fabsf(lam_c)))) * LOG2E;
    u32x4 praw[5], pgr[2];
    const bf16_t* xrb = A.XR + rowbase * 512 + 64 * n;
    const bf16_t* grb = A.GR + rowbase * 512 + 64 * n + 32 * half;
#define LRU_LOAD(cc) do { \
        _Pragma("unroll") for (int i_ = 0; i_ < 5; ++i_) { const int idx = tid + 512 * i_, j = idx >> 3, pc = idx & 7, pos = 256 * (cc) - 3 + j; \
            praw[i_] = (u32x4){0u, 0u, 0u, 0u}; if (idx < 2072 && pos >= 0) praw[i_] = *(const u32x4*)(xrb + (size_t)pos * 512 + 8 * pc); } \
        _Pragma("unroll") for (int i_ = 0; i_ < 2; ++i_) { const int idx = tid + 512 * i_, j = idx >> 2, pc = idx & 3; \
            pgr[i_] = *(const u32x4*)(grb + (size_t)(256 * (cc) + j) * 512 + 8 * pc); } } while (0)
    LRU_LOAD(0);
    float carry = 0.f;
    for (int cch = 0; cch < 8; ++cch) {
        __syncthreads();
#pragma unroll
        for (int i_ = 0; i_ < 5; ++i_) { const int idx = tid + 512 * i_; if (idx < 2072) *(LAS u32x4*)(lds + (idx >> 3) * LR_RAWSTR + (idx & 7) * 16) = praw[i_]; }
#pragma unroll
        for (int i_ = 0; i_ < 2; ++i_) { const int idx = tid + 512 * i_; *(LAS u32x4*)(lds + LR_GR + (idx >> 2) * 64 + (idx & 3) * 16) = pgr[i_]; }
        if (cch < 7) LRU_LOAD(cch + 1);
        __syncthreads();
        float cw[4][8], cbv[8];
        {
            const LAS float* cwl = (const LAS float*)(lds + LR_CW);
#pragma unroll
            for (int k = 0; k < 4; ++k) { const f32x4 t0 = *(const LAS f32x4*)(cwl + k * 64 + 8 * co), t1 = *(const LAS f32x4*)(cwl + k * 64 + 8 * co + 4);
                cw[k][0] = t0[0]; cw[k][1] = t0[1]; cw[k][2] = t0[2]; cw[k][3] = t0[3]; cw[k][4] = t1[0]; cw[k][5] = t1[1]; cw[k][6] = t1[2]; cw[k][7] = t1[3]; }
            const f32x4 t0 = *(const LAS f32x4*)(cwl + 256 + 8 * co), t1 = *(const LAS f32x4*)(cwl + 256 + 8 * co + 4);
            cbv[0] = t0[0]; cbv[1] = t0[1]; cbv[2] = t0[2]; cbv[3] = t0[3]; cbv[4] = t1[0]; cbv[5] = t1[1]; cbv[6] = t1[2]; cbv[7] = t1[3];
        }
#pragma unroll
        for (int p = 0; p < 4; ++p) {
            const int tl = 8 * p + tsub;
            float av[8];
#pragma unroll
            for (int j = 0; j < 8; ++j) av[j] = cbv[j];
#pragma unroll
            for (int k = 0; k < 4; ++k) {
                const u32x4 raw = *(const LAS u32x4*)(lds + (32 * wid + tl + k) * LR_RAWSTR + co * 16);
                av[0] += cw[k][0] * bflo(raw.x); av[1] += cw[k][1] * bfhi(raw.x); av[2] += cw[k][2] * bflo(raw.y); av[3] += cw[k][3] * bfhi(raw.y);
                av[4] += cw[k][4] * bflo(raw.z); av[5] += cw[k][5] * bfhi(raw.z); av[6] += cw[k][6] * bflo(raw.w); av[7] += cw[k][7] * bfhi(raw.w);
            }
            *(LAS f32x4*)(xcw + tl * XCS + 8 * co) = (f32x4){av[0], av[1], av[2], av[3]};
            *(LAS f32x4*)(xcw + tl * XCS + 8 * co + 4) = (f32x4){av[4], av[5], av[6], av[7]};
        }
        LDS_WAIT();
        f32x16 R, I;
#pragma unroll
        for (int i = 0; i < 16; ++i) { R[i] = 0.f; I[i] = 0.f; }
#pragma unroll
        for (int s = 0; s < 4; ++s) {
            const f32x4 a0 = *(const LAS f32x4*)(xcw + r * XCS + 16 * s + 8 * hh), a1 = *(const LAS f32x4*)(xcw + r * XCS + 16 * s + 8 * hh + 4);
            const bf16x8 af = pack8(a0[0], a0[1], a0[2], a0[3], a1[0], a1[1], a1[2], a1[3]);
            const bf16x8 wa_f = *(const LAS bf16x8*)(lds + LR_WF + (2 * s) * 1024 + lane * 16), wx_f = *(const LAS bf16x8*)(lds + LR_WF + (2 * s + 1) * 1024 + lane * 16);
            R = MFMA32(af, wa_f, R); I = MFMA32(af, wx_f, I);
        }
        float av_[16], uv_[16];
#pragma unroll
        for (int i = 0; i < 16; ++i) {
            const float xcf = xcw[crow(i, hh) * XCS + 32 * half + r];
            const float rr = __builtin_amdgcn_rcpf(1.0f + __builtin_amdgcn_exp2f(-(R[i] + ba_c) * LOG2E));
            const float ii = __builtin_amdgcn_rcpf(1.0f + __builtin_amdgcn_exp2f(-(I[i] + bx_c) * LOG2E));
            const float la2 = -rr * spl2;
            const float a = __builtin_amdgcn_exp2f(la2);
            const float y = la2 * (2.0f / LOG2E);
            const float om = (y > -0.25f) ? -y * (1.0f + y * (0.5f + y * ((1.0f / 6.0f) + y * ((1.0f / 24.0f) + y * (1.0f / 120.0f))))) : 1.0f - a * a;
            av_[i] = a; uv_[i] = sqrtf(om) * ii * xcf;
        }
        asm volatile("" ::: "memory");
        float Ag[4], Bg[4], pA[4], pB[4];
#pragma unroll
        for (int g = 0; g < 4; ++g) {
            Ag[g] = (av_[4 * g] * av_[4 * g + 1]) * (av_[4 * g + 2] * av_[4 * g + 3]);
            Bg[g] = ((uv_[4 * g] * av_[4 * g + 1] + uv_[4 * g + 1]) * av_[4 * g + 2] + uv_[4 * g + 2]) * av_[4 * g + 3] + uv_[4 * g + 3];
            pA[g] = sx(Ag[g], 32, lane); pB[g] = sx(Bg[g], 32, lane);
        }
        float hcur = 0.f, acur = 1.0f;
#pragma unroll
        for (int g = 0; g < 4; ++g) {
            const float A0 = hh == 0 ? Ag[g] : pA[g], B0 = hh == 0 ? Bg[g] : pB[g];
            const float A1 = hh == 0 ? pA[g] : Ag[g], B1 = hh == 0 ? pB[g] : Bg[g];
            const float s0 = hcur, c0 = acur; hcur = A0 * hcur + B0; acur *= A0;
            const float s1 = hcur, c1 = acur; hcur = A1 * hcur + B1; acur *= A1;
            float hv = hh == 0 ? s0 : s1, ac = hh == 0 ? c0 : c1;
#pragma unroll
            for (int i = 4 * g; i < 4 * g + 4; ++i) { hv = av_[i] * hv + uv_[i]; ac *= av_[i]; uv_[i] = hv; av_[i] = ac; }
        }
        if (hh == 0) { exch[(wid * 32 + r) * 2] = acur; exch[(wid * 32 + r) * 2 + 1] = hcur; }
        __syncthreads();
        float hin = carry, run = carry;
#pragma unroll
        for (int w8 = 0; w8 < 8; ++w8) { if (w8 == wid) hin = run; run = exch[(w8 * 32 + r) * 2] * run + exch[(w8 * 32 + r) * 2 + 1]; }
        carry = run;
#pragma unroll
        for (int i = 0; i < 16; ++i) {
            const int tl = crow(i, hh);
            const float hv = uv_[i] + av_[i] * hin;
            const float gv = bflo((unsigned)*(const LAS unsigned short*)(lds + LR_GR + (32 * wid + tl) * 64 + r * 2));
            const float yy = 0.7978845608028654f * (gv + 0.044715f * gv * gv * gv);
            const float ge = gv * __builtin_amdgcn_rcpf(1.0f + __builtin_amdgcn_exp2f(-2.0f * LOG2E * yy));
            A.Y[(rowbase + 256 * cch + 32 * wid + tl) * 1024 + c] = (bf16_t)(pk2(hv * ge, 0.f) & 0xffffu);
        }
    }
#undef LRU_LOAD
}

__device__ __forceinline__ float wave_sum(float v, int lane) {
#pragma unroll
    for (int o = 1; o < 64; o <<= 1) v += sx(v, o, lane);
    return v;
}
__device__ __forceinline__ int headperm(int n) { return (n & ~255) | (((n >> 5) & 1) << 7) | (((n >> 6) & 3) << 5) | (n & 31); }
__device__ __forceinline__ void transpose_item(const float* W, int N, bf16_t* WT, int K, int dst_row0, int k0, int n0, LAS float* scr, int lane) {
    float tv[32];
#pragma unroll
    for (int i = 0; i < 32; ++i) { const int kk = 2 * i + (lane >> 5); tv[i] = W[(size_t)(k0 + kk) * N + n0 + (lane & 31)]; }
#pragma unroll
    for (int i = 0; i < 32; ++i) { const int kk = 2 * i + (lane >> 5); scr[kk * 33 + (lane & 31)] = tv[i]; }
    LDS_WAIT();
    const int c8 = lane & 7;
#pragma unroll
    for (int j = 0; j < 4; ++j) { const int n = (lane >> 3) + 8 * j; const LAS float* s = scr + (8 * c8) * 33 + n;
        u32x4 o; o.x = pk2(s[0 * 33], s[1 * 33]); o.y = pk2(s[2 * 33], s[3 * 33]); o.z = pk2(s[4 * 33], s[5 * 33]); o.w = pk2(s[6 * 33], s[7 * 33]);
        *(u32x4*)(WT + (size_t)(dst_row0 + n) * K + k0 + 8 * c8) = o; }
    LDS_WAIT();
}


#define XB_TMO      128
#define XB_XCNT(j)  (256  + 64 * (j))
#define XB_XSUB(j)  (1280 + 64 * (j))
#define XB_XGEN(j)  (2304 + 64 * (j))
#define XB_TOP      3328
#define XB_TOPGEN   3392
#define XCD_BAR_WORDS 3456
#define XB_SPIN_CAP (1u << 20)
__device__ __forceinline__ unsigned xb_ld(unsigned* p)              { return __hip_atomic_load(p, __ATOMIC_RELAXED, __HIP_MEMORY_SCOPE_AGENT); }
__device__ __forceinline__ unsigned xb_add(unsigned* p, unsigned v) { return __hip_atomic_fetch_add(p, v, __ATOMIC_RELAXED, __HIP_MEMORY_SCOPE_AGENT); }
__device__ __forceinline__ unsigned xb_xcc_id() { return (unsigned)__builtin_amdgcn_s_getreg((3 << 11) | 20) & 0xFu; }
#define XB_SPIN(cond, bar) do { unsigned _sp = 0; while (cond) { __builtin_amdgcn_s_sleep(1); \
    if ((++_sp & 255u) == 0u) { if (xb_ld(&(bar)[XB_TMO])) break; if (_sp > XB_SPIN_CAP) { atomicAdd(&(bar)[XB_TMO], 1u); break; } } } } while (0)
struct XcdBarrier { unsigned* bar; unsigned x; volatile LAS unsigned* st; };
__device__ __forceinline__ void xcd_barrier_complete(unsigned* bar, unsigned x, unsigned& nloc, unsigned& nx) {
    const unsigned G = gridDim.x * gridDim.y * gridDim.z;
    unsigned sum, cnt, mine, sp = 0u;
    for (;;) {
        sum = 0u; cnt = 0u; mine = 0u;
#pragma unroll
        for (unsigned j = 0; j < 16; ++j) { const unsigned c = xb_ld(&bar[XB_XCNT(j)]); sum += c; cnt += (c > 0u) ? 1u : 0u; mine = (j == x) ? c : mine; }
        if (sum == G) break;
        __builtin_amdgcn_s_sleep(1);
        if ((++sp & 255u) == 0u) { if (xb_ld(&bar[XB_TMO])) break; if (sp > XB_SPIN_CAP) { atomicAdd(&bar[XB_TMO], 1u); break; } }
    }
    nloc = mine > 0u ? mine : 1u; nx = cnt > 0u ? cnt : 1u;
}
__device__ __forceinline__ void xcd_barrier(const XcdBarrier& b, const bool leader) {
    asm volatile("s_waitcnt vmcnt(0)" ::: "memory");
    __syncthreads();
    if (leader) {
        unsigned* bar = b.bar;
        __builtin_amdgcn_s_waitcnt(0);
        unsigned nloc = b.st[0], nx = b.st[1];
        if (nloc == 0u) { xcd_barrier_complete(bar, b.x, nloc, nx); b.st[0] = nloc; b.st[1] = nx; }
        const unsigned old = xb_add(&bar[XB_XSUB(b.x)], 1u);
        const unsigned gen = old / nloc;
        if (old + 1u == (gen + 1u) * nloc) {
            __builtin_amdgcn_fence(__ATOMIC_RELEASE, "agent");
            asm volatile("s_waitcnt vmcnt(0)" ::: "memory");
            const unsigned og = xb_add(&bar[XB_TOP], 1u);
            const unsigned tg = og / nx;
            if (og + 1u == (tg + 1u) * nx) xb_add(&bar[XB_TOPGEN], 1u);
            else XB_SPIN(xb_ld(&bar[XB_TOPGEN]) == tg, bar);
            __builtin_amdgcn_fence(__ATOMIC_ACQUIRE, "agent");
            xb_add(&bar[XB_XGEN(b.x)], 1u);
            asm volatile("s_waitcnt vmcnt(0)" ::: "memory");
        } else {
            XB_SPIN(xb_ld(&bar[XB_XGEN(b.x)]) == gen, bar);
            __builtin_amdgcn_fence(__ATOMIC_ACQUIRE, "agent");
            asm volatile("s_waitcnt vmcnt(0)" ::: "memory");
        }
    }
    __syncthreads();
}

struct Args { const float* in[27]; float* out; unsigned char* ws; };

__global__ void __launch_bounds__(512, 2) fwd_mega(Args args) {
    extern __shared__ __attribute__((aligned(16))) unsigned char lds_raw[];
    LAS unsigned char* lds = (LAS unsigned char*)lds_raw;
    cg::grid_group grid = cg::this_grid();
#define GSYNC_CG() do { if (args.ws == nullptr) grid.sync(); GSYNC(); } while (0)
#define GSYNC() do { int l_; asm volatile("v_mbcnt_lo_u32_b32 %0, -1, 0\n\tv_mbcnt_hi_u32_b32 %0, -1, %0" : "=v"(l_)); xcd_barrier(xbar, wid_s == 0 && l_ == 0); if (DUP_MASK & 4) xcd_barrier(xbar, wid_s == 0 && l_ == 0); } while (0)
    const int G = gridDim.x, bid = blockIdx.x, NGW = G * 8;
    const int wid_s = __builtin_amdgcn_readfirstlane((int)threadIdx.x >> 6);
    XcdBarrier xbar;
    {
        volatile LAS unsigned* st = (volatile LAS unsigned*)(lds + 139264);
        if (threadIdx.x < 4) st[threadIdx.x] = 0u;
        __syncthreads();
        xbar.bar = (unsigned*)(args.ws + WS_BAR); xbar.x = xb_xcc_id(); xbar.st = st;
        if (threadIdx.x == 0) (void)xb_add(&xbar.bar[XB_XCNT(xbar.x)], 1u);
    }
#define PHASE_IDS int lane_; asm volatile("v_mbcnt_lo_u32_b32 %0, -1, 0\n\tv_mbcnt_hi_u32_b32 %0, -1, %0" : "=v"(lane_)); const int lane = lane_ & 63; const int wid = wid_s; const int tid = wid * 64 + lane; const int gw = bid * 8 + wid; (void)gw;
    unsigned char* ws = args.ws;
    const float* x = args.in[0]; const float* cc = args.in[1]; const float* ada_w = args.in[2]; const float* ada_b = args.in[3];
    const float* norm_mix_g = args.in[4]; const float* norm_ffn_g = args.in[5];
    float* MOD = (float*)(ws + WS_MOD); float* SHW = (float*)(ws + WS_SHW);
    float* SSQ0 = (float*)(ws + WS_SSQ0); float* SSQ1 = (float*)(ws + WS_SSQ1); float* SSQ2 = (float*)(ws + WS_SSQ2); float* SSQ3 = (float*)(ws + WS_SSQ3);
    bf16_t* XG = (bf16_t*)(ws + WS_XG); bf16_t* PB = (bf16_t*)(ws + WS_P); bf16_t* YB = (bf16_t*)(ws + WS_Y); bf16_t* ACT = (bf16_t*)(ws + WS_ACT); bf16_t* XS = (bf16_t*)(ws + WS_XS);
    float* HALO = (float*)(ws + WS_HALO); float* FIXP = (float*)(ws + WS_FIXP); float* FIXU = (float*)(ws + WS_FIXU);
    bf16_t* W_IN0 = (bf16_t*)(ws + WS_W_IN0); bf16_t* W_OUT0 = (bf16_t*)(ws + WS_W_OUT0); bf16_t* W_GU0 = (bf16_t*)(ws + WS_W_GU0); bf16_t* W_DN0 = (bf16_t*)(ws + WS_W_DN0);
    bf16_t* W_IN1 = (bf16_t*)(ws + WS_W_IN1); bf16_t* W_OUT1 = (bf16_t*)(ws + WS_W_OUT1); bf16_t* W_GU1 = (bf16_t*)(ws + WS_W_GU1); bf16_t* W_DN1 = (bf16_t*)(ws + WS_W_DN1);

    for (int prep = 0; prep < ((DUP_MASK & 8) ? 2 : 1); ++prep) {
    for (int item = bid; item < 256; item += G) {
        PHASE_IDS
        const int l = item >> 7, chunk = item & 127;
        LAS float* sl = (LAS float*)lds;
        LAS float* part = (LAS float*)(lds + 65536);
        __syncthreads();
        for (int idx = tid; idx < 16384; idx += 512) { const float v = cc[idx]; sl[idx] = v / (1.0f + __expf(-v)); }
        __syncthreads();
        float acc[16];
#pragma unroll
        for (int bb = 0; bb < 16; ++bb) acc[bb] = 0.f;
        const int colc = chunk * 48 + (lane < 48 ? lane : 47);
        const float* Wp = ada_w + (size_t)l * 1024 * 6144 + colc;
        for (int k = 128 * wid; k < 128 * wid + 128; k += 16) {
            float wv[16];
#pragma unroll
            for (int j = 0; j < 16; ++j) wv[j] = Wp[(size_t)(k + j) * 6144];
#pragma unroll
            for (int j4 = 0; j4 < 4; ++j4)
#pragma unroll
                for (int bb = 0; bb < 16; ++bb) { const f32x4 s4 = *(const LAS f32x4*)(sl + bb * 1024 + k + 4 * j4); acc[bb] += (s4[0] * wv[4 * j4] + s4[1] * wv[4 * j4 + 1]) + (s4[2] * wv[4 * j4 + 2] + s4[3] * wv[4 * j4 + 3]); }
        }
#pragma unroll
        for (int bb = 0; bb < 16; ++bb) part[(wid * 16 + bb) * 64 + lane] = acc[bb];
        __syncthreads();
        for (int o = tid; o < 1024; o += 512) {
            const int bb = o >> 6, cl = o & 63;
            if (cl < 48) {
                float sacc = ada_b[l * 6144 + chunk * 48 + cl];
#pragma unroll
                for (int w8 = 0; w8 < 8; ++w8) sacc += part[(w8 * 16 + bb) * 64 + cl];
                MOD[((size_t)l * 16 + bb) * 6144 + chunk * 48 + cl] = sacc;
            }
        }
        __syncthreads();
    }
    {
        PHASE_IDS
        LAS float* scr = (LAS float*)(lds + wid * 16384);
        constexpr int NITEMS = 1280 + 512 + 3 * 1408 + 768 + 512 + 3 * 1408;
        for (int it = gw; it < NITEMS; it += NGW) {
            int rI = it; const float* W; int N, K; bf16_t* WT; int mapk;
            if (rI < 1280) { W = args.in[6]; N = 2560; K = 1024; WT = W_IN0; mapk = 1; }
            else if ((rI -= 1280) < 512) { W = args.in[16]; N = 1024; K = 1024; WT = W_OUT0; mapk = 0; }
            else if ((rI -= 512) < 1408) { W = args.in[22]; N = FF; K = 1024; WT = W_GU0; mapk = 3; }
            else if ((rI -= 1408) < 1408) { W = args.in[23]; N = FF; K = 1024; WT = W_GU0; mapk = 4; }
            else if ((rI -= 1408) < 1408) { W = args.in[26]; N = 1024; K = FF; WT = W_DN0; mapk = 0; }
            else if ((rI -= 1408) < 768) { W = args.in[17]; N = 1536; K = 1024; WT = W_IN1; mapk = 2; }
            else if ((rI -= 768) < 512) { W = args.in[21]; N = 1024; K = 1024; WT = W_OUT1; mapk = 0; }
            else if ((rI -= 512) < 1408) { W = args.in[22] + (size_t)1024 * FF; N = FF; K = 1024; WT = W_GU1; mapk = 3; }
            else if ((rI -= 1408) < 1408) { W = args.in[23] + (size_t)1024 * FF; N = FF; K = 1024; WT = W_GU1; mapk = 4; }
            else { rI -= 1408; W = args.in[26] + (size_t)FF * 1024; N = 1024; K = FF; WT = W_DN1; mapk = 0; }
            const int nblk = N / 32, kb = rI / nblk, nb = rI % nblk, k0 = 64 * kb, n0 = 32 * nb;
            int d0 = n0;
            if (mapk == 1) { const int region = n0 >> 9; if (region == 2 || region == 3) d0 = headperm(n0); }
            else if (mapk == 2) { if (n0 < 1280) d0 = headperm(n0); }
            else if (mapk == 3) d0 = 256 * (n0 >> 7) + (n0 & 127);
            else if (mapk == 4) d0 = 256 * (n0 >> 7) + 128 + (n0 & 127);
            transpose_item(W, N, WT, K, d0, k0, n0, scr, lane);
        }
    }
    GSYNC_CG();

    {
    PHASE_IDS
    for (int m0 = gw; m0 < M; m0 += 2 * NGW) {
        const int m1 = (m0 + NGW < M) ? m0 + NGW : m0;
        f32x4 v[2][4], gm[2][4];
#pragma unroll
        for (int rr = 0; rr < 2; ++rr) {
            const int m = rr ? m1 : m0; const int bb = m >> 11;
            const f32x4* xr = (const f32x4*)(x + (size_t)m * 1024) + lane;
            const f32x4* gp = (const f32x4*)norm_mix_g + lane;
            const f32x4* sp = (const f32x4*)(MOD + (size_t)bb * 6144 + 1024) + lane;
#pragma unroll
            for (int j = 0; j < 4; ++j) { v[rr][j] = xr[64 * j]; gm[rr][j] = gp[64 * j] * (sp[64 * j] + 1.0f); }
        }
#pragma unroll
        for (int rr = 0; rr < 2; ++rr) {
            const int m = rr ? m1 : m0;
            u32x2* op = (u32x2*)(XG + (size_t)m * 1024) + lane;
            float sacc = 0.f;
#pragma unroll
            for (int j = 0; j < 4; ++j) {
                const f32x4 q = v[rr][j] * v[rr][j]; sacc += (q[0] + q[1]) + (q[2] + q[3]);
                const f32x4 o = v[rr][j] * gm[rr][j]; u32x2 w; w.x = pk2(o[0], o[1]); w.y = pk2(o[2], o[3]); op[64 * j] = w;
            }
            sacc = wave_sum(sacc, lane);
            if (lane == 0) SSQ0[m] = sacc;
        }
    }
    for (int gi = 0; gi < 4; ++gi) {
        const bf16_t* Wt; int N; const float* shp; float* outp;
        if (gi == 0) { Wt = W_IN0; N = 2560; shp = MOD; outp = SHW + SHW_IN0; }
        else if (gi == 1) { Wt = W_GU0; N = 5632; shp = MOD + 3 * 1024; outp = SHW + SHW_GU0; }
        else if (gi == 2) { Wt = W_IN1; N = 1536; shp = MOD + (size_t)16 * 6144; outp = SHW + SHW_IN1; }
        else { Wt = W_GU1; N = 5632; shp = MOD + (size_t)16 * 6144 + 3 * 1024; outp = SHW + SHW_GU1; }
        LAS float* shl = (LAS float*)lds;
        __syncthreads();
        for (int idx = tid; idx < 16384; idx += 512) shl[idx] = shp[(size_t)(idx >> 10) * 6144 + (idx & 1023)];
        __syncthreads();
        for (int p = gw; p < N; p += NGW) {
            asm volatile("" ::: "memory");
            const u32x4 r0 = *(const u32x4*)(Wt + (size_t)p * 1024 + 8 * lane), r1 = *(const u32x4*)(Wt + (size_t)p * 1024 + 512 + 8 * lane);
            float wv[16];
            wv[0] = bflo(r0.x); wv[1] = bfhi(r0.x); wv[2] = bflo(r0.y); wv[3] = bfhi(r0.y); wv[4] = bflo(r0.z); wv[5] = bfhi(r0.z); wv[6] = bflo(r0.w); wv[7] = bfhi(r0.w);
            wv[8] = bflo(r1.x); wv[9] = bfhi(r1.x); wv[10] = bflo(r1.y); wv[11] = bfhi(r1.y); wv[12] = bflo(r1.z); wv[13] = bfhi(r1.z); wv[14] = bflo(r1.w); wv[15] = bfhi(r1.w);
            float d[16];
#pragma unroll
            for (int bb = 0; bb < 16; ++bb) {
                const LAS float* sb_ = shl + bb * 1024 + 8 * lane;
                const f32x4 s0 = *(const LAS f32x4*)(sb_), s1 = *(const LAS f32x4*)(sb_ + 4), s2 = *(const LAS f32x4*)(sb_ + 512), s3 = *(const LAS f32x4*)(sb_ + 516);
                d[bb] = (wv[0] * s0[0] + wv[1] * s0[1]) + (wv[2] * s0[2] + wv[3] * s0[3]) + (wv[4] * s1[0] + wv[5] * s1[1]) + (wv[6] * s1[2] + wv[7] * s1[3])
                      + (wv[8] * s2[0] + wv[9] * s2[1]) + (wv[10] * s2[2] + wv[11] * s2[3]) + (wv[12] * s3[0] + wv[13] * s3[1]) + (wv[14] * s3[2] + wv[15] * s3[3]);
            }
            const bool h5 = (lane & 32) != 0, h4 = (lane & 16) != 0, h3 = (lane & 8) != 0, h2 = (lane & 4) != 0;
            float e8[8], e4[4], e2[2];
#pragma unroll
            for (int j = 0; j < 8; ++j) { const float snd = h5 ? d[j] : d[j + 8], kp = h5 ? d[j + 8] : d[j]; e8[j] = kp + sx(snd, 32, lane); }
#pragma unroll
            for (int j = 0; j < 4; ++j) { const float snd = h4 ? e8[j] : e8[j + 4], kp = h4 ? e8[j + 4] : e8[j]; e4[j] = kp + sx(snd, 16, lane); }
#pragma unroll
            for (int j = 0; j < 2; ++j) { const float snd = h3 ? e4[j] : e4[j + 2], kp = h3 ? e4[j + 2] : e4[j]; e2[j] = kp + sx(snd, 8, lane); }
            float tot; { const float snd = h2 ? e2[0] : e2[1], kp = h2 ? e2[1] : e2[0]; tot = kp + sx(snd, 4, lane); }
            tot += sx(tot, 2, lane); tot += sx(tot, 1, lane);
            const int bsel = (h5 ? 8 : 0) + (h4 ? 4 : 0) + (h3 ? 2 : 0) + (h2 ? 1 : 0);
            if ((lane & 3) == 0) outp[(size_t)bsel * N + p] = tot;
        }
    }
    }
    GSYNC();

    }
    pg8::StaticOrder S;
    {
        PHASE_IDS
        pg8::Gemm g{XG, W_IN0, M, 2560, 1024}; S.init(M, 2560, G, bid);
        EpiIn<0> E{SSQ0, SHW + SHW_IN0, 2560, PB, args.in[14], args.in[15]};
        pg8::gemm_phase<EpiIn<0>>(lds, g, S, E, tid);
    }
#if (DUP_MASK & 32)
    {
        PHASE_IDS
        pg8::Gemm g{XG, W_IN0, M, 2560, 1024}; S.init(M, 2560, G, bid);
        EpiIn<0> E{SSQ0, SHW + SHW_IN0, 2560, PB, args.in[14], args.in[15]};
        pg8::gemm_phase<EpiIn<0>>(lds, g, S, E, tid);
    }
#endif
    GSYNC();

    {
        const bf16_t* XR = PB; const bf16_t* GR = PB + (size_t)M * 512; const bf16_t* Qb = PB + (size_t)2 * M * 512; const bf16_t* Kb = PB + (size_t)3 * M * 512; const bf16_t* Vb = PB + (size_t)4 * M * 512;
        PHASE_IDS
        LruArgs LA{XR, GR, YB, args.in[7], args.in[8], args.in[9], args.in[10], args.in[11], args.in[12], args.in[13]};
        for (int rep = 0; rep < ((DUP_MASK & 1) ? 2 : 1); ++rep) {
        for (int rep2 = 0; rep2 < ((DUP_MASK & 256) ? 2 : 1); ++rep2)
        for (int item = bid; item < 256; item += G) lru_item(lds, LA, item, tid, wid, lane);
        for (int u = bid; u < 1024; u += G) {
            const int rr = u >> 8, i = u & 255, hi = i >> 7, bh = i & 127;
            int qb;
            if (rr == 0) qb = hi ? 6 : 7; else if (rr == 1) qb = hi ? 5 : 4; else if (rr == 2) qb = hi ? 2 : 3; else qb = hi ? 1 : 0;
            sb_unit(lds, Qb, Kb, Vb, YB, bh >> 3, bh & 7, qb, tid, wid, lane);
        }
        }
    }
    GSYNC();

    {
        PHASE_IDS
        pg8::Gemm g{YB, W_OUT0, M, 1024, 1024}; S.init(M, 1024, G, bid);
        EpiRes<true, false, false> E{x, XS, MOD + 2 * 1024, norm_ffn_g, MOD + 4 * 1024, XG, SSQ1};
        pg8::gemm_phase<EpiRes<true, false, false>>(lds, g, S, E, tid);
    }
    GSYNC();

    for (int layer = 0; layer < 2; ++layer) {
        if (layer == 1) {
            {
                PHASE_IDS
                pg8::Gemm g{XG, W_IN1, M, 1536, 1024}; S.init(M, 1536, G, bid);
                EpiIn<1> E{SSQ2, SHW + SHW_IN1, 1536, PB, args.in[18], args.in[19]};
                pg8::gemm_phase<EpiIn<1>>(lds, g, S, E, tid);
            }
            GSYNC();
            {
                const bf16_t* Qb = PB; const bf16_t* Kb = PB + (size_t)M * 1024; const bf16_t* Vb = Kb + (size_t)M * 256;
                PHASE_IDS
                for (int rep = 0; rep < ((DUP_MASK & 16) ? 2 : 1); ++rep)
                for (int u = bid; u < 2048; u += G) { const int qc = u & 31, kvh = (u >> 5) & 3, bb = u >> 7; swa_unit(lds, Qb, Kb, Vb, args.in[20], YB, bb, kvh, qc, tid, wid, lane); }
            }
            GSYNC();
            {
                PHASE_IDS
                pg8::Gemm g{YB, W_OUT1, M, 1024, 1024}; S.init(M, 1024, G, bid);
                EpiRes<false, false, false> E{XS, XS, MOD + (size_t)16 * 6144 + 2 * 1024, norm_ffn_g + 1024, MOD + (size_t)16 * 6144 + 4 * 1024, XG, SSQ3};
                pg8::gemm_phase<EpiRes<false, false, false>>(lds, g, S, E, tid);
            }
            GSYNC();
        }
#if (DUP_MASK & 64)
        {
            PHASE_IDS
            pg8::Gemm g{XG, layer ? W_GU1 : W_GU0, M, 5632, 1024}; S.init(M, 5632, G, bid);
            EpiGU E{layer ? SSQ3 : SSQ1, SHW + (layer ? SHW_GU1 : SHW_GU0), args.in[24] + (size_t)layer * 3 * FF, args.in[25] + (size_t)layer * FF, ACT, HALO, FIXP, FIXU};
            pg8::gemm_phase<EpiGU>(lds, g, S, E, tid);
        }
#endif
        {
            PHASE_IDS
            pg8::Gemm g{XG, layer ? W_GU1 : W_GU0, M, 5632, 1024}; S.init(M, 5632, G, bid);
            EpiGU E{layer ? SSQ3 : SSQ1, SHW + (layer ? SHW_GU1 : SHW_GU0), args.in[24] + (size_t)layer * 3 * FF, args.in[25] + (size_t)layer * FF, ACT, HALO, FIXP, FIXU};
            pg8::gemm_phase<EpiGU>(lds, g, S, E, tid);
        }
        GSYNC();
        {
            PHASE_IDS
            const float* cw = args.in[24] + (size_t)layer * 3 * FF;
            for (int rep = 0; rep < ((DUP_MASK & 128) ? 2 : 1); ++rep)
            for (int idx = bid * 512 + tid; idx < 512 * 2 * 704; idx += G * 512) {
                const int c4 = idx % 704, sr = idx / 704, s = sr & 1, gs = sr >> 1;
                const size_t fo = ((size_t)gs * 2 + s) * FF + 4 * c4;
                f32x4 a = *(const f32x4*)(FIXP + fo); const f32x4 up = *(const f32x4*)(FIXU + fo);
                if ((gs & 31) != 0) {
                    const f32x4 h1 = *(const f32x4*)(HALO + ((size_t)(gs - 1) * 2 + 1) * FF + 4 * c4);
                    const f32x4 w0 = *(const f32x4*)(cw + 4 * c4);
                    if (s == 0) { const f32x4 h2 = *(const f32x4*)(HALO + ((size_t)(gs - 1) * 2) * FF + 4 * c4); const f32x4 w1 = *(const f32x4*)(cw + FF + 4 * c4); a = a + w1 * h1 + w0 * h2; }
                    else a = a + w0 * h1;
                }
                const f32x4 o = silu4(a) * up; u32x2 w; w.x = pk2(o[0], o[1]); w.y = pk2(o[2], o[3]);
                *(u32x2*)(ACT + (size_t)(gs * 64 + s) * FF + 4 * c4) = w;
            }
        }
        GSYNC();
        if (layer == 0) {
            PHASE_IDS
            pg8::Gemm g{ACT, W_DN0, M, 1024, FF}; S.init(M, 1024, G, bid);
            EpiRes<false, false, false> E{XS, XS, MOD + 5 * 1024, norm_mix_g + 1024, MOD + (size_t)16 * 6144 + 1 * 1024, XG, SSQ2};
            pg8::gemm_phase<EpiRes<false, false, false>>(lds, g, S, E, tid);
            GSYNC();
        } else {
            PHASE_IDS
            pg8::Gemm g{ACT, W_DN1, M, 1024, FF}; S.init(M, 1024, G, bid);
            EpiRes<false, true, true> E{XS, args.out, MOD + (size_t)16 * 6144 + 5 * 1024, nullptr, nullptr, nullptr, nullptr};
            pg8::gemm_phase<EpiRes<false, true, true>>(lds, g, S, E, tid);
        }
    }
}

extern "C" void kernel_launch(void* const* d_in, const int* in_sizes, int n_in, void* d_out, int out_size, void* d_ws, size_t ws_size, hipStream_t stream) {
    static int grid = 0;
    if (grid == 0) {
        if (n_in != 27 || out_size != M * DM || ws_size < WS_END) { fprintf(stderr, "kernel_launch: unexpected shapes (n_in %d out %d ws %zu)\n", n_in, out_size, ws_size); grid = -1; return; }
        int dev = 0, cus = 0, per_cu = 0;
        (void)hipGetDevice(&dev);
        (void)hipDeviceGetAttribute(&cus, hipDeviceAttributeMultiprocessorCount, dev);
        (void)hipFuncSetAttribute((const void*)fwd_mega, hipFuncAttributeMaxDynamicSharedMemorySize, LDS_BYTES);
        (void)hipOccupancyMaxActiveBlocksPerMultiprocessor(&per_cu, (const void*)fwd_mega, 512, LDS_BYTES);
        (void)hipGetLastError();
        grid = cus;
        if (per_cu < 1) fprintf(stderr, "kernel_launch: occupancy query says %d blocks/CU\n", per_cu);
    }
    if (grid < 0) return;
    (void)hipMemsetAsync(d_ws, 0, WS_ZERO_BYTES, stream);
    Args a{};
    for (int i = 0; i < 27; ++i) a.in[i] = (const float*)d_in[i];
    a.out = (float*)d_out; a.ws = (unsigned char*)d_ws;
    void* kargs[] = {&a};
    hipError_t e = hipLaunchCooperativeKernel((const void*)fwd_mega, dim3(grid), dim3(512), kargs, LDS_BYTES, stream);
    if (e != hipSuccess) fprintf(stderr, "cooperative launch failed: %s (grid %d)\n", hipGetErrorString(e), grid);
}
```

```cpp
#include <hip/hip_runtime.h>
#include <hip/hip_cooperative_groups.h>
#include <cstdio>
#include <cstdint>
namespace cg = cooperative_groups;

#define LAS __attribute__((address_space(3)))
typedef unsigned short bf16_t;
typedef short bf16x8 __attribute__((ext_vector_type(8)));
typedef short s16x4 __attribute__((ext_vector_type(4)));
typedef float f32x4 __attribute__((ext_vector_type(4)));
typedef float f32x2 __attribute__((ext_vector_type(2)));
typedef float f32x16 __attribute__((ext_vector_type(16)));
typedef unsigned u32x4 __attribute__((ext_vector_type(4)));
typedef unsigned u32x2 __attribute__((ext_vector_type(2)));
typedef __bf16 bf2_t __attribute__((ext_vector_type(2)));

__device__ __forceinline__ unsigned pk2(float lo, float hi) { f32x2 v = {lo, hi}; bf2_t r = __builtin_convertvector(v, bf2_t); return __builtin_bit_cast(unsigned, r); }
__device__ __forceinline__ float bflo(unsigned u) { return __uint_as_float(u << 16); }
__device__ __forceinline__ float bfhi(unsigned u) { return __uint_as_float(u & 0xffff0000u); }
#define LDS_WAIT() asm volatile("s_waitcnt lgkmcnt(0)" ::: "memory")
__device__ __forceinline__ float sx(float v, int mask, int lane) { return __int_as_float(__builtin_amdgcn_ds_bpermute((lane ^ mask) << 2, __float_as_int(v))); }

constexpr int NB = 16, SEQ = 2048, DM = 1024, M = NB * SEQ, FF = 2816;
constexpr float EPS = 1e-6f;
constexpr float LOG2E = 1.4426950408889634f;
constexpr float QSCALE = 0.125f * LOG2E;

constexpr size_t MiB = 1u << 20;
constexpr size_t WS_SSQ1 = 0, WS_SSQ2 = 128 * 1024, WS_SSQ3 = 256 * 1024, WS_ZERO_BYTES = 512 * 1024;
constexpr size_t WS_BAR = 384 * 1024;
constexpr size_t WS_SSQ0 = 512 * 1024;
constexpr size_t WS_MOD = 1 * MiB;
constexpr size_t WS_SHW = 2 * MiB;
constexpr size_t SHW_IN0 = 0, SHW_GU0 = 16 * 2560, SHW_IN1 = SHW_GU0 + 16 * 5632, SHW_GU1 = SHW_IN1 + 16 * 1536;
constexpr size_t WS_HALO = 3 * MiB, WS_FIXP = 15 * MiB, WS_FIXU = 27 * MiB;
constexpr size_t WS_W_IN0 = 40 * MiB, WS_W_OUT0 = 45 * MiB, WS_W_GU0 = 47 * MiB, WS_W_DN0 = 58 * MiB;
constexpr size_t WS_W_IN1 = 64 * MiB, WS_W_OUT1 = 67 * MiB, WS_W_GU1 = 69 * MiB, WS_W_DN1 = 80 * MiB;
constexpr size_t WS_XG = 96 * MiB;
constexpr size_t WS_P = 160 * MiB;
constexpr size_t WS_Y = 320 * MiB;
constexpr size_t WS_ACT = 160 * MiB;
constexpr size_t WS_XS = 384 * MiB;
constexpr size_t WS_END = 448 * MiB;

constexpr int LDS_BYTES = 147456;
#ifndef DUP_MASK
#define DUP_MASK 0
#endif

namespace pg8 {
constexpr int BM = 256, BK = 64, HALF = 128, HTB = HALF * BK * 2, STAGE_BYTES = 8 * HTB, NXCD = 8, WGM = 4;
__host__ __device__ __forceinline__ int lds_byte(int r, int c) { const int st = (r >> 4) * 2 + (c >> 5), rr = r & 15, cc = c & 31, ob = rr * 64 + cc * 2; return st * 1024 + (ob ^ (((ob >> 9) & 1) << 5)); }
__host__ __device__ __forceinline__ void stage_rc(int b, int& R, int& C) { const int st = b / 1024, sb = b % 1024, swz = sb ^ (((sb >> 9) & 1) << 5); R = (st >> 1) * 16 + swz / 64; C = (st & 1) * 32 + (swz % 64) / 2; }
struct Unit { int pm, pn; };
struct Gemm { const bf16_t* A; const bf16_t* Bt; int M, N, K; };
struct StaticOrder {
    int nM, nN, nwg, G, c;
    __host__ __device__ void init(int M_, int N_, int G_, int c_) { nM = M_ / BM; nN = N_ / BM; nwg = nM * nN; G = G_; c = c_; }
    __host__ __device__ bool next(int i, Unit& u) const {
        const long L = (long)i * G + c; if (L >= nwg) return false;
        int wgid = (int)L; { const int q = nwg / NXCD, r = nwg % NXCD, xcd = wgid % NXCD, off = wgid / NXCD; wgid = (xcd < r ? xcd * (q + 1) : r * (q + 1) + (xcd - r) * q) + off; }
        const int nig = WGM * nN, gid = wgid / nig, fm = gid * WGM, gsz = (nM - fm) < WGM ? (nM - fm) : WGM;
        u.pm = fm + ((wgid % nig) % gsz); u.pn = (wgid % nig) / gsz; return true;
    }
};

template <class Epi, bool ALIGN_EPI = true, bool SP2 = true>
__device__ __forceinline__ void gemm_phase(LAS unsigned char* lds, const Gemm g, const StaticOrder& S, const Epi& E, const int tid) {
    const int wid = __builtin_amdgcn_readfirstlane(tid >> 6), lane = tid & 63, wr = wid >> 2, wc = wid & 3, fr = lane & 15, fq = lane >> 4;
    const int K = g.K, nt = K / BK;
    unsigned voffA[2];
#pragma unroll
    for (int i = 0; i < 2; ++i) { int R, C; stage_rc(tid * 16 + i * 8192, R, C); voffA[i] = (unsigned)(R * K + C) * 2u; }
    const size_t kstep = (size_t)(BK * 2);
    const size_t hstep = (size_t)HALF * K * 2;
    const size_t tstep = 2 * hstep;
    const unsigned ldsw = (unsigned)wid * 1024u;
    const int aoff = lds_byte(wr * 64 + fr, fq * 8), boff = lds_byte(wc * 32 + fr, fq * 8);
#define PG8_SA(b, h) (((b) * 2 + (h)) * HTB)
#define PG8_SB(b, h) ((4 + (b) * 2 + (h)) * HTB)
#define PG8_STAGE(bufoff, gbase, voff) do { _Pragma("unroll") for (int _i = 0; _i < 2; ++_i) \
        __builtin_amdgcn_global_load_lds((const unsigned*)((const char*)(gbase) + (voff)[_i]), (LAS unsigned*)(lds + (bufoff) + ldsw + _i * 8192), 16, 0, 0); } while (0)
#define PG8_LDA(dst, b, h) do { _Pragma("unroll") for (int m = 0; m < 4; ++m) _Pragma("unroll") for (int k = 0; k < 2; ++k) dst[m][k] = *(const LAS bf16x8*)(lds + PG8_SA(b, h) + aoff + m * 2048 + k * 1024); } while (0)
#define PG8_LDB(dst, b, h) do { _Pragma("unroll") for (int n = 0; n < 2; ++n) _Pragma("unroll") for (int k = 0; k < 2; ++k) dst[n][k] = *(const LAS bf16x8*)(lds + PG8_SB(b, h) + boff + n * 2048 + k * 1024); } while (0)
#define PG8_MMA(ai, bj, At, Bt) do { __builtin_amdgcn_s_setprio(1); _Pragma("unroll") for (int m = 0; m < 4; ++m) _Pragma("unroll") for (int n = 0; n < 2; ++n) _Pragma("unroll") for (int k = 0; k < 2; ++k) \
        acc[ai][bj][m][n] = __builtin_amdgcn_mfma_f32_16x16x32_bf16(Bt[n][k], At[m][k], acc[ai][bj][m][n], 0, 0, 0); __builtin_amdgcn_s_setprio(0); } while (0)
#define PG8_WAIT_V(n) asm volatile("s_waitcnt vmcnt(" #n ")" ::: "memory")
#define PG8_WAIT_L(n) asm volatile("s_waitcnt lgkmcnt(" #n ")" ::: "memory")
#define PG8_BAR __builtin_amdgcn_s_barrier()
#define PG8_SCHED __builtin_amdgcn_sched_barrier(0)
    Unit cur, nxt; int ui = 0;
    if (!S.next(0, cur)) return;
    f32x4 acc[2][2][4][2];
#pragma unroll
    for (int a = 0; a < 2; ++a)
#pragma unroll
        for (int b = 0; b < 2; ++b)
#pragma unroll
            for (int m = 0; m < 4; ++m)
#pragma unroll
                for (int n = 0; n < 2; ++n) acc[a][b][m][n] = (f32x4){0.f, 0.f, 0.f, 0.f};
    bf16x8 At[4][2], B0[2][2], B1[2][2];
    const char* cA = (const char*)g.A + (size_t)cur.pm * tstep; const char* cB = (const char*)g.Bt + (size_t)cur.pn * tstep;
    {
        PG8_STAGE(PG8_SB(0, 0), cB, voffA); PG8_STAGE(PG8_SB(0, 1), cB + hstep, voffA); PG8_STAGE(PG8_SA(0, 0), cA, voffA); PG8_STAGE(PG8_SA(0, 1), cA + hstep, voffA);
        if (wr == 1) PG8_BAR;
        PG8_WAIT_V(2); PG8_BAR;
        PG8_STAGE(PG8_SB(1, 0), cB + kstep, voffA); PG8_STAGE(PG8_SA(1, 0), cA + kstep, voffA); PG8_STAGE(PG8_SB(1, 1), cB + hstep + kstep, voffA);
        PG8_WAIT_V(6); PG8_BAR;
    }
    for (;;) {
        const bool has_next = S.next(ui + 1, nxt);
        const char* nA = has_next ? (const char*)g.A + (size_t)nxt.pm * tstep : cA; const char* nB = has_next ? (const char*)g.Bt + (size_t)nxt.pn * tstep : cB;
        for (int t = 0; t < nt; t += 2) {
            const bool last = (t == nt - 2);
            const char* a1 = cA + (size_t)(t + 1) * kstep;
            const char* a2 = last ? nA : cA + (size_t)(t + 2) * kstep; const char* b2 = last ? nB : cB + (size_t)(t + 2) * kstep;
            const char* a3 = a2 + kstep; const char* b3 = b2 + kstep;
            PG8_LDB(B0, 0, 0); PG8_LDB(B1, 0, 1); PG8_SCHED; PG8_LDA(At, 0, 0); PG8_STAGE(PG8_SA(1, 1), a1 + hstep, voffA);
            PG8_WAIT_V(8); PG8_WAIT_L(0); PG8_BAR; PG8_MMA(0, 0, At, B0); PG8_MMA(0, 1, At, B1); PG8_BAR; PG8_SCHED;
            PG8_LDA(At, 0, 1); PG8_STAGE(PG8_SB(0, 0), b2, voffA); PG8_STAGE(PG8_SB(0, 1), b2 + hstep, voffA); PG8_STAGE(PG8_SA(0, 0), a2, voffA);
            PG8_WAIT_V(8); PG8_WAIT_L(0); PG8_BAR; PG8_MMA(1, 0, At, B0); PG8_MMA(1, 1, At, B1); PG8_BAR; PG8_SCHED;
            PG8_LDB(B0, 1, 0); PG8_LDB(B1, 1, 1); PG8_SCHED; PG8_LDA(At, 1, 0); PG8_STAGE(PG8_SA(0, 1), a2 + hstep, voffA);
            PG8_WAIT_V(8); PG8_WAIT_L(0); PG8_BAR; PG8_MMA(0, 0, At, B0); PG8_MMA(0, 1, At, B1); PG8_BAR; PG8_SCHED;
            PG8_LDA(At, 1, 1); PG8_STAGE(PG8_SB(1, 0), b3, voffA); PG8_STAGE(PG8_SB(1, 1), b3 + hstep, voffA); PG8_STAGE(PG8_SA(1, 0), a3, voffA);
            PG8_WAIT_V(8); PG8_WAIT_L(0); PG8_BAR; PG8_MMA(1, 0, At, B0); PG8_MMA(1, 1, At, B1); PG8_BAR; PG8_SCHED;
        }
        if constexpr (ALIGN_EPI) { if (wr == 0) PG8_BAR; }
        { int le_; asm volatile("v_mbcnt_lo_u32_b32 %0, -1, 0\n\tv_mbcnt_hi_u32_b32 %0, -1, %0" : "=v"(le_));
          E(acc, cur, wr, wc, le_ & 15, (le_ >> 4) & 3); }
        if (!has_next) break;
#pragma unroll
        for (int a = 0; a < 2; ++a)
#pragma unroll
            for (int b = 0; b < 2; ++b)
#pragma unroll
                for (int m = 0; m < 4; ++m)
#pragma unroll
                    for (int n = 0; n < 2; ++n) acc[a][b][m][n] = (f32x4){0.f, 0.f, 0.f, 0.f};
        cur = nxt; cA = nA; cB = nB; ++ui;
        if constexpr (ALIGN_EPI) { if (wr == 1) PG8_BAR; }
    }
    PG8_WAIT_V(0);
    if constexpr (!ALIGN_EPI) { if (wr == 0) PG8_BAR; }
    PG8_BAR;
#undef PG8_SA
#undef PG8_SB
#undef PG8_STAGE
#undef PG8_LDA
#undef PG8_LDB
#undef PG8_MMA
#undef PG8_WAIT_V
#undef PG8_WAIT_L
#undef PG8_BAR
#undef PG8_SCHED
}
}
using pg8::Unit;


#define GLD4(base, boff) (*(const f32x4*)((const char*)(base) + (unsigned)(boff)))
#define GST4(base, boff, v) (*(f32x4*)((char*)(base) + (unsigned)(boff)) = (v))
#define GST2(base, boff, v) (*(u32x2*)((char*)(base) + (unsigned)(boff)) = (v))
#define GLD1(base, boff) (*(const float*)((const char*)(base) + (unsigned)(boff)))
#define GLDU4(base, boff) (*(const u32x4*)((const char*)(base) + (unsigned)(boff)))
#define GSTU4(base, boff, v) (*(u32x4*)((char*)(base) + (unsigned)(boff)) = (v))

template <int LAYER> struct EpiIn {
    const float* ssq; const float* shw; int N; bf16_t* P; const float* gq; const float* gk;
    __device__ __forceinline__ void operator()(const f32x4 (&acc)[2][2][4][2], const Unit& u, int wr, int wc, int fr_in, int fq_in) const {
        int fr = fr_in, fq = fq_in; asm volatile("" : "+v"(fr), "+v"(fq));
        const int b = u.pm >> 3; const int lane_e = fq * 16 + fr;
        bf16_t* base; int ld, col0, mode;
        if (LAYER == 0) { const int region = u.pn >> 1; base = P + (size_t)region * M * 512; ld = 512; col0 = (u.pn & 1) * 256; mode = region == 2 ? 1 : (region == 3 ? 2 : 0); }
        else {
            if (u.pn < 4) { base = P; ld = 1024; col0 = u.pn * 256; mode = 1; }
            else if (u.pn == 4) { base = P + (size_t)M * 1024; ld = 256; col0 = 0; mode = 2; }
            else { base = P + (size_t)M * 1024 + (size_t)M * 256; ld = 256; col0 = 0; mode = 0; }
        }
        const float* bias = shw + (size_t)b * N + u.pn * 256;
        const unsigned boff = (unsigned)(wc * 32 + 4 * fq) * 4u;
        f32x4 bv[2][2];
#pragma unroll
        for (int bj = 0; bj < 2; ++bj)
#pragma unroll
            for (int n = 0; n < 2; ++n) bv[bj][n] = GLD4(bias, boff + (bj * 128 + n * 16) * 4);
        const int row0 = u.pm * 256 + wr * 64 + fr;
        float rsv[2][4];
#pragma unroll
        for (int ai = 0; ai < 2; ++ai)
#pragma unroll
            for (int m = 0; m < 4; ++m) rsv[ai][m] = GLD1(ssq, (unsigned)row0 * 4u + (ai * 128 + m * 16) * 4);
#pragma unroll
        for (int ai = 0; ai < 2; ++ai)
#pragma unroll
            for (int m = 0; m < 4; ++m) rsv[ai][m] = rsqrtf(rsv[ai][m] * (1.0f / 1024.0f) + EPS);
        const unsigned ldb = (unsigned)ld * 2u;
        if (mode == 0) {
            const unsigned o0 = (unsigned)row0 * ldb + (unsigned)(col0 + wc * 32 + 8 * fq) * 2u;
#pragma unroll
            for (int ai = 0; ai < 2; ++ai)
#pragma unroll
                for (int m = 0; m < 4; ++m) {
                    const float rs = rsv[ai][m];
                    const unsigned ro = o0 + (unsigned)(ai * 128 + m * 16) * ldb;
#pragma unroll
                    for (int bj = 0; bj < 2; ++bj) { const f32x4 v0 = acc[ai][bj][m][0] * rs + bv[bj][0], v1 = acc[ai][bj][m][1] * rs + bv[bj][1];
                        u32x4 w; w.x = pk2(v0[0], v0[1]); w.y = pk2(v0[2], v0[3]); w.z = pk2(v1[0], v1[1]); w.w = pk2(v1[2], v1[3]); GSTU4(base, ro + (bj * 128) * 2, w); }
                }
        } else {
            const float* gn = (mode == 1) ? gq : gk; const float sc = (mode == 1) ? QSCALE : 1.0f;
            f32x4 gv[2][2];
#pragma unroll
            for (int bj = 0; bj < 2; ++bj)
#pragma unroll
                for (int n = 0; n < 2; ++n) gv[bj][n] = GLD4(gn, (unsigned)(8 * fq) * 4u + (32 * bj + 4 * n) * 4) * sc;
            const unsigned o0 = (unsigned)row0 * ldb + (unsigned)(col0 + 64 * wc + 8 * fq) * 2u;
#pragma unroll
            for (int ai = 0; ai < 2; ++ai)
#pragma unroll
                for (int m = 0; m < 4; ++m) {
                    const float rs = rsv[ai][m];
                    f32x4 v[2][2]; float ss = 0.f;
#pragma unroll
                    for (int bj = 0; bj < 2; ++bj)
#pragma unroll
                        for (int n = 0; n < 2; ++n) { v[bj][n] = acc[ai][bj][m][n] * rs + bv[bj][n]; const f32x4 q = v[bj][n] * v[bj][n]; ss += (q[0] + q[1]) + (q[2] + q[3]); }
                    ss += sx(ss, 16, lane_e); ss += sx(ss, 32, lane_e);
                    const float hr = rsqrtf(ss * (1.0f / 64.0f) + EPS);
                    const unsigned ro = o0 + (unsigned)(ai * 128 + m * 16) * ldb;
#pragma unroll
                    for (int bj = 0; bj < 2; ++bj) { const f32x4 o0_ = v[bj][0] * hr * gv[bj][0], o1_ = v[bj][1] * hr * gv[bj][1];
                        u32x4 w; w.x = pk2(o0_[0], o0_[1]); w.y = pk2(o0_[2], o0_[3]); w.z = pk2(o1_[0], o1_[1]); w.w = pk2(o1_[2], o1_[3]); GSTU4(base, ro + (32 * bj) * 2, w); }
                }
        }
    }
};

#define GLD2(base, boff) (*(const u32x2*)((const char*)(base) + (unsigned)(boff)))
template <bool IN_F32, bool LAST> struct EpiRes {
    const float* xin32; float* xout32; const float* gate; const float* pg; const float* psc; const float* ng; const float* nsc; bf16_t* xg; float* ssq;
    __device__ __forceinline__ void operator()(const f32x4 (&acc)[2][2][4][2], const Unit& u, int wr, int wc, int fr_in, int fq_in) const {
        int fr = fr_in, fq = fq_in; asm volatile("" : "+v"(fr), "+v"(fq));
        const int b = u.pm >> 3; const int lane_e = fq * 16 + fr; (void)lane_e;
        const int col = u.pn * 256 + wc * 32 + 8 * fq;
        const float* gtp = gate + (size_t)b * 6144; const float* nsp = LAST ? gate : nsc + (size_t)b * 6144; const float* psp = IN_F32 ? gate : psc + (size_t)b * 6144;
        f32x4 gt[2][2], gm[2][2], ri[2][2];
#pragma unroll
        for (int bj = 0; bj < 2; ++bj)
#pragma unroll
            for (int n = 0; n < 2; ++n) {
                const unsigned co = (unsigned)col * 4u + (bj * 128 + n * 4) * 4;
                gt[bj][n] = GLD4(gtp, co);
                if (!LAST) gm[bj][n] = GLD4(ng, co) * (GLD4(nsp, co) + 1.0f);
                if (!IN_F32) { const f32x4 d = GLD4(pg, co) * (GLD4(psp, co) + 1.0f); ri[bj][n] = (f32x4){1.0f / d[0], 1.0f / d[1], 1.0f / d[2], 1.0f / d[3]}; }
            }
        const int row0 = u.pm * 256 + wr * 64 + fr;
        const unsigned e0 = (unsigned)row0 * 1024u + (unsigned)col;
        u32x4 raw[2][2][2][IN_F32 ? 2 : 1];
#define EPIRES_LOAD(buf, hb_) do { _Pragma("unroll") for (int mm = 0; mm < 2; ++mm) _Pragma("unroll") for (int bj = 0; bj < 2; ++bj) { \
            const unsigned eo = e0 + (unsigned)(((hb_ >> 1) * 128 + ((hb_ & 1) * 2 + mm) * 16) * 1024 + bj * 128); \
            if (IN_F32) { raw[buf][mm][bj][0] = GLDU4(xin32, eo * 4u); raw[buf][mm][bj][IN_F32 ? 1 : 0] = GLDU4(xin32, eo * 4u + 16u); } \
            else raw[buf][mm][bj][0] = GLDU4(xg, eo * 2u); } } while (0)
        EPIRES_LOAD(0, 0);
#pragma unroll
        for (int hb = 0; hb < 4; ++hb) {
            const int ai = hb >> 1, cb_ = hb & 1;
            if (hb < 3) { if (cb_ == 0) EPIRES_LOAD(1, (hb + 1)); else EPIRES_LOAD(0, (hb + 1)); }
#pragma unroll
            for (int mm = 0; mm < 2; ++mm) {
                const int m = (hb & 1) * 2 + mm;
                const unsigned ro = e0 + (unsigned)((ai * 128 + m * 16) * 1024);
                float s = 0.f;
#pragma unroll
                for (int bj = 0; bj < 2; ++bj) {
                    f32x4 x0, x1;
                    if (IN_F32) { x0 = __builtin_bit_cast(f32x4, raw[cb_][mm][bj][0]); x1 = __builtin_bit_cast(f32x4, raw[cb_][mm][bj][IN_F32 ? 1 : 0]); }
                    else { const u32x4 r4 = raw[cb_][mm][bj][0]; x0 = (f32x4){bflo(r4.x), bfhi(r4.x), bflo(r4.y), bfhi(r4.y)} * ri[bj][0]; x1 = (f32x4){bflo(r4.z), bfhi(r4.z), bflo(r4.w), bfhi(r4.w)} * ri[bj][1]; }
                    const f32x4 v0 = x0 + gt[bj][0] * acc[ai][bj][m][0], v1 = x1 + gt[bj][1] * acc[ai][bj][m][1];
                    const unsigned eo = ro + (unsigned)(bj * 128);
                    if (LAST) { __builtin_nontemporal_store(v0, (f32x4*)((char*)xout32 + eo * 4u)); __builtin_nontemporal_store(v1, (f32x4*)((char*)xout32 + eo * 4u + 16u)); }
                    else {
                        const f32x4 q0 = v0 * v0, q1 = v1 * v1; s += ((q0[0] + q0[1]) + (q0[2] + q0[3])) + ((q1[0] + q1[1]) + (q1[2] + q1[3]));
                        const f32x4 o0 = v0 * gm[bj][0], o1 = v1 * gm[bj][1];
                        u32x4 w; w.x = pk2(o0[0], o0[1]); w.y = pk2(o0[2], o0[3]); w.z = pk2(o1[0], o1[1]); w.w = pk2(o1[2], o1[3]); GSTU4(xg, eo * 2u, w);
                    }
                }
                if (!LAST) { s += sx(s, 16, lane_e); s += sx(s, 32, lane_e); if (fq == 0) unsafeAtomicAdd(ssq + (row0 + ai * 128 + m * 16), s); }
            }
        }
#undef EPIRES_LOAD
    }
};

struct EpiNull {
    float* sink;
    __device__ __forceinline__ void operator()(const f32x4 (&acc)[2][2][4][2], const Unit& u, int wr, int wc, int fr, int fq) const {
        f32x4 t = (f32x4){0.f, 0.f, 0.f, 0.f};
#pragma unroll
        for (int ai = 0; ai < 2; ++ai)
#pragma unroll
            for (int bj = 0; bj < 2; ++bj)
#pragma unroll
                for (int m = 0; m < 4; ++m)
#pragma unroll
                    for (int n = 0; n < 2; ++n) t = t + acc[ai][bj][m][n];
        if (t[0] + t[1] + t[2] + t[3] == 1.2345e33f) sink[u.pm] = t[0];
    }
};

__device__ __forceinline__ f32x4 silu4(f32x4 a) {
    f32x4 r;
#pragma unroll
    for (int e = 0; e < 4; ++e) r[e] = a[e] * __builtin_amdgcn_rcpf(1.0f + __builtin_amdgcn_exp2f(-a[e] * LOG2E));
    return r;
}
template <int N_> __device__ __forceinline__ f32x4 ror4(f32x4 v) {
    f32x4 r;
#pragma unroll
    for (int e = 0; e < 4; ++e) r[e] = __int_as_float(__builtin_amdgcn_mov_dpp(__float_as_int(v[e]), 0x120 + N_, 0xf, 0xf, false));
    return r;
}
struct EpiGU {
    const float* ssq; const float* shw; const float* cw; const float* cbias; bf16_t* act; float* halo; float* fixp; float* fixu;
    __device__ __forceinline__ void operator()(const f32x4 (&acc)[2][2][4][2], const Unit& u, int wr, int wc, int fr_in, int fq_in) const {
        int fr = fr_in, fq = fq_in; asm volatile("" : "+v"(fr), "+v"(fq));
        const int b = u.pm >> 3;
        const int fcol = u.pn * 128 + wc * 32 + 8 * fq;
        const float* bias = shw + (size_t)b * 5632 + u.pn * 256;
        const unsigned boff = (unsigned)(wc * 32 + 4 * fq) * 4u;
        const int row0 = u.pm * 256 + wr * 64 + fr;
        float rsv[2][4];
#pragma unroll
        for (int ai = 0; ai < 2; ++ai)
#pragma unroll
            for (int m = 0; m < 4; ++m) rsv[ai][m] = GLD1(ssq, (unsigned)row0 * 4u + (ai * 128 + m * 16) * 4);
        f32x4 bg_[2], bu_[2], w0_[2], w1_[2], w2_[2], cb_[2];
#pragma unroll
        for (int n = 0; n < 2; ++n) {
            bg_[n] = GLD4(bias, boff + n * 64); bu_[n] = GLD4(bias, boff + 512 + n * 64);
            const unsigned co = (unsigned)fcol * 4u + n * 16;
            w0_[n] = GLD4(cw, co); w1_[n] = GLD4(cw, co + FF * 4); w2_[n] = GLD4(cw, co + 2 * FF * 4); cb_[n] = GLD4(cbias, co);
        }
#pragma unroll
        for (int ai = 0; ai < 2; ++ai)
#pragma unroll
            for (int m = 0; m < 4; ++m) rsv[ai][m] = rsqrtf(rsv[ai][m] * (1.0f / 1024.0f) + EPS);
        const unsigned aoff0 = ((unsigned)row0 * (unsigned)FF + (unsigned)fcol) * 2u;
#pragma unroll
        for (int ai = 0; ai < 2; ++ai) {
            const int gs = u.pm * 4 + ai * 2 + wr;
            f32x4 p1[2], p2[2];
#pragma unroll
            for (int n = 0; n < 2; ++n) { p1[n] = (f32x4){0.f, 0.f, 0.f, 0.f}; p2[n] = p1[n]; }
#pragma unroll
            for (int m = 0; m < 4; ++m) {
                const float rs = rsv[ai][m];
                f32x4 o[2];
#pragma unroll
                for (int n = 0; n < 2; ++n) {
                    const f32x4 g = acc[ai][0][m][n] * rs + bg_[n];
                    const f32x4 up = acc[ai][1][m][n] * rs + bu_[n];
                    const f32x4 c1 = ror4<1>(g), c2 = ror4<2>(g);
                    const f32x4 g1 = fr >= 1 ? c1 : p1[n];
                    const f32x4 g2 = fr >= 2 ? c2 : p2[n];
                    if (m == 0 && fr < 2) {
                        f32x4 pp = w2_[n] * g + cb_[n]; if (fr == 1) pp = pp + w1_[n] * g1;
                        const unsigned fo = ((unsigned)(gs * 2 + fr) * (unsigned)FF + (unsigned)fcol) * 4u + n * 16;
                        GST4(fixp, fo, pp); GST4(fixu, fo, up);
                    }
                    const f32x4 a = w2_[n] * g + w1_[n] * g1 + w0_[n] * g2 + cb_[n];
                    o[n] = silu4(a) * up;
                    if (m == 3 && fr >= 14) GST4(halo, ((unsigned)(gs * 2 + (fr - 14)) * (unsigned)FF + (unsigned)fcol) * 4u + n * 16, g);
                    p1[n] = c1; p2[n] = c2;
                }
                if (!(m == 0 && fr < 2)) {
                    u32x4 w; w.x = pk2(o[0][0], o[0][1]); w.y = pk2(o[0][2], o[0][3]); w.z = pk2(o[1][0], o[1][1]); w.w = pk2(o[1][2], o[1][3]);
                    GSTU4(act, aoff0 + (unsigned)((ai * 128 + m * 16) * FF) * 2u, w);
                }
            }
        }
    }
};

#define MFMA32(a, b, c) __builtin_amdgcn_mfma_f32_32x32x16_bf16((a), (b), (c), 0, 0, 0)
__device__ __forceinline__ int crow(int i, int h) { return (i & 3) + 8 * (i >> 2) + 4 * h; }
__device__ __forceinline__ bf16x8 pack8(float a0, float a1, float a2, float a3, float a4, float a5, float a6, float a7) {
    u32x4 p; p.x = pk2(a0, a1); p.y = pk2(a2, a3); p.z = pk2(a4, a5); p.w = pk2(a6, a7); return __builtin_bit_cast(bf16x8, p);
}
__device__ __forceinline__ bf16x8 tr8(const LAS unsigned char* p_lo, int hi_off) {
    const s16x4 lo = __builtin_amdgcn_ds_read_tr16_b64_v4i16((LAS s16x4*)p_lo);
    const s16x4 hi = __builtin_amdgcn_ds_read_tr16_b64_v4i16((LAS s16x4*)(p_lo + hi_off));
    return __builtin_shufflevector(lo, hi, 0, 1, 2, 3, 4, 5, 6, 7);
}

__device__ __forceinline__ void store_ot32(bf16_t* rowp, const f32x16& O, float sc, int hh) {
    u32x2 o2[4];
#pragma unroll
    for (int g = 0; g < 4; ++g) { o2[g].x = pk2(O[4 * g] * sc, O[4 * g + 1] * sc); o2[g].y = pk2(O[4 * g + 2] * sc, O[4 * g + 3] * sc); }
#pragma unroll
    for (int k = 0; k < 4; k += 2) {
        u32x2 a = o2[k], b = o2[k + 1];
        { const auto rx = __builtin_amdgcn_permlane32_swap(a.x, b.x, false, false); a.x = rx[0]; b.x = rx[1]; }
        { const auto ry = __builtin_amdgcn_permlane32_swap(a.y, b.y, false, false); a.y = ry[0]; b.y = ry[1]; }
        u32x4 w; w.x = a.x; w.y = a.y; w.z = b.x; w.w = b.y;
        *(u32x4*)((char*)rowp + (hh ? 16 : 0) + 16 * k) = w;
    }
}
constexpr int KSTR = 144, VSTR = 192;
constexpr int SBW_BYTES = 32 * VSTR;
constexpr float SB_EXIT = 64.0f;
__device__ __forceinline__ void sb_wave(LAS unsigned char* vl, const bf16_t* Q, const bf16_t* K, const bf16_t* V, bf16_t* Y, int b, int h, int qg, int lane) {
    const int r = lane & 31, hh = lane >> 5;
    const size_t rowbase = (size_t)b * SEQ;
    const int qw0 = 32 * qg;
    bf16x8 qf[4];
    { const bf16_t* qp = Q + (rowbase + qw0 + r) * 512 + h * 64 + 8 * hh;
#pragma unroll
      for (int s = 0; s < 4; ++s) qf[s] = *(const bf16x8*)(qp + 16 * s); }
    f32x16 O0, O1;
#pragma unroll
    for (int i = 0; i < 16; ++i) { O0[i] = 0.f; O1[i] = 0.f; }
    float carry = 0.f;
    const bf16_t* kp = K + (rowbase + r) * 512 + h * 64 + 8 * hh;
    const bf16_t* vp = V + (rowbase + (lane >> 3)) * 512 + h * 64 + (lane & 7) * 8;
    const int vst = (lane >> 3) * VSTR + (lane & 7) * 16;
    bf16x8 kf[4]; u32x4 vr[4];
#pragma unroll
    for (int s = 0; s < 4; ++s) kf[s] = *(const bf16x8*)(kp + (size_t)(32 * qg) * 512 + 16 * s);
#pragma unroll
    for (int i = 0; i < 4; ++i) vr[i] = *(const u32x4*)(vp + (size_t)(32 * qg + 8 * i) * 512);
    const int q4 = (lane & 15) >> 2, p4 = lane & 3, blk = (lane >> 4) & 1;
    const int vlane_off = (4 * hh + q4) * VSTR + 8 * (4 * blk + p4);
    for (int kb = qg; kb >= 0; --kb) {
        asm volatile("" ::: "memory");
#pragma unroll
        for (int i = 0; i < 4; ++i) *(LAS u32x4*)(vl + vst + 8 * i * VSTR) = vr[i];
        bf16x8 kc[4];
#pragma unroll
        for (int s = 0; s < 4; ++s) kc[s] = kf[s];
        if (kb > 0) {
#pragma unroll
            for (int s = 0; s < 4; ++s) kf[s] = *(const bf16x8*)(kp + (size_t)(32 * (kb - 1)) * 512 + 16 * s);
#pragma unroll
            for (int i = 0; i < 4; ++i) vr[i] = *(const u32x4*)(vp + (size_t)(32 * (kb - 1) + 8 * i) * 512);
        }
        const bool diag = (kb == qg);
        f32x16 z;
#pragma unroll
        for (int i = 0; i < 16; ++i) z[i] = 0.f;
#pragma unroll
        for (int s = 0; s < 4; ++s) z = MFMA32(kc[s], qf[s], z);
        float sp[16];
#pragma unroll
        for (int i = 0; i < 16; ++i) {
            const float e = __builtin_amdgcn_exp2f(z[i]);
            float v = __builtin_amdgcn_logf(1.0f + e);
            if (diag && !(crow(i, hh) < r)) v = 0.f;
            sp[i] = v;
        }
        float G[4], Gp[4];
#pragma unroll
        for (int g = 0; g < 4; ++g) { G[g] = (sp[4 * g] + sp[4 * g + 1]) + (sp[4 * g + 2] + sp[4 * g + 3]); Gp[g] = sx(G[g], 32, lane); }
        float suf = carry; float w[16];
#pragma unroll
        for (int g = 3; g >= 0; --g) {
            float run = suf + (hh == 0 ? Gp[g] : 0.f);
#pragma unroll
            for (int i = 4 * g + 3; i >= 4 * g; --i) {
                run += sp[i];
                float wv = __builtin_amdgcn_exp2f(z[i] - run);
                if (diag && !(crow(i, hh) < r)) wv = 0.f;
                w[i] = wv;
            }
            suf += G[g] + Gp[g];
        }
        carry = suf;
        LDS_WAIT();
#pragma unroll
        for (int s = 0; s < 2; ++s) {
            const bf16x8 pf = pack8(w[8 * s], w[8 * s + 1], w[8 * s + 2], w[8 * s + 3], w[8 * s + 4], w[8 * s + 5], w[8 * s + 6], w[8 * s + 7]);
            const LAS unsigned char* vq = vl + (16 * s) * VSTR + vlane_off;
            const bf16x8 a0 = tr8(vq, 8 * VSTR), a1 = tr8(vq + 64, 8 * VSTR);
            O0 = MFMA32(a0, pf, O0); O1 = MFMA32(a1, pf, O1);
        }
        if (__all(carry >= SB_EXIT)) break;
    }
    bf16_t* yp = Y + (rowbase + qw0 + r) * 1024 + 512 + h * 64;
    store_ot32(yp, O0, 1.0f, hh); store_ot32(yp + 32, O1, 1.0f, hh);
}

constexpr int SW_VOFF = 192 * KSTR;
constexpr int SW_BUF = 192 * KSTR + 192 * VSTR;
__device__ __forceinline__ void swa_phase(LAS unsigned char* lds, const bf16_t* Q, const bf16_t* K, const bf16_t* V, const float* sinks, bf16_t* Y, int bid, int G, int tid, int wid, int lane) {
    const int r = lane & 31, hh = lane >> 5, qsub = wid & 1;
    const int q4 = (lane & 15) >> 2, p4 = lane & 3, blk = (lane >> 4) & 1;
    const int vlane_off = (4 * hh + q4) * VSTR + 8 * (4 * blk + p4);
    int u = (G % 8 == 0) ? (bid % 8) * (G / 8) + bid / 8 : bid;
    if (u >= 2048) return;
    u32x4 kv[3], vv[3]; bf16x8 qn[4];
#define SWA_LOAD(uu) do { const int qc_ = (uu) & 31, kvh_ = ((uu) >> 5) & 3, b_ = (uu) >> 7; \
        _Pragma("unroll") for (int it = 0; it < 3; ++it) { const int idx = tid + it * 512, srow = idx >> 3, spc = idx & 7, kpos = 64 * qc_ - 128 + srow; \
            kv[it] = (u32x4){0u, 0u, 0u, 0u}; vv[it] = (u32x4){0u, 0u, 0u, 0u}; \
            if (kpos >= 0) { const unsigned off = ((unsigned)(b_ * SEQ + kpos) * 256u + (unsigned)(kvh_ * 64 + spc * 8)) * 2u; kv[it] = GLDU4(K, off); vv[it] = GLDU4(V, off); } } \
        { const unsigned qo = ((unsigned)(b_ * SEQ + 64 * qc_ + 32 * qsub + r) * 1024u + (unsigned)((4 * kvh_ + (wid >> 1)) * 64 + 8 * hh)) * 2u; \
          _Pragma("unroll") for (int s = 0; s < 4; ++s) qn[s] = __builtin_bit_cast(bf16x8, GLDU4(Q, qo + 32 * s)); } } while (0)
    SWA_LOAD(u);
    int cur = 0;
    __syncthreads();
    for (;;) {
        const int qc = u & 31, kvh = (u >> 5) & 3, b = u >> 7;
        const int head = 4 * kvh + (wid >> 1);
        const int qw0 = 64 * qc + 32 * qsub;
        const int kbase = 64 * qc - 128;
        LAS unsigned char* kb_ = lds + cur * SW_BUF; LAS unsigned char* vb_ = kb_ + 192 * KSTR;
#pragma unroll
        for (int it = 0; it < 3; ++it) { const int idx = tid + it * 512, srow = idx >> 3, spc = idx & 7; *(LAS u32x4*)(kb_ + srow * KSTR + spc * 16) = kv[it]; *(LAS u32x4*)(vb_ + srow * VSTR + spc * 16) = vv[it]; }
        bf16x8 qf[4];
#pragma unroll
        for (int s = 0; s < 4; ++s) qf[s] = qn[s];
        __syncthreads();
        const int un = u + G; const bool has_next = un < 2048;
        if (has_next) SWA_LOAD(un);
        f32x16 O0, O1;
#pragma unroll
        for (int i = 0; i < 16; ++i) { O0[i] = 0.f; O1[i] = 0.f; }
        float mrun = sinks[head] * LOG2E, lsum = (hh == 0) ? 1.0f : 0.0f;
#pragma unroll
        for (int j = 0; j < 5; ++j) {
            const int rb = qsub + j;
            const int key0 = kbase + 32 * rb;
            if (key0 >= 0) {
                f32x16 z;
#pragma unroll
                for (int i = 0; i < 16; ++i) z[i] = 0.f;
#pragma unroll
                for (int s = 0; s < 4; ++s) { const bf16x8 a = *(const LAS bf16x8*)(kb_ + (32 * rb + r) * KSTR + 32 * s + 16 * hh); z = MFMA32(a, qf[s], z); }
                float bm = -3.0e38f;
#pragma unroll
                for (int i = 0; i < 16; ++i) {
                    bool valid = true;
                    if (j == 0) valid = (crow(i, hh) > r);
                    if (j == 4) valid = (crow(i, hh) <= r);
                    if (!valid) z[i] = -3.0e38f;
                    bm = fmaxf(bm, z[i]);
                }
                bm = fmaxf(bm, sx(bm, 32, lane));
                if (__any(bm > mrun + 8.0f)) {
                    const float mnew = fmaxf(mrun, bm);
                    const float alpha = __builtin_amdgcn_exp2f(mrun - mnew);
                    mrun = mnew; lsum *= alpha;
#pragma unroll
                    for (int i = 0; i < 16; ++i) { O0[i] *= alpha; O1[i] *= alpha; }
                }
                float w[16]; float ps = 0.f;
#pragma unroll
                for (int i = 0; i < 16; ++i) { w[i] = __builtin_amdgcn_exp2f(z[i] - mrun); ps += w[i]; }
                lsum += ps;
#pragma unroll
                for (int s = 0; s < 2; ++s) {
                    const bf16x8 pf = pack8(w[8 * s], w[8 * s + 1], w[8 * s + 2], w[8 * s + 3], w[8 * s + 4], w[8 * s + 5], w[8 * s + 6], w[8 * s + 7]);
                    const LAS unsigned char* vp = vb_ + (32 * rb + 16 * s) * VSTR + vlane_off;
                    const bf16x8 a0 = tr8(vp, 8 * VSTR), a1 = tr8(vp + 64, 8 * VSTR);
                    O0 = MFMA32(a0, pf, O0); O1 = MFMA32(a1, pf, O1);
                }
            }
        }
        lsum += sx(lsum, 32, lane);
        const float inv = 1.0f / lsum;
        bf16_t* yp = Y + ((size_t)b * SEQ + qw0 + r) * 1024 + head * 64;
        store_ot32(yp, O0, inv, hh); store_ot32(yp + 32, O1, inv, hh);
        if (!has_next) break;
        u = un; cur ^= 1;
    }
#undef SWA_LOAD
}

constexpr int XCS = 68;
constexpr int LR_RAWSTR = 144, LR_GR = 37376, LR_XCW = 53760, LR_EXCH = 123392, LR_CW = 125440  , LR_WF = 126720  ;
struct LruArgs { const bf16_t* XR; const bf16_t* GR; bf16_t* Y; const float* convw; const float* convb; const float* wa; const float* ba; const float* wx; const float* bx; const float* lam; };
__device__ __forceinline__ void lru_item(LAS unsigned char* lds, const LruArgs& A, int item, int tid, int wid, int lane) {
    const int b = item >> 4, n = (item >> 1) & 7, half = item & 1;
    const int r = lane & 31, hh = lane >> 5;
    const int co = lane & 7, tsub = lane >> 3;
    const size_t rowbase = (size_t)b * SEQ;
    LAS float* xcw = (LAS float*)(lds + LR_XCW + wid * (32 * XCS * 4));
    LAS float* exch = (LAS float*)(lds + LR_EXCH);
    __syncthreads();
    {
        LAS float* cwl = (LAS float*)(lds + LR_CW);
#pragma unroll
        for (int k = 0; k < 4; ++k)
#pragma unroll
            for (int j = 0; j < 8; ++j) cwl[k * 64 + 8 * co + j] = A.convw[k * 512 + 64 * n + 8 * co + j];
#pragma unroll
        for (int j = 0; j < 8; ++j) cwl[256 + 8 * co + j] = A.convb[64 * n + 8 * co + j];
#pragma unroll
        for (int s = 0; s < 4; ++s) {
            float ta[8], tx[8];
#pragma unroll
            for (int j = 0; j < 8; ++j) { const int idx = (n * 64 + 16 * s + 8 * hh + j) * 64 + 32 * half + r; ta[j] = A.wa[idx]; tx[j] = A.wx[idx]; }
            *(LAS bf16x8*)(lds + LR_WF + (2 * s) * 1024 + lane * 16) = pack8(ta[0], ta[1], ta[2], ta[3], ta[4], ta[5], ta[6], ta[7]);
            *(LAS bf16x8*)(lds + LR_WF + (2 * s + 1) * 1024 + lane * 16) = pack8(tx[0], tx[1], tx[2], tx[3], tx[4], tx[5], tx[6], tx[7]);
        }
    }
    const int c = 64 * n + 32 * half + r;
    const float ba_c = A.ba[c], bx_c = A.bx[c];
    const float lam_c = A.lam[c];
    const float spl2 = 8.0f * (fmaxf(-lam_c, 0.f) + log1pf(expf(-fabsf(lam_c)))) * LOG2E;
    u32x4 praw[5], pgr[2];
    const bf16_t* xrb = A.XR + rowbase * 512 + 64 * n;
    const bf16_t* grb = A.GR + rowbase * 512 + 64 * n + 32 * half;
#define LRU_LOAD(cc) do { \
        _Pragma("unroll") for (int i_ = 0; i_ < 5; ++i_) { const int idx = tid + 512 * i_, j = idx >> 3, pc = idx & 7, pos = 256 * (cc) - 3 + j; \
            praw[i_] = (u32x4){0u, 0u, 0u, 0u}; if (idx < 2072 && pos >= 0) praw[i_] = *(const u32x4*)(xrb + (size_t)pos * 512 + 8 * pc); } \
        _Pragma("unroll") for (int i_ = 0; i_ < 2; ++i_) { const int idx = tid + 512 * i_, j = idx >> 2, pc = idx & 3; \
            pgr[i_] = *(const u32x4*)(grb + (size_t)(256 * (cc) + j) * 512 + 8 * pc); } } while (0)
    LRU_LOAD(0);
    float carry = 0.f;
    for (int cch = 0; cch < 8; ++cch) {
        __syncthreads();
#pragma unroll
        for (int i_ = 0; i_ < 5; ++i_) { const int idx = tid + 512 * i_; if (idx < 2072) *(LAS u32x4*)(lds + (idx >> 3) * LR_RAWSTR + (idx & 7) * 16) = praw[i_]; }
#pragma unroll
        for (int i_ = 0; i_ < 2; ++i_) { const int idx = tid + 512 * i_; *(LAS u32x4*)(lds + LR_GR + (idx >> 2) * 64 + (idx & 3) * 16) = pgr[i_]; }
        if (cch < 7) LRU_LOAD(cch + 1);
        __syncthreads();
        float cw[4][8], cbv[8];
        {
            const LAS float* cwl = (const LAS float*)(lds + LR_CW);
#pragma unroll
            for (int k = 0; k < 4; ++k) { const f32x4 t0 = *(const LAS f32x4*)(cwl + k * 64 + 8 * co), t1 = *(const LAS f32x4*)(cwl + k * 64 + 8 * co + 4);
                cw[k][0] = t0[0]; cw[k][1] = t0[1]; cw[k][2] = t0[2]; cw[k][3] = t0[3]; cw[k][4] = t1[0]; cw[k][5] = t1[1]; cw[k][6] = t1[2]; cw[k][7] = t1[3]; }
            const f32x4 t0 = *(const LAS f32x4*)(cwl + 256 + 8 * co), t1 = *(const LAS f32x4*)(cwl + 256 + 8 * co + 4);
            cbv[0] = t0[0]; cbv[1] = t0[1]; cbv[2] = t0[2]; cbv[3] = t0[3]; cbv[4] = t1[0]; cbv[5] = t1[1]; cbv[6] = t1[2]; cbv[7] = t1[3];
        }
#pragma unroll
        for (int p = 0; p < 4; ++p) {
            const int tl = 8 * p + tsub;
            float av[8];
#pragma unroll
            for (int j = 0; j < 8; ++j) av[j] = cbv[j];
#pragma unroll
            for (int k = 0; k < 4; ++k) {
                const u32x4 raw = *(const LAS u32x4*)(lds + (32 * wid + tl + k) * LR_RAWSTR + co * 16);
                av[0] += cw[k][0] * bflo(raw.x); av[1] += cw[k][1] * bfhi(raw.x); av[2] += cw[k][2] * bflo(raw.y); av[3] += cw[k][3] * bfhi(raw.y);
                av[4] += cw[k][4] * bflo(raw.z); av[5] += cw[k][5] * bfhi(raw.z); av[6] += cw[k][6] * bflo(raw.w); av[7] += cw[k][7] * bfhi(raw.w);
            }
            *(LAS f32x4*)(xcw + tl * XCS + 8 * co) = (f32x4){av[0], av[1], av[2], av[3]};
            *(LAS f32x4*)(xcw + tl * XCS + 8 * co + 4) = (f32x4){av[4], av[5], av[6], av[7]};
        }
        LDS_WAIT();
        f32x16 R, I;
#pragma unroll
        for (int i = 0; i < 16; ++i) { R[i] = 0.f; I[i] = 0.f; }
#pragma unroll
        for (int s = 0; s < 4; ++s) {
            const f32x4 a0 = *(const LAS f32x4*)(xcw + r * XCS + 16 * s + 8 * hh), a1 = *(const LAS f32x4*)(xcw + r * XCS + 16 * s + 8 * hh + 4);
            const bf16x8 af = pack8(a0[0], a0[1], a0[2], a0[3], a1[0], a1[1], a1[2], a1[3]);
            const bf16x8 wa_f = *(const LAS bf16x8*)(lds + LR_WF + (2 * s) * 1024 + lane * 16), wx_f = *(const LAS bf16x8*)(lds + LR_WF + (2 * s + 1) * 1024 + lane * 16);
            R = MFMA32(af, wa_f, R); I = MFMA32(af, wx_f, I);
        }
        float av_[16], uv_[16];
#pragma unroll
        for (int i = 0; i < 16; ++i) {
            const float xcf = xcw[crow(i, hh) * XCS + 32 * half + r];
            const float rr = __builtin_amdgcn_rcpf(1.0f + __builtin_amdgcn_exp2f(-(R[i] + ba_c) * LOG2E));
            const float ii = __builtin_amdgcn_rcpf(1.0f + __builtin_amdgcn_exp2f(-(I[i] + bx_c) * LOG2E));
            const float la2 = -rr * spl2;
            const float a = __builtin_amdgcn_exp2f(la2);
            const float y = la2 * (2.0f / LOG2E);
            const float om = (y > -0.25f) ? -y * (1.0f + y * (0.5f + y * ((1.0f / 6.0f) + y * ((1.0f / 24.0f) + y * (1.0f / 120.0f))))) : 1.0f - a * a;
            av_[i] = a; uv_[i] = sqrtf(om) * ii * xcf;
        }
        asm volatile("" ::: "memory");
        float Ag[4], Bg[4], pA[4], pB[4];
#pragma unroll
        for (int g = 0; g < 4; ++g) {
            Ag[g] = (av_[4 * g] * av_[4 * g + 1]) * (av_[4 * g + 2] * av_[4 * g + 3]);
            Bg[g] = ((uv_[4 * g] * av_[4 * g + 1] + uv_[4 * g + 1]) * av_[4 * g + 2] + uv_[4 * g + 2]) * av_[4 * g + 3] + uv_[4 * g + 3];
            pA[g] = sx(Ag[g], 32, lane); pB[g] = sx(Bg[g], 32, lane);
        }
        float hcur = 0.f, acur = 1.0f;
#pragma unroll
        for (int g = 0; g < 4; ++g) {
            const float A0 = hh == 0 ? Ag[g] : pA[g], B0 = hh == 0 ? Bg[g] : pB[g];
            const float A1 = hh == 0 ? pA[g] : Ag[g], B1 = hh == 0 ? pB[g] : Bg[g];
            const float s0 = hcur, c0 = acur; hcur = A0 * hcur + B0; acur *= A0;
            const float s1 = hcur, c1 = acur; hcur = A1 * hcur + B1; acur *= A1;
            float hv = hh == 0 ? s0 : s1, ac = hh == 0 ? c0 : c1;
#pragma unroll
            for (int i = 4 * g; i < 4 * g + 4; ++i) { hv = av_[i] * hv + uv_[i]; ac *= av_[i]; uv_[i] = hv; av_[i] = ac; }
        }
        if (hh == 0) { exch[(wid * 32 + r) * 2] = acur; exch[(wid * 32 + r) * 2 + 1] = hcur; }
        __syncthreads();
        float hin = carry, run = carry;
#pragma unroll
        for (int w8 = 0; w8 < 8; ++w8) { if (w8 == wid) hin = run; run = exch[(w8 * 32 + r) * 2] * run + exch[(w8 * 32 + r) * 2 + 1]; }
        carry = run;
        LAS unsigned char* ot = (LAS unsigned char*)xcw;
#pragma unroll
        for (int i = 0; i < 16; ++i) {
            const int tl = crow(i, hh);
            const float hv = uv_[i] + av_[i] * hin;
            const float gv = bflo((unsigned)*(const LAS unsigned short*)(lds + LR_GR + (32 * wid + tl) * 64 + r * 2));
            const float yy = 0.7978845608028654f * (gv + 0.044715f * gv * gv * gv);
            const float ge = gv * __builtin_amdgcn_rcpf(1.0f + __builtin_amdgcn_exp2f(-2.0f * LOG2E * yy));
            *(LAS unsigned short*)(ot + tl * 64 + r * 2) = (unsigned short)(pk2(hv * ge, 0.f) & 0xffffu);
        }
        LDS_WAIT();
#pragma unroll
        for (int k2 = 0; k2 < 2; ++k2) {
            const int idx = lane + 64 * k2, row = idx >> 2, pc = idx & 3;
            const u32x4 w = *(const LAS u32x4*)(ot + row * 64 + pc * 16);
            *(u32x4*)(A.Y + (rowbase + 256 * cch + 32 * wid + row) * 1024 + 64 * n + 32 * half + 8 * pc) = w;
        }
        asm volatile("" ::: "memory");
    }
#undef LRU_LOAD
}

__device__ __forceinline__ float wave_sum(float v, int lane) {
#pragma unroll
    for (int o = 1; o < 64; o <<= 1) v += sx(v, o, lane);
    return v;
}
__device__ __forceinline__ int headperm(int n) { return (n & ~255) | (((n >> 5) & 1) << 7) | (((n >> 6) & 3) << 5) | (n & 31); }
struct TrItem { const float* W; bf16_t* WT; int N, K, k0, n0, d0, perm; };
__device__ __forceinline__ void tr_load(const TrItem& t, int lane, float (&tv)[32]) {
#pragma unroll
    for (int i = 0; i < 32; ++i) { const int kk = 2 * i + (lane >> 5); tv[i] = t.W[(size_t)(t.k0 + kk) * t.N + t.n0 + (lane & 31)]; }
}
__device__ __forceinline__ void tr_store(const TrItem& t, int lane, const float (&tv)[32], LAS float* scr) {
#pragma unroll
    for (int i = 0; i < 32; ++i) { const int kk = 2 * i + (lane >> 5); scr[kk * 33 + (lane & 31)] = tv[i]; }
    LDS_WAIT();
    const int c8 = lane & 7;
#pragma unroll
    for (int j = 0; j < 4; ++j) { const int nl = (lane >> 3) + 8 * j; const LAS float* sp = scr + (8 * c8) * 33 + nl; const int n = t.perm ? (16 * ((nl >> 2) & 1) + 4 * (nl >> 3) + (nl & 3)) : nl;
        u32x4 o; o.x = pk2(sp[0 * 33], sp[1 * 33]); o.y = pk2(sp[2 * 33], sp[3 * 33]); o.z = pk2(sp[4 * 33], sp[5 * 33]); o.w = pk2(sp[6 * 33], sp[7 * 33]);
        *(u32x4*)(t.WT + (size_t)(t.d0 + n) * t.K + t.k0 + 8 * c8) = o; }
    LDS_WAIT();
}

#define XB_TMO      128
#define XB_XCNT(j)  (256  + 64 * (j))
#define XB_XSUB(j)  (1280 + 64 * (j))
#define XB_XGEN(j)  (2304 + 64 * (j))
#define XB_TOP      3328
#define XB_TOPGEN   3392
#define XCD_BAR_WORDS 3456
#define XB_SPIN_CAP (1u << 20)
__device__ __forceinline__ unsigned xb_ld(unsigned* p)              { return __hip_atomic_load(p, __ATOMIC_RELAXED, __HIP_MEMORY_SCOPE_AGENT); }
__device__ __forceinline__ unsigned xb_add(unsigned* p, unsigned v) { return __hip_atomic_fetch_add(p, v, __ATOMIC_RELAXED, __HIP_MEMORY_SCOPE_AGENT); }
__device__ __forceinline__ unsigned xb_xcc_id() { return (unsigned)__builtin_amdgcn_s_getreg((3 << 11) | 20) & 0xFu; }
#define XB_SPIN(cond, bar) do { unsigned _sp = 0; while (cond) { __builtin_amdgcn_s_sleep(1); \
    if ((++_sp & 255u) == 0u) { if (xb_ld(&(bar)[XB_TMO])) break; if (_sp > XB_SPIN_CAP) { atomicAdd(&(bar)[XB_TMO], 1u); break; } } } } while (0)
struct XcdBarrier { unsigned* bar; unsigned x; volatile LAS unsigned* st; };
__device__ __forceinline__ void xcd_barrier_complete(unsigned* bar, unsigned x, unsigned& nloc, unsigned& nx) {
    const unsigned G = gridDim.x * gridDim.y * gridDim.z;
    unsigned sum, cnt, mine, sp = 0u;
    for (;;) {
        sum = 0u; cnt = 0u; mine = 0u;
#pragma unroll
        for (unsigned j = 0; j < 16; ++j) { const unsigned c = xb_ld(&bar[XB_XCNT(j)]); sum += c; cnt += (c > 0u) ? 1u : 0u; mine = (j == x) ? c : mine; }
        if (sum == G) break;
        __builtin_amdgcn_s_sleep(1);
        if ((++sp & 255u) == 0u) { if (xb_ld(&bar[XB_TMO])) break; if (sp > XB_SPIN_CAP) { atomicAdd(&bar[XB_TMO], 1u); break; } }
    }
    nloc = mine > 0u ? mine : 1u; nx = cnt > 0u ? cnt : 1u;
}
__device__ __forceinline__ void xcd_barrier(const XcdBarrier& b, const bool leader) {
    asm volatile("s_waitcnt vmcnt(0)" ::: "memory");
    __syncthreads();
    if (leader) {
        unsigned* bar = b.bar;
        __builtin_amdgcn_s_waitcnt(0);
        unsigned nloc = b.st[0], nx = b.st[1];
        if (nloc == 0u) { xcd_barrier_complete(bar, b.x, nloc, nx); b.st[0] = nloc; b.st[1] = nx; }
        const unsigned old = xb_add(&bar[XB_XSUB(b.x)], 1u);
        const unsigned gen = old / nloc;
        if (old + 1u == (gen + 1u) * nloc) {
            __builtin_amdgcn_fence(__ATOMIC_RELEASE, "agent");
            asm volatile("s_waitcnt vmcnt(0)" ::: "memory");
            const unsigned og = xb_add(&bar[XB_TOP], 1u);
            const unsigned tg = og / nx;
            if (og + 1u == (tg + 1u) * nx) xb_add(&bar[XB_TOPGEN], 1u);
            else XB_SPIN(xb_ld(&bar[XB_TOPGEN]) == tg, bar);
            __builtin_amdgcn_fence(__ATOMIC_ACQUIRE, "agent");
            xb_add(&bar[XB_XGEN(b.x)], 1u);
            asm volatile("s_waitcnt vmcnt(0)" ::: "memory");
        } else {
            XB_SPIN(xb_ld(&bar[XB_XGEN(b.x)]) == gen, bar);
            __builtin_amdgcn_fence(__ATOMIC_ACQUIRE, "agent");
            asm volatile("s_waitcnt vmcnt(0)" ::: "memory");
        }
    }
    __syncthreads();
}

struct Args { const float* in[27]; float* out; unsigned char* ws; };

__global__ void __launch_bounds__(512, 2) fwd_mega(Args args) {
    extern __shared__ __attribute__((aligned(16))) unsigned char lds_raw[];
    LAS unsigned char* lds = (LAS unsigned char*)lds_raw;
    cg::grid_group grid = cg::this_grid();
#ifndef STAGGER_TICKS
#define STAGGER_TICKS 0
#endif
#define STAGGER() do { if (STAGGER_TICKS > 0 && ((bid >> 3) & 1)) { const unsigned long long t0_ = __builtin_amdgcn_s_memrealtime(); while (__builtin_amdgcn_s_memrealtime() - t0_ < (unsigned long long)STAGGER_TICKS) __builtin_amdgcn_s_sleep(16); } } while (0)
#define GSYNC_CG() do { if (args.ws == nullptr) grid.sync(); GSYNC(); } while (0)
#define GSYNC() do { int l_; asm volatile("v_mbcnt_lo_u32_b32 %0, -1, 0\n\tv_mbcnt_hi_u32_b32 %0, -1, %0" : "=v"(l_)); xcd_barrier(xbar, wid_s == 0 && l_ == 0); if (DUP_MASK & 4) xcd_barrier(xbar, wid_s == 0 && l_ == 0); } while (0)
    const int G = gridDim.x, bid = blockIdx.x, NGW = G * 8;
    const int wid_s = __builtin_amdgcn_readfirstlane((int)threadIdx.x >> 6);
    XcdBarrier xbar;
    {
        volatile LAS unsigned* st = (volatile LAS unsigned*)(lds + 139264);
        if (threadIdx.x < 4) st[threadIdx.x] = 0u;
        __syncthreads();
        xbar.bar = (unsigned*)(args.ws + WS_BAR); xbar.x = xb_xcc_id(); xbar.st = st;
        if (threadIdx.x == 0) (void)xb_add(&xbar.bar[XB_XCNT(xbar.x)], 1u);
    }
#define PHASE_IDS int lane_; asm volatile("v_mbcnt_lo_u32_b32 %0, -1, 0\n\tv_mbcnt_hi_u32_b32 %0, -1, %0" : "=v"(lane_)); const int lane = lane_ & 63; const int wid = wid_s; const int tid = wid * 64 + lane; const int gw = bid * 8 + wid; (void)gw;
    unsigned char* ws = args.ws;
    const float* x = args.in[0]; const float* cc = args.in[1]; const float* ada_w = args.in[2]; const float* ada_b = args.in[3];
    const float* norm_mix_g = args.in[4]; const float* norm_ffn_g = args.in[5];
    float* MOD = (float*)(ws + WS_MOD); float* SHW = (float*)(ws + WS_SHW);
    float* SSQ0 = (float*)(ws + WS_SSQ0); float* SSQ1 = (float*)(ws + WS_SSQ1); float* SSQ2 = (float*)(ws + WS_SSQ2); float* SSQ3 = (float*)(ws + WS_SSQ3);
    bf16_t* XG = (bf16_t*)(ws + WS_XG); bf16_t* PB = (bf16_t*)(ws + WS_P); bf16_t* YB = (bf16_t*)(ws + WS_Y); bf16_t* ACT = (bf16_t*)(ws + WS_ACT); bf16_t* XS = (bf16_t*)(ws + WS_XS);
    float* HALO = (float*)(ws + WS_HALO); float* FIXP = (float*)(ws + WS_FIXP); float* FIXU = (float*)(ws + WS_FIXU);
    bf16_t* W_IN0 = (bf16_t*)(ws + WS_W_IN0); bf16_t* W_OUT0 = (bf16_t*)(ws + WS_W_OUT0); bf16_t* W_GU0 = (bf16_t*)(ws + WS_W_GU0); bf16_t* W_DN0 = (bf16_t*)(ws + WS_W_DN0);
    bf16_t* W_IN1 = (bf16_t*)(ws + WS_W_IN1); bf16_t* W_OUT1 = (bf16_t*)(ws + WS_W_OUT1); bf16_t* W_GU1 = (bf16_t*)(ws + WS_W_GU1); bf16_t* W_DN1 = (bf16_t*)(ws + WS_W_DN1);

    for (int prep = 0; prep < ((DUP_MASK & 8) ? 2 : 1); ++prep) {
    for (int item = bid; item < 256; item += G) {
        PHASE_IDS
        const int l = item >> 7, chunk = item & 127;
        LAS float* sl = (LAS float*)lds;
        LAS float* part = (LAS float*)(lds + 65536);
        __syncthreads();
        for (int idx = tid; idx < 16384; idx += 512) { const float v = cc[idx]; sl[idx] = v / (1.0f + __expf(-v)); }
        __syncthreads();
        float acc[16];
#pragma unroll
        for (int bb = 0; bb < 16; ++bb) acc[bb] = 0.f;
        const int colc = chunk * 48 + (lane < 48 ? lane : 47);
        const float* Wp = ada_w + (size_t)l * 1024 * 6144 + colc;
        float wv[16], wn[16];
#pragma unroll
        for (int j = 0; j < 16; ++j) { wv[j] = Wp[(size_t)(128 * wid + j) * 6144]; wn[j] = 0.f; }
        for (int k = 128 * wid; k < 128 * wid + 128; k += 16) {
            if (k + 16 < 128 * wid + 128) {
#pragma unroll
                for (int j = 0; j < 16; ++j) wn[j] = Wp[(size_t)(k + 16 + j) * 6144];
            }
#pragma unroll
            for (int j4 = 0; j4 < 4; ++j4)
#pragma unroll
                for (int bb = 0; bb < 16; ++bb) { const f32x4 s4 = *(const LAS f32x4*)(sl + bb * 1024 + k + 4 * j4); acc[bb] += (s4[0] * wv[4 * j4] + s4[1] * wv[4 * j4 + 1]) + (s4[2] * wv[4 * j4 + 2] + s4[3] * wv[4 * j4 + 3]); }
#pragma unroll
            for (int j = 0; j < 16; ++j) wv[j] = wn[j];
        }
#pragma unroll
        for (int bb = 0; bb < 16; ++bb) part[(wid * 16 + bb) * 64 + lane] = acc[bb];
        __syncthreads();
        for (int o = tid; o < 1024; o += 512) {
            const int bb = o >> 6, cl = o & 63;
            if (cl < 48) {
                float sacc = ada_b[l * 6144 + chunk * 48 + cl];
#pragma unroll
                for (int w8 = 0; w8 < 8; ++w8) sacc += part[(w8 * 16 + bb) * 64 + cl];
                MOD[((size_t)l * 16 + bb) * 6144 + chunk * 48 + cl] = sacc;
            }
        }
        __syncthreads();
    }
    {
        PHASE_IDS
        LAS float* scr = (LAS float*)(lds + wid * 16384);
        constexpr int NITEMS = 1280 + 512 + 3 * 1408 + 768 + 512 + 3 * 1408;
#define TR_DECODE(T_, it_) do { int rI = (it_); int mapk; \
            if (rI < 1280) { T_.W = args.in[6]; T_.N = 2560; T_.K = 1024; T_.WT = W_IN0; mapk = 1; } \
            else if ((rI -= 1280) < 512) { T_.W = args.in[16]; T_.N = 1024; T_.K = 1024; T_.WT = W_OUT0; mapk = 0; } \
            else if ((rI -= 512) < 1408) { T_.W = args.in[22]; T_.N = FF; T_.K = 1024; T_.WT = W_GU0; mapk = 3; } \
            else if ((rI -= 1408) < 1408) { T_.W = args.in[23]; T_.N = FF; T_.K = 1024; T_.WT = W_GU0; mapk = 4; } \
            else if ((rI -= 1408) < 1408) { T_.W = args.in[26]; T_.N = 1024; T_.K = FF; T_.WT = W_DN0; mapk = 0; } \
            else if ((rI -= 1408) < 768) { T_.W = args.in[17]; T_.N = 1536; T_.K = 1024; T_.WT = W_IN1; mapk = 2; } \
            else if ((rI -= 768) < 512) { T_.W = args.in[21]; T_.N = 1024; T_.K = 1024; T_.WT = W_OUT1; mapk = 0; } \
            else if ((rI -= 512) < 1408) { T_.W = args.in[22] + (size_t)1024 * FF; T_.N = FF; T_.K = 1024; T_.WT = W_GU1; mapk = 3; } \
            else if ((rI -= 1408) < 1408) { T_.W = args.in[23] + (size_t)1024 * FF; T_.N = FF; T_.K = 1024; T_.WT = W_GU1; mapk = 4; } \
            else { rI -= 1408; T_.W = args.in[26] + (size_t)FF * 1024; T_.N = 1024; T_.K = FF; T_.WT = W_DN1; mapk = 0; } \
            const int nblk = T_.N / 32, kb_ = rI / nblk, nb_ = rI % nblk; T_.k0 = 64 * kb_; T_.n0 = 32 * nb_; \
            int d0 = T_.n0; \
            if (mapk == 1) { const int region = T_.n0 >> 9; if (region == 2 || region == 3) d0 = headperm(T_.n0); } \
            else if (mapk == 2) { if (T_.n0 < 1280) d0 = headperm(T_.n0); } \
            else if (mapk == 3) d0 = 256 * (T_.n0 >> 7) + (T_.n0 & 127); \
            else if (mapk == 4) d0 = 256 * (T_.n0 >> 7) + 128 + (T_.n0 & 127); \
            T_.d0 = d0; T_.perm = 1; } while (0)
        for (int it = gw; it < NITEMS; it += 2 * NGW) {
            const bool two = (it + NGW) < NITEMS;
            TrItem ta, tb; TR_DECODE(ta, it); TR_DECODE(tb, two ? it + NGW : it);
            float va[32], vb[32];
            tr_load(ta, lane, va);
            if (two) tr_load(tb, lane, vb);
            tr_store(ta, lane, va, scr);
            if (two) tr_store(tb, lane, vb, scr);
        }
#undef TR_DECODE
    }
    GSYNC_CG();

    {
    PHASE_IDS
    for (int i0 = 0; i0 < 32; i0 += 8) {
        f32x4 v4[8];
#pragma unroll
        for (int i = 0; i < 8; ++i) {
            const int e = (tid + 512 * (i0 + i)) * 4, gi = e >> 14, bb = (e >> 10) & 15, k = e & 1023;
            v4[i] = *(const f32x4*)(MOD + ((size_t)((gi >> 1) * 16 + bb)) * 6144 + ((gi & 1) ? 3 * 1024 : 0) + k);
        }
#pragma unroll
        for (int i = 0; i < 8; ++i) {
            const int e = (tid + 512 * (i0 + i)) * 4;
            u32x2 w; w.x = pk2(v4[i][0], v4[i][1]); w.y = pk2(v4[i][2], v4[i][3]);
            *(LAS u32x2*)(lds + (size_t)e * 2) = w;
        }
    }
    {
        const int mbase = gw * (M / NGW);
        const int bb = mbase >> 11;
        f32x4 gm[4];
#pragma unroll
        for (int j = 0; j < 4; ++j) { const int c4 = 2 * lane + (j & 1) + 128 * (j >> 1);
            gm[j] = *((const f32x4*)norm_mix_g + c4) * (*((const f32x4*)(MOD + (size_t)bb * 6144 + 1024) + c4) + 1.0f); }
        const int nrow = M / NGW;
        for (int i0 = 0; i0 + 4 <= nrow; i0 += 4) {
            f32x4 v[4][4];
#pragma unroll
            for (int rr = 0; rr < 4; ++rr)
#pragma unroll
                for (int j = 0; j < 4; ++j) v[rr][j] = *((const f32x4*)(x + (size_t)(mbase + i0 + rr) * 1024) + 2 * lane + (j & 1) + 128 * (j >> 1));
            float sacc[4];
#pragma unroll
            for (int rr = 0; rr < 4; ++rr) {
                u32x4* op = (u32x4*)(XG + (size_t)(mbase + i0 + rr) * 1024) + lane;
                sacc[rr] = 0.f;
#pragma unroll
                for (int jj = 0; jj < 2; ++jj) {
                    const f32x4 q0 = v[rr][2 * jj] * v[rr][2 * jj], q1 = v[rr][2 * jj + 1] * v[rr][2 * jj + 1];
                    sacc[rr] += ((q0[0] + q0[1]) + (q0[2] + q0[3])) + ((q1[0] + q1[1]) + (q1[2] + q1[3]));
                    const f32x4 o0 = v[rr][2 * jj] * gm[2 * jj], o1 = v[rr][2 * jj + 1] * gm[2 * jj + 1];
                    u32x4 w; w.x = pk2(o0[0], o0[1]); w.y = pk2(o0[2], o0[3]); w.z = pk2(o1[0], o1[1]); w.w = pk2(o1[2], o1[3]); op[64 * jj] = w;
                }
            }
#pragma unroll
            for (int o = 1; o < 64; o <<= 1) {
#pragma unroll
                for (int rr = 0; rr < 4; ++rr) sacc[rr] += sx(sacc[rr], o, lane);
            }
            if (lane < 4) SSQ0[mbase + i0 + lane] = lane == 0 ? sacc[0] : (lane == 1 ? sacc[1] : (lane == 2 ? sacc[2] : sacc[3]));
        }
    }
    __syncthreads();
    {
        constexpr int NROWS = 2560 + 5632 + 1536 + 5632;
        for (int p0 = gw; p0 < NROWS; p0 += 2 * NGW) {
            asm volatile("" ::: "memory");
            u32x4 r0[2], r1[2]; int gi_[2], pl_[2], N_[2]; float* out_[2];
#pragma unroll
            for (int rr = 0; rr < 2; ++rr) {
                int p = p0 + rr * NGW; if (p >= NROWS) p = p0;
                const bf16_t* Wt; int gi, pl, N; float* outp;
                if (p < 2560) { gi = 0; pl = p; N = 2560; Wt = W_IN0; outp = SHW + SHW_IN0; }
                else if (p < 8192) { gi = 1; pl = p - 2560; N = 5632; Wt = W_GU0; outp = SHW + SHW_GU0; }
                else if (p < 9728) { gi = 2; pl = p - 8192; N = 1536; Wt = W_IN1; outp = SHW + SHW_IN1; }
                else { gi = 3; pl = p - 9728; N = 5632; Wt = W_GU1; outp = SHW + SHW_GU1; }
                r0[rr] = *(const u32x4*)(Wt + (size_t)pl * 1024 + 8 * lane); r1[rr] = *(const u32x4*)(Wt + (size_t)pl * 1024 + 512 + 8 * lane);
                gi_[rr] = gi; pl_[rr] = pl; N_[rr] = N; out_[rr] = outp;
            }
#pragma unroll
            for (int rr = 0; rr < 2; ++rr) {
                if (rr == 1 && p0 + NGW >= NROWS) break;
                float wv[16];
                wv[0] = bflo(r0[rr].x); wv[1] = bfhi(r0[rr].x); wv[2] = bflo(r0[rr].y); wv[3] = bfhi(r0[rr].y); wv[4] = bflo(r0[rr].z); wv[5] = bfhi(r0[rr].z); wv[6] = bflo(r0[rr].w); wv[7] = bfhi(r0[rr].w);
                wv[8] = bflo(r1[rr].x); wv[9] = bfhi(r1[rr].x); wv[10] = bflo(r1[rr].y); wv[11] = bfhi(r1[rr].y); wv[12] = bflo(r1[rr].z); wv[13] = bfhi(r1[rr].z); wv[14] = bflo(r1[rr].w); wv[15] = bfhi(r1[rr].w);
                float d[16];
                const LAS unsigned char* sbase = lds + (size_t)gi_[rr] * 32768 + 16 * lane;
#pragma unroll
                for (int bb = 0; bb < 16; ++bb) {
                    const u32x4 s0 = *(const LAS u32x4*)(sbase + bb * 2048), s1 = *(const LAS u32x4*)(sbase + bb * 2048 + 1024);
                    d[bb] = (wv[0] * bflo(s0.x) + wv[1] * bfhi(s0.x)) + (wv[2] * bflo(s0.y) + wv[3] * bfhi(s0.y)) + (wv[4] * bflo(s0.z) + wv[5] * bfhi(s0.z)) + (wv[6] * bflo(s0.w) + wv[7] * bfhi(s0.w))
                          + (wv[8] * bflo(s1.x) + wv[9] * bfhi(s1.x)) + (wv[10] * bflo(s1.y) + wv[11] * bfhi(s1.y)) + (wv[12] * bflo(s1.z) + wv[13] * bfhi(s1.z)) + (wv[14] * bflo(s1.w) + wv[15] * bfhi(s1.w));
                }
                const bool h5 = (lane & 32) != 0, h4 = (lane & 16) != 0, h3 = (lane & 8) != 0, h2 = (lane & 4) != 0;
                float e8[8], e4[4], e2[2];
#pragma unroll
                for (int j = 0; j < 8; ++j) { const float snd = h5 ? d[j] : d[j + 8], kp = h5 ? d[j + 8] : d[j]; e8[j] = kp + sx(snd, 32, lane); }
#pragma unroll
                for (int j = 0; j < 4; ++j) { const float snd = h4 ? e8[j] : e8[j + 4], kp = h4 ? e8[j + 4] : e8[j]; e4[j] = kp + sx(snd, 16, lane); }
#pragma unroll
                for (int j = 0; j < 2; ++j) { const float snd = h3 ? e4[j] : e4[j + 2], kp = h3 ? e4[j + 2] : e4[j]; e2[j] = kp + sx(snd, 8, lane); }
                float tot; { const float snd = h2 ? e2[0] : e2[1], kp = h2 ? e2[1] : e2[0]; tot = kp + sx(snd, 4, lane); }
                tot += sx(tot, 2, lane); tot += sx(tot, 1, lane);
                const int bsel = (h5 ? 8 : 0) + (h4 ? 4 : 0) + (h3 ? 2 : 0) + (h2 ? 1 : 0);
                if ((lane & 3) == 0) out_[rr][(size_t)bsel * N_[rr] + pl_[rr]] = tot;
            }
        }
    }
    }
    GSYNC();

    }
    pg8::StaticOrder S;
    {
        PHASE_IDS
        pg8::Gemm g{XG, W_IN0, M, 2560, 1024}; S.init(M, 2560, G, bid);
        EpiIn<0> E{SSQ0, SHW + SHW_IN0, 2560, PB, args.in[14], args.in[15]};
        pg8::gemm_phase<EpiIn<0>>(lds, g, S, E, tid);
    }
#if (DUP_MASK & 32)
    {
        PHASE_IDS
        pg8::Gemm g{XG, W_IN0, M, 2560, 1024}; S.init(M, 2560, G, bid);
        EpiIn<0> E{SSQ0, SHW + SHW_IN0, 2560, PB, args.in[14], args.in[15]};
        pg8::gemm_phase<EpiIn<0>>(lds, g, S, E, tid);
    }
#endif
    GSYNC();

    {
        const bf16_t* XR = PB; const bf16_t* GR = PB + (size_t)M * 512; const bf16_t* Qb = PB + (size_t)2 * M * 512; const bf16_t* Kb = PB + (size_t)3 * M * 512; const bf16_t* Vb = PB + (size_t)4 * M * 512;
        PHASE_IDS
        LruArgs LA{XR, GR, YB, args.in[7], args.in[8], args.in[9], args.in[10], args.in[11], args.in[12], args.in[13]};
        for (int rep = 0; rep < ((DUP_MASK & 1) ? 2 : 1); ++rep) {
        for (int rep2 = 0; rep2 < ((DUP_MASK & 256) ? 2 : 1); ++rep2)
        for (int item = bid; item < 256; item += G) lru_item(lds, LA, item, tid, wid, lane);
        __syncthreads();
        for (int bu = bid; bu < 1024; bu += G) {
            const int bh = bu & 127, qhi = 7 - (bu >> 7);
            sb_wave(lds + wid * SBW_BYTES, Qb, Kb, Vb, YB, bh >> 3, bh & 7, qhi * 8 + wid, lane);
        }
        }
    }
    GSYNC();

    {
        PHASE_IDS
        pg8::Gemm g{YB, W_OUT0, M, 1024, 1024}; S.init(M, 1024, G, bid);
        EpiRes<false, false> E{nullptr, nullptr, MOD + 2 * 1024, norm_mix_g, MOD + 1 * 1024, norm_ffn_g, MOD + 4 * 1024, XG, SSQ1};
        pg8::gemm_phase<EpiRes<false, false>>(lds, g, S, E, tid);
    }
    GSYNC();

    for (int layer = 0; layer < 2; ++layer) {
        if (layer == 1) {
            {
                PHASE_IDS
                pg8::Gemm g{XG, W_IN1, M, 1536, 1024}; S.init(M, 1536, G, bid);
                EpiIn<1> E{SSQ2, SHW + SHW_IN1, 1536, PB, args.in[18], args.in[19]};
                pg8::gemm_phase<EpiIn<1>>(lds, g, S, E, tid);
            }
            GSYNC();
            {
                const bf16_t* Qb = PB; const bf16_t* Kb = PB + (size_t)M * 1024; const bf16_t* Vb = Kb + (size_t)M * 256;
                PHASE_IDS
                for (int rep = 0; rep < ((DUP_MASK & 16) ? 2 : 1); ++rep)
                swa_phase(lds, Qb, Kb, Vb, args.in[20], YB, bid, G, tid, wid, lane);
            }
            GSYNC();
            {
                PHASE_IDS
                pg8::Gemm g{YB, W_OUT1, M, 1024, 1024}; S.init(M, 1024, G, bid);
                EpiRes<false, false> E{nullptr, nullptr, MOD + (size_t)16 * 6144 + 2 * 1024, norm_mix_g + 1024, MOD + (size_t)16 * 6144 + 1 * 1024, norm_ffn_g + 1024, MOD + (size_t)16 * 6144 + 4 * 1024, XG, SSQ3};
                pg8::gemm_phase<EpiRes<false, false>>(lds, g, S, E, tid);
            }
            GSYNC();
        }
#if (DUP_MASK & 64)
        {
            PHASE_IDS
            pg8::Gemm g{XG, layer ? W_GU1 : W_GU0, M, 5632, 1024}; S.init(M, 5632, G, bid);
            EpiGU E{layer ? SSQ3 : SSQ1, SHW + (layer ? SHW_GU1 : SHW_GU0), args.in[24] + (size_t)layer * 3 * FF, args.in[25] + (size_t)layer * FF, ACT, HALO, FIXP, FIXU};
            pg8::gemm_phase<EpiGU>(lds, g, S, E, tid);
        }
#endif
        {
            PHASE_IDS
            pg8::Gemm g{XG, layer ? W_GU1 : W_GU0, M, 5632, 1024}; S.init(M, 5632, G, bid);
            EpiGU E{layer ? SSQ3 : SSQ1, SHW + (layer ? SHW_GU1 : SHW_GU0), args.in[24] + (size_t)layer * 3 * FF, args.in[25] + (size_t)layer * FF, ACT, HALO, FIXP, FIXU};
            pg8::gemm_phase<EpiGU>(lds, g, S, E, tid);
        }
        GSYNC();
        {
            PHASE_IDS
            const float* cw = args.in[24] + (size_t)layer * 3 * FF;
            pg8::StaticOrder SF; SF.init(M, 1024, G, bid);
            Unit fu; int prev_pm = -1;
            for (int ui = 0; SF.next(ui, fu); ++ui) {
                if (fu.pm == prev_pm) continue;
                prev_pm = fu.pm;
                for (int idx = tid; idx < 8 * 704; idx += 512) {
                    const int c4 = idx % 704, sr = idx / 704, s = sr & 1, gs = 4 * fu.pm + (sr >> 1);
                    const size_t fo = ((size_t)gs * 2 + s) * FF + 4 * c4;
                    f32x4 a = *(const f32x4*)(FIXP + fo); const f32x4 up = *(const f32x4*)(FIXU + fo);
                    if ((gs & 31) != 0) {
                        const f32x4 h1 = *(const f32x4*)(HALO + ((size_t)(gs - 1) * 2 + 1) * FF + 4 * c4);
                        const f32x4 w0 = *(const f32x4*)(cw + 4 * c4);
                        if (s == 0) { const f32x4 h2 = *(const f32x4*)(HALO + ((size_t)(gs - 1) * 2) * FF + 4 * c4); const f32x4 w1 = *(const f32x4*)(cw + FF + 4 * c4); a = a + w1 * h1 + w0 * h2; }
                        else a = a + w0 * h1;
                    }
                    const f32x4 o = silu4(a) * up; u32x2 w; w.x = pk2(o[0], o[1]); w.y = pk2(o[2], o[3]);
                    *(u32x2*)(ACT + (size_t)(gs * 64 + s) * FF + 4 * c4) = w;
                }
            }
            asm volatile("s_waitcnt vmcnt(0)" ::: "memory");
            __syncthreads();
        }
        if (layer == 0) {
            PHASE_IDS
            pg8::Gemm g{ACT, W_DN0, M, 1024, FF}; S.init(M, 1024, G, bid);
            EpiRes<false, false> E{nullptr, nullptr, MOD + 5 * 1024, norm_ffn_g, MOD + 4 * 1024, norm_mix_g + 1024, MOD + (size_t)16 * 6144 + 1 * 1024, XG, SSQ2};
            pg8::gemm_phase<EpiRes<false, false>>(lds, g, S, E, tid);
#if (DUP_MASK & 1024)
            { EpiNull E3{HALO}; pg8::gemm_phase<EpiNull>(lds, g, S, E3, tid); }
#endif
            GSYNC();
        } else {
            PHASE_IDS
            pg8::Gemm g{ACT, W_DN1, M, 1024, FF}; S.init(M, 1024, G, bid);
            EpiRes<false, true> E{nullptr, args.out, MOD + (size_t)16 * 6144 + 5 * 1024, norm_ffn_g + 1024, MOD + (size_t)16 * 6144 + 4 * 1024, nullptr, nullptr, XG, nullptr};
            pg8::gemm_phase<EpiRes<false, true>>(lds, g, S, E, tid);
        }
    }
}

extern "C" void kernel_launch(void* const* d_in, const int* in_sizes, int n_in, void* d_out, int out_size, void* d_ws, size_t ws_size, hipStream_t stream) {
    static int grid = 0;
    if (grid == 0) {
        if (n_in != 27 || out_size != M * DM || ws_size < WS_END) { fprintf(stderr, "kernel_launch: unexpected shapes (n_in %d out %d ws %zu)\n", n_in, out_size, ws_size); grid = -1; return; }
        int dev = 0, cus = 0, per_cu = 0;
        (void)hipGetDevice(&dev);
        (void)hipDeviceGetAttribute(&cus, hipDeviceAttributeMultiprocessorCount, dev);
        (void)hipFuncSetAttribute((const void*)fwd_mega, hipFuncAttributeMaxDynamicSharedMemorySize, LDS_BYTES);
        (void)hipOccupancyMaxActiveBlocksPerMultiprocessor(&per_cu, (const void*)fwd_mega, 512, LDS_BYTES);
        (void)hipGetLastError();
        grid = cus;
        if (per_cu < 1) fprintf(stderr, "kernel_launch: occupancy query says %d blocks/CU\n", per_cu);
    }
    if (grid < 0) return;
    (void)hipMemsetAsync(d_ws, 0, WS_ZERO_BYTES, stream);
    Args a{};
    for (int i = 0; i < 27; ++i) a.in[i] = (const float*)d_in[i];
    a.out = (float*)d_out; a.ws = (unsigned char*)d_ws;
    void* kargs[] = {&a};
    hipError_t e = hipLaunchCooperativeKernel((const void*)fwd_mega, dim3(grid), dim3(512), kargs, LDS_BYTES, stream);
    if (e != hipSuccess) fprintf(stderr, "cooperative launch failed: %s (grid %d)\n", hipGetErrorString(e), grid);
}
```

```cpp
#include <hip/hip_runtime.h>
#include <hip/hip_cooperative_groups.h>
#include <cstdio>
#include <cstdint>
namespace cg = cooperative_groups;

#define LAS __attribute__((address_space(3)))
typedef unsigned short bf16_t;
typedef short bf16x8 __attribute__((ext_vector_type(8)));
typedef short s16x4 __attribute__((ext_vector_type(4)));
typedef float f32x4 __attribute__((ext_vector_type(4)));
typedef float f32x2 __attribute__((ext_vector_type(2)));
typedef float f32x16 __attribute__((ext_vector_type(16)));
typedef unsigned u32x4 __attribute__((ext_vector_type(4)));
typedef unsigned u32x2 __attribute__((ext_vector_type(2)));
typedef __bf16 bf2_t __attribute__((ext_vector_type(2)));

__device__ __forceinline__ unsigned pk2(float lo, float hi) { f32x2 v = {lo, hi}; bf2_t r = __builtin_convertvector(v, bf2_t); return __builtin_bit_cast(unsigned, r); }
__device__ __forceinline__ float bflo(unsigned u) { return __uint_as_float(u << 16); }
__device__ __forceinline__ float bfhi(unsigned u) { return __uint_as_float(u & 0xffff0000u); }
#define LDS_WAIT() asm volatile("s_waitcnt lgkmcnt(0)" ::: "memory")
__device__ __forceinline__ float sx(float v, int mask, int lane) { return __int_as_float(__builtin_amdgcn_ds_bpermute((lane ^ mask) << 2, __float_as_int(v))); }

constexpr int NB = 16, SEQ = 2048, DM = 1024, M = NB * SEQ, FF = 2816;
constexpr float EPS = 1e-6f;
constexpr float LOG2E = 1.4426950408889634f;
constexpr float QSCALE = 0.125f * LOG2E;

constexpr size_t MiB = 1u << 20;
constexpr size_t WS_SSQ1 = 0, WS_SSQ2 = 128 * 1024, WS_SSQ3 = 256 * 1024, WS_ZERO_BYTES = 512 * 1024;
constexpr size_t WS_BAR = 384 * 1024;
constexpr size_t WS_SSQ0 = 512 * 1024;
constexpr size_t WS_MOD = 1 * MiB;
constexpr size_t WS_SHW = 2 * MiB;
constexpr size_t SHW_IN0 = 0, SHW_GU0 = 16 * 2560, SHW_IN1 = SHW_GU0 + 16 * 5632, SHW_GU1 = SHW_IN1 + 16 * 1536;
constexpr size_t WS_HALO = 3 * MiB, WS_FIXP = 15 * MiB, WS_FIXU = 27 * MiB;
constexpr size_t WS_W_IN0 = 40 * MiB, WS_W_OUT0 = 45 * MiB, WS_W_GU0 = 47 * MiB, WS_W_DN0 = 58 * MiB;
constexpr size_t WS_W_IN1 = 64 * MiB, WS_W_OUT1 = 67 * MiB, WS_W_GU1 = 69 * MiB, WS_W_DN1 = 80 * MiB;
constexpr size_t WS_XG = 96 * MiB;
constexpr size_t WS_P = 160 * MiB;
constexpr size_t WS_Y = 320 * MiB;
constexpr size_t WS_ACT = 160 * MiB;
constexpr size_t WS_XS = 384 * MiB;
constexpr size_t WS_END = 448 * MiB;

constexpr int LDS_BYTES = 147456;
#ifndef DUP_MASK
#define DUP_MASK 0
#endif

namespace pg8 {
constexpr int BM = 256, BK = 64, HALF = 128, HTB = HALF * BK * 2, STAGE_BYTES = 8 * HTB, NXCD = 8, WGM = 4;
__host__ __device__ __forceinline__ int lds_byte(int r, int c) { const int st = (r >> 4) * 2 + (c >> 5), rr = r & 15, cc = c & 31, ob = rr * 64 + cc * 2; return st * 1024 + (ob ^ (((ob >> 9) & 1) << 5)); }
__host__ __device__ __forceinline__ void stage_rc(int b, int& R, int& C) { const int st = b / 1024, sb = b % 1024, swz = sb ^ (((sb >> 9) & 1) << 5); R = (st >> 1) * 16 + swz / 64; C = (st & 1) * 32 + (swz % 64) / 2; }
struct Unit { int pm, pn; };
struct Gemm { const bf16_t* A; const bf16_t* Bt; int M, N, K; };
struct StaticOrder {
    int nM, nN, nwg, G, c;
    __host__ __device__ void init(int M_, int N_, int G_, int c_) { nM = M_ / BM; nN = N_ / BM; nwg = nM * nN; G = G_; c = c_; }
    __host__ __device__ bool next(int i, Unit& u) const {
        const long L = (long)i * G + c; if (L >= nwg) return false;
        int wgid = (int)L; { const int q = nwg / NXCD, r = nwg % NXCD, xcd = wgid % NXCD, off = wgid / NXCD; wgid = (xcd < r ? xcd * (q + 1) : r * (q + 1) + (xcd - r) * q) + off; }
        const int nig = WGM * nN, gid = wgid / nig, fm = gid * WGM, gsz = (nM - fm) < WGM ? (nM - fm) : WGM;
        u.pm = fm + ((wgid % nig) % gsz); u.pn = (wgid % nig) / gsz; return true;
    }
};

template <class Epi, bool ALIGN_EPI = true, bool SP2 = true>
__device__ __forceinline__ void gemm_phase(LAS unsigned char* lds, const Gemm g, const StaticOrder& S, const Epi& E, const int tid) {
    const int wid = __builtin_amdgcn_readfirstlane(tid >> 6), lane = tid & 63, wr = wid >> 2, wc = wid & 3, fr = lane & 15, fq = lane >> 4;
    const int K = g.K, nt = K / BK;
    unsigned voffA[2];
#pragma unroll
    for (int i = 0; i < 2; ++i) { int R, C; stage_rc(tid * 16 + i * 8192, R, C); voffA[i] = (unsigned)(R * K + C) * 2u; }
    const size_t kstep = (size_t)(BK * 2);
    const size_t hstep = (size_t)HALF * K * 2;
    const size_t tstep = 2 * hstep;
    const unsigned ldsw = (unsigned)wid * 1024u;
    const int aoff = lds_byte(wr * 64 + fr, fq * 8), boff = lds_byte(wc * 32 + fr, fq * 8);
#define PG8_SA(b, h) (((b) * 2 + (h)) * HTB)
#define PG8_SB(b, h) ((4 + (b) * 2 + (h)) * HTB)
#define PG8_STAGE(bufoff, gbase, voff) do { _Pragma("unroll") for (int _i = 0; _i < 2; ++_i) \
        __builtin_amdgcn_global_load_lds((const unsigned*)((const char*)(gbase) + (voff)[_i]), (LAS unsigned*)(lds + (bufoff) + ldsw + _i * 8192), 16, 0, 0); } while (0)
#define PG8_LDA(dst, b, h) do { _Pragma("unroll") for (int m = 0; m < 4; ++m) _Pragma("unroll") for (int k = 0; k < 2; ++k) dst[m][k] = *(const LAS bf16x8*)(lds + PG8_SA(b, h) + aoff + m * 2048 + k * 1024); } while (0)
#define PG8_LDB(dst, b, h) do { _Pragma("unroll") for (int n = 0; n < 2; ++n) _Pragma("unroll") for (int k = 0; k < 2; ++k) dst[n][k] = *(const LAS bf16x8*)(lds + PG8_SB(b, h) + boff + n * 2048 + k * 1024); } while (0)
#define PG8_MMA(ai, bj, At, Bt) do { __builtin_amdgcn_s_setprio(1); _Pragma("unroll") for (int m = 0; m < 4; ++m) _Pragma("unroll") for (int n = 0; n < 2; ++n) _Pragma("unroll") for (int k = 0; k < 2; ++k) \
        acc[ai][bj][m][n] = __builtin_amdgcn_mfma_f32_16x16x32_bf16(Bt[n][k], At[m][k], acc[ai][bj][m][n], 0, 0, 0); __builtin_amdgcn_s_setprio(0); } while (0)
#define PG8_WAIT_V(n) asm volatile("s_waitcnt vmcnt(" #n ")" ::: "memory")
#define PG8_WAIT_L(n) asm volatile("s_waitcnt lgkmcnt(" #n ")" ::: "memory")
#define PG8_BAR __builtin_amdgcn_s_barrier()
#define PG8_SCHED __builtin_amdgcn_sched_barrier(0)
    Unit cur, nxt; int ui = 0;
    if (!S.next(0, cur)) return;
    f32x4 acc[2][2][4][2];
#pragma unroll
    for (int a = 0; a < 2; ++a)
#pragma unroll
        for (int b = 0; b < 2; ++b)
#pragma unroll
            for (int m = 0; m < 4; ++m)
#pragma unroll
                for (int n = 0; n < 2; ++n) acc[a][b][m][n] = (f32x4){0.f, 0.f, 0.f, 0.f};
    bf16x8 At[4][2], B0[2][2], B1[2][2];
    const char* cA = (const char*)g.A + (size_t)cur.pm * tstep; const char* cB = (const char*)g.Bt + (size_t)cur.pn * tstep;
    {
        PG8_STAGE(PG8_SB(0, 0), cB, voffA); PG8_STAGE(PG8_SB(0, 1), cB + hstep, voffA); PG8_STAGE(PG8_SA(0, 0), cA, voffA); PG8_STAGE(PG8_SA(0, 1), cA + hstep, voffA);
        if (wr == 1) PG8_BAR;
        PG8_WAIT_V(2); PG8_BAR;
        PG8_STAGE(PG8_SB(1, 0), cB + kstep, voffA); PG8_STAGE(PG8_SA(1, 0), cA + kstep, voffA); PG8_STAGE(PG8_SB(1, 1), cB + hstep + kstep, voffA);
        PG8_WAIT_V(6); PG8_BAR;
    }
    for (;;) {
        const bool has_next = S.next(ui + 1, nxt);
        const char* nA = has_next ? (const char*)g.A + (size_t)nxt.pm * tstep : cA; const char* nB = has_next ? (const char*)g.Bt + (size_t)nxt.pn * tstep : cB;
        for (int t = 0; t < nt; t += 2) {
            const bool last = (t == nt - 2);
            const char* a1 = cA + (size_t)(t + 1) * kstep;
            const char* a2 = last ? nA : cA + (size_t)(t + 2) * kstep; const char* b2 = last ? nB : cB + (size_t)(t + 2) * kstep;
            const char* a3 = a2 + kstep; const char* b3 = b2 + kstep;
            PG8_LDB(B0, 0, 0); PG8_LDB(B1, 0, 1); PG8_SCHED; PG8_LDA(At, 0, 0); PG8_STAGE(PG8_SA(1, 1), a1 + hstep, voffA);
            PG8_WAIT_V(8); PG8_WAIT_L(0); PG8_BAR; PG8_MMA(0, 0, At, B0); PG8_MMA(0, 1, At, B1); PG8_BAR; PG8_SCHED;
            PG8_LDA(At, 0, 1); PG8_STAGE(PG8_SB(0, 0), b2, voffA); PG8_STAGE(PG8_SB(0, 1), b2 + hstep, voffA); PG8_STAGE(PG8_SA(0, 0), a2, voffA);
            PG8_WAIT_V(8); PG8_WAIT_L(0); PG8_BAR; PG8_MMA(1, 0, At, B0); PG8_MMA(1, 1, At, B1); PG8_BAR; PG8_SCHED;
            PG8_LDB(B0, 1, 0); PG8_LDB(B1, 1, 1); PG8_SCHED; PG8_LDA(At, 1, 0); PG8_STAGE(PG8_SA(0, 1), a2 + hstep, voffA);
            PG8_WAIT_V(8); PG8_WAIT_L(0); PG8_BAR; PG8_MMA(0, 0, At, B0); PG8_MMA(0, 1, At, B1); PG8_BAR; PG8_SCHED;
            PG8_LDA(At, 1, 1); PG8_STAGE(PG8_SB(1, 0), b3, voffA); PG8_STAGE(PG8_SB(1, 1), b3 + hstep, voffA); PG8_STAGE(PG8_SA(1, 0), a3, voffA);
            PG8_WAIT_V(8); PG8_WAIT_L(0); PG8_BAR; PG8_MMA(1, 0, At, B0); PG8_MMA(1, 1, At, B1); PG8_BAR; PG8_SCHED;
        }
        if constexpr (ALIGN_EPI) { if (wr == 0) PG8_BAR; }
        { int le_; asm volatile("v_mbcnt_lo_u32_b32 %0, -1, 0\n\tv_mbcnt_hi_u32_b32 %0, -1, %0" : "=v"(le_));
          E(acc, cur, wr, wc, le_ & 15, (le_ >> 4) & 3); }
        if (!has_next) break;
#pragma unroll
        for (int a = 0; a < 2; ++a)
#pragma unroll
            for (int b = 0; b < 2; ++b)
#pragma unroll
                for (int m = 0; m < 4; ++m)
#pragma unroll
                    for (int n = 0; n < 2; ++n) acc[a][b][m][n] = (f32x4){0.f, 0.f, 0.f, 0.f};
        cur = nxt; cA = nA; cB = nB; ++ui;
        if constexpr (ALIGN_EPI) { if (wr == 1) PG8_BAR; }
    }
    PG8_WAIT_V(0);
    if constexpr (!ALIGN_EPI) { if (wr == 0) PG8_BAR; }
    PG8_BAR;
#undef PG8_SA
#undef PG8_SB
#undef PG8_STAGE
#undef PG8_LDA
#undef PG8_LDB
#undef PG8_MMA
#undef PG8_WAIT_V
#undef PG8_WAIT_L
#undef PG8_BAR
#undef PG8_SCHED
}
}
using pg8::Unit;


#define GLD4(base, boff) (*(const f32x4*)((const char*)(base) + (unsigned)(boff)))
#define GST4(base, boff, v) (*(f32x4*)((char*)(base) + (unsigned)(boff)) = (v))
#define GST2(base, boff, v) (*(u32x2*)((char*)(base) + (unsigned)(boff)) = (v))
#define GLD1(base, boff) (*(const float*)((const char*)(base) + (unsigned)(boff)))
#define GLDU4(base, boff) (*(const u32x4*)((const char*)(base) + (unsigned)(boff)))
#define GSTU4(base, boff, v) (*(u32x4*)((char*)(base) + (unsigned)(boff)) = (v))

template <int LAYER> struct EpiIn {
    const float* ssq; const float* shw; int N; bf16_t* P; const float* gq; const float* gk;
    __device__ __forceinline__ void operator()(const f32x4 (&acc)[2][2][4][2], const Unit& u, int wr, int wc, int fr_in, int fq_in) const {
        int fr = fr_in, fq = fq_in; asm volatile("" : "+v"(fr), "+v"(fq));
        const int b = u.pm >> 3; const int lane_e = fq * 16 + fr;
        bf16_t* base; int ld, col0, mode;
        if (LAYER == 0) { const int region = u.pn >> 1; base = P + (size_t)region * M * 512; ld = 512; col0 = (u.pn & 1) * 256; mode = region == 2 ? 1 : (region == 3 ? 2 : 0); }
        else {
            if (u.pn < 4) { base = P; ld = 1024; col0 = u.pn * 256; mode = 1; }
            else if (u.pn == 4) { base = P + (size_t)M * 1024; ld = 256; col0 = 0; mode = 2; }
            else { base = P + (size_t)M * 1024 + (size_t)M * 256; ld = 256; col0 = 0; mode = 0; }
        }
        const float* bias = shw + (size_t)b * N + u.pn * 256;
        const unsigned boff = (unsigned)(wc * 32 + 4 * fq) * 4u;
        f32x4 bv[2][2];
#pragma unroll
        for (int bj = 0; bj < 2; ++bj)
#pragma unroll
            for (int n = 0; n < 2; ++n) bv[bj][n] = GLD4(bias, boff + (bj * 128 + n * 16) * 4);
        const int row0 = u.pm * 256 + wr * 64 + fr;
        float rsv[2][4];
#pragma unroll
        for (int ai = 0; ai < 2; ++ai)
#pragma unroll
            for (int m = 0; m < 4; ++m) rsv[ai][m] = GLD1(ssq, (unsigned)row0 * 4u + (ai * 128 + m * 16) * 4);
#pragma unroll
        for (int ai = 0; ai < 2; ++ai)
#pragma unroll
            for (int m = 0; m < 4; ++m) rsv[ai][m] = rsqrtf(rsv[ai][m] * (1.0f / 1024.0f) + EPS);
        const unsigned ldb = (unsigned)ld * 2u;
        if (mode == 0) {
            const unsigned o0 = (unsigned)row0 * ldb + (unsigned)(col0 + wc * 32 + 8 * fq) * 2u;
#pragma unroll
            for (int ai = 0; ai < 2; ++ai)
#pragma unroll
                for (int m = 0; m < 4; ++m) {
                    const float rs = rsv[ai][m];
                    const unsigned ro = o0 + (unsigned)(ai * 128 + m * 16) * ldb;
#pragma unroll
                    for (int bj = 0; bj < 2; ++bj) { const f32x4 v0 = acc[ai][bj][m][0] * rs + bv[bj][0], v1 = acc[ai][bj][m][1] * rs + bv[bj][1];
                        u32x4 w; w.x = pk2(v0[0], v0[1]); w.y = pk2(v0[2], v0[3]); w.z = pk2(v1[0], v1[1]); w.w = pk2(v1[2], v1[3]); GSTU4(base, ro + (bj * 128) * 2, w); }
                }
        } else {
            const float* gn = (mode == 1) ? gq : gk; const float sc = (mode == 1) ? QSCALE : 1.0f;
            f32x4 gv[2][2];
#pragma unroll
            for (int bj = 0; bj < 2; ++bj)
#pragma unroll
                for (int n = 0; n < 2; ++n) gv[bj][n] = GLD4(gn, (unsigned)(8 * fq) * 4u + (32 * bj + 4 * n) * 4) * sc;
            const unsigned o0 = (unsigned)row0 * ldb + (unsigned)(col0 + 64 * wc + 8 * fq) * 2u;
#pragma unroll
            for (int ai = 0; ai < 2; ++ai)
#pragma unroll
                for (int m = 0; m < 4; ++m) {
                    const float rs = rsv[ai][m];
                    f32x4 v[2][2]; float ss = 0.f;
#pragma unroll
                    for (int bj = 0; bj < 2; ++bj)
#pragma unroll
                        for (int n = 0; n < 2; ++n) { v[bj][n] = acc[ai][bj][m][n] * rs + bv[bj][n]; const f32x4 q = v[bj][n] * v[bj][n]; ss += (q[0] + q[1]) + (q[2] + q[3]); }
                    ss += sx(ss, 16, lane_e); ss += sx(ss, 32, lane_e);
                    const float hr = rsqrtf(ss * (1.0f / 64.0f) + EPS);
                    const unsigned ro = o0 + (unsigned)(ai * 128 + m * 16) * ldb;
#pragma unroll
                    for (int bj = 0; bj < 2; ++bj) { const f32x4 o0_ = v[bj][0] * hr * gv[bj][0], o1_ = v[bj][1] * hr * gv[bj][1];
                        u32x4 w; w.x = pk2(o0_[0], o0_[1]); w.y = pk2(o0_[2], o0_[3]); w.z = pk2(o1_[0], o1_[1]); w.w = pk2(o1_[2], o1_[3]); GSTU4(base, ro + (32 * bj) * 2, w); }
                }
        }
    }
};

#define GLD2(base, boff) (*(const u32x2*)((const char*)(base) + (unsigned)(boff)))
template <bool IN_F32, bool LAST> struct EpiRes {
    const float* xin32; float* xout32; const float* gate; const float* pg; const float* psc; const float* ng; const float* nsc; bf16_t* xg; float* ssq;
    __device__ __forceinline__ void operator()(const f32x4 (&acc)[2][2][4][2], const Unit& u, int wr, int wc, int fr_in, int fq_in) const {
        int fr = fr_in, fq = fq_in; asm volatile("" : "+v"(fr), "+v"(fq));
        const int b = u.pm >> 3; const int lane_e = fq * 16 + fr; (void)lane_e;
        const int col = u.pn * 256 + wc * 32 + 8 * fq;
        const float* gtp = gate + (size_t)b * 6144; const float* nsp = LAST ? gate : nsc + (size_t)b * 6144; const float* psp = IN_F32 ? gate : psc + (size_t)b * 6144;
        f32x4 gt[2][2], gm[2][2], ri[2][2];
#pragma unroll
        for (int bj = 0; bj < 2; ++bj)
#pragma unroll
            for (int n = 0; n < 2; ++n) {
                const unsigned co = (unsigned)col * 4u + (bj * 128 + n * 4) * 4;
                gt[bj][n] = GLD4(gtp, co);
                if (!LAST) gm[bj][n] = GLD4(ng, co) * (GLD4(nsp, co) + 1.0f);
                if (!IN_F32) { const f32x4 d = GLD4(pg, co) * (GLD4(psp, co) + 1.0f); ri[bj][n] = (f32x4){1.0f / d[0], 1.0f / d[1], 1.0f / d[2], 1.0f / d[3]}; }
            }
        const int row0 = u.pm * 256 + wr * 64 + fr;
        const unsigned e0 = (unsigned)row0 * 1024u + (unsigned)col;
        u32x4 raw[2][2][2][IN_F32 ? 2 : 1];
#define EPIRES_LOAD(buf, hb_) do { _Pragma("unroll") for (int mm = 0; mm < 2; ++mm) _Pragma("unroll") for (int bj = 0; bj < 2; ++bj) { \
            const unsigned eo = e0 + (unsigned)(((hb_ >> 1) * 128 + ((hb_ & 1) * 2 + mm) * 16) * 1024 + bj * 128); \
            if (IN_F32) { raw[buf][mm][bj][0] = GLDU4(xin32, eo * 4u); raw[buf][mm][bj][IN_F32 ? 1 : 0] = GLDU4(xin32, eo * 4u + 16u); } \
            else raw[buf][mm][bj][0] = GLDU4(xg, eo * 2u); } } while (0)
        EPIRES_LOAD(0, 0);
#pragma unroll
        for (int hb = 0; hb < 4; ++hb) {
            const int ai = hb >> 1, cb_ = hb & 1;
            if (hb < 3) { if (cb_ == 0) EPIRES_LOAD(1, (hb + 1)); else EPIRES_LOAD(0, (hb + 1)); }
#pragma unroll
            for (int mm = 0; mm < 2; ++mm) {
                const int m = (hb & 1) * 2 + mm;
                const unsigned ro = e0 + (unsigned)((ai * 128 + m * 16) * 1024);
                float s = 0.f;
#pragma unroll
                for (int bj = 0; bj < 2; ++bj) {
                    f32x4 x0, x1;
                    if (IN_F32) { x0 = __builtin_bit_cast(f32x4, raw[cb_][mm][bj][0]); x1 = __builtin_bit_cast(f32x4, raw[cb_][mm][bj][IN_F32 ? 1 : 0]); }
                    else { const u32x4 r4 = raw[cb_][mm][bj][0]; x0 = (f32x4){bflo(r4.x), bfhi(r4.x), bflo(r4.y), bfhi(r4.y)} * ri[bj][0]; x1 = (f32x4){bflo(r4.z), bfhi(r4.z), bflo(r4.w), bfhi(r4.w)} * ri[bj][1]; }
                    const f32x4 v0 = x0 + gt[bj][0] * acc[ai][bj][m][0], v1 = x1 + gt[bj][1] * acc[ai][bj][m][1];
                    const unsigned eo = ro + (unsigned)(bj * 128);
                    if (LAST) { GST4(xout32, eo * 4u, v0); GST4(xout32, eo * 4u + 16u, v1); }
                    else {
                        const f32x4 q0 = v0 * v0, q1 = v1 * v1; s += ((q0[0] + q0[1]) + (q0[2] + q0[3])) + ((q1[0] + q1[1]) + (q1[2] + q1[3]));
                        const f32x4 o0 = v0 * gm[bj][0], o1 = v1 * gm[bj][1];
                        u32x4 w; w.x = pk2(o0[0], o0[1]); w.y = pk2(o0[2], o0[3]); w.z = pk2(o1[0], o1[1]); w.w = pk2(o1[2], o1[3]); GSTU4(xg, eo * 2u, w);
                    }
                }
                if (!LAST) { s += sx(s, 16, lane_e); s += sx(s, 32, lane_e); if (fq == 0) unsafeAtomicAdd(ssq + (row0 + ai * 128 + m * 16), s); }
            }
        }
#undef EPIRES_LOAD
    }
};

struct EpiNull {
    float* sink;
    __device__ __forceinline__ void operator()(const f32x4 (&acc)[2][2][4][2], const Unit& u, int wr, int wc, int fr, int fq) const {
        f32x4 t = (f32x4){0.f, 0.f, 0.f, 0.f};
#pragma unroll
        for (int ai = 0; ai < 2; ++ai)
#pragma unroll
            for (int bj = 0; bj < 2; ++bj)
#pragma unroll
                for (int m = 0; m < 4; ++m)
#pragma unroll
                    for (int n = 0; n < 2; ++n) t = t + acc[ai][bj][m][n];
        if (t[0] + t[1] + t[2] + t[3] == 1.2345e33f) sink[u.pm] = t[0];
    }
};

__device__ __forceinline__ f32x4 silu4(f32x4 a) {
    f32x4 r;
#pragma unroll
    for (int e = 0; e < 4; ++e) r[e] = a[e] * __builtin_amdgcn_rcpf(1.0f + __builtin_amdgcn_exp2f(-a[e] * LOG2E));
    return r;
}
template <int N_> __device__ __forceinline__ f32x4 ror4(f32x4 v) {
    f32x4 r;
#pragma unroll
    for (int e = 0; e < 4; ++e) r[e] = __int_as_float(__builtin_amdgcn_mov_dpp(__float_as_int(v[e]), 0x120 + N_, 0xf, 0xf, false));
    return r;
}
struct EpiGU {
    const float* ssq; const float* shw; const float* cw; const float* cbias; bf16_t* act; float* halo; float* fixp; float* fixu;
    __device__ __forceinline__ void operator()(const f32x4 (&acc)[2][2][4][2], const Unit& u, int wr, int wc, int fr_in, int fq_in) const {
        int fr = fr_in, fq = fq_in; asm volatile("" : "+v"(fr), "+v"(fq));
        const int b = u.pm >> 3;
        const int fcol = u.pn * 128 + wc * 32 + 8 * fq;
        const float* bias = shw + (size_t)b * 5632 + u.pn * 256;
        const unsigned boff = (unsigned)(wc * 32 + 4 * fq) * 4u;
        const int row0 = u.pm * 256 + wr * 64 + fr;
        float rsv[2][4];
#pragma unroll
        for (int ai = 0; ai < 2; ++ai)
#pragma unroll
            for (int m = 0; m < 4; ++m) rsv[ai][m] = GLD1(ssq, (unsigned)row0 * 4u + (ai * 128 + m * 16) * 4);
        f32x4 bg_[2], bu_[2], w0_[2], w1_[2], w2_[2], cb_[2];
#pragma unroll
        for (int n = 0; n < 2; ++n) {
            bg_[n] = GLD4(bias, boff + n * 64); bu_[n] = GLD4(bias, boff + 512 + n * 64);
            const unsigned co = (unsigned)fcol * 4u + n * 16;
            w0_[n] = GLD4(cw, co); w1_[n] = GLD4(cw, co + FF * 4); w2_[n] = GLD4(cw, co + 2 * FF * 4); cb_[n] = GLD4(cbias, co);
        }
#pragma unroll
        for (int ai = 0; ai < 2; ++ai)
#pragma unroll
            for (int m = 0; m < 4; ++m) rsv[ai][m] = rsqrtf(rsv[ai][m] * (1.0f / 1024.0f) + EPS);
        const unsigned aoff0 = ((unsigned)row0 * (unsigned)FF + (unsigned)fcol) * 2u;
#pragma unroll
        for (int ai = 0; ai < 2; ++ai) {
            const int gs = u.pm * 4 + ai * 2 + wr;
            f32x4 p1[2], p2[2];
#pragma unroll
            for (int n = 0; n < 2; ++n) { p1[n] = (f32x4){0.f, 0.f, 0.f, 0.f}; p2[n] = p1[n]; }
#pragma unroll
            for (int m = 0; m < 4; ++m) {
                const float rs = rsv[ai][m];
                f32x4 o[2];
#pragma unroll
                for (int n = 0; n < 2; ++n) {
                    const f32x4 g = acc[ai][0][m][n] * rs + bg_[n];
                    const f32x4 up = acc[ai][1][m][n] * rs + bu_[n];
                    const f32x4 c1 = ror4<1>(g), c2 = ror4<2>(g);
                    const f32x4 g1 = fr >= 1 ? c1 : p1[n];
                    const f32x4 g2 = fr >= 2 ? c2 : p2[n];
                    if (m == 0 && fr < 2) {
                        f32x4 pp = w2_[n] * g + cb_[n]; if (fr == 1) pp = pp + w1_[n] * g1;
                        const unsigned fo = ((unsigned)(gs * 2 + fr) * (unsigned)FF + (unsigned)fcol) * 4u + n * 16;
                        GST4(fixp, fo, pp); GST4(fixu, fo, up);
                    }
                    const f32x4 a = w2_[n] * g + w1_[n] * g1 + w0_[n] * g2 + cb_[n];
                    o[n] = silu4(a) * up;
                    if (m == 3 && fr >= 14) GST4(halo, ((unsigned)(gs * 2 + (fr - 14)) * (unsigned)FF + (unsigned)fcol) * 4u + n * 16, g);
                    p1[n] = c1; p2[n] = c2;
                }
                if (!(m == 0 && fr < 2)) {
                    u32x4 w; w.x = pk2(o[0][0], o[0][1]); w.y = pk2(o[0][2], o[0][3]); w.z = pk2(o[1][0], o[1][1]); w.w = pk2(o[1][2], o[1][3]);
                    GSTU4(act, aoff0 + (unsigned)((ai * 128 + m * 16) * FF) * 2u, w);
                }
            }
        }
    }
};

#define MFMA32(a, b, c) __builtin_amdgcn_mfma_f32_32x32x16_bf16((a), (b), (c), 0, 0, 0)
__device__ __forceinline__ int crow(int i, int h) { return (i & 3) + 8 * (i >> 2) + 4 * h; }
__device__ __forceinline__ bf16x8 pack8(float a0, float a1, float a2, float a3, float a4, float a5, float a6, float a7) {
    u32x4 p; p.x = pk2(a0, a1); p.y = pk2(a2, a3); p.z = pk2(a4, a5); p.w = pk2(a6, a7); return __builtin_bit_cast(bf16x8, p);
}
__device__ __forceinline__ bf16x8 tr8(const LAS unsigned char* p_lo, int hi_off) {
    const s16x4 lo = __builtin_amdgcn_ds_read_tr16_b64_v4i16((LAS s16x4*)p_lo);
    const s16x4 hi = __builtin_amdgcn_ds_read_tr16_b64_v4i16((LAS s16x4*)(p_lo + hi_off));
    return __builtin_shufflevector(lo, hi, 0, 1, 2, 3, 4, 5, 6, 7);
}

__device__ __forceinline__ void store_ot32(bf16_t* rowp, const f32x16& O, float sc, int hh) {
    u32x2 o2[4];
#pragma unroll
    for (int g = 0; g < 4; ++g) { o2[g].x = pk2(O[4 * g] * sc, O[4 * g + 1] * sc); o2[g].y = pk2(O[4 * g + 2] * sc, O[4 * g + 3] * sc); }
#pragma unroll
    for (int k = 0; k < 4; k += 2) {
        u32x2 a = o2[k], b = o2[k + 1];
        { const auto rx = __builtin_amdgcn_permlane32_swap(a.x, b.x, false, false); a.x = rx[0]; b.x = rx[1]; }
        { const auto ry = __builtin_amdgcn_permlane32_swap(a.y, b.y, false, false); a.y = ry[0]; b.y = ry[1]; }
        u32x4 w; w.x = a.x; w.y = a.y; w.z = b.x; w.w = b.y;
        *(u32x4*)((char*)rowp + (hh ? 16 : 0) + 16 * k) = w;
    }
}
constexpr int KSTR = 144, VSTR = 192;
constexpr int SBW_BYTES = 32 * VSTR;
constexpr float SB_EXIT = 64.0f;
__device__ __forceinline__ void sb_wave(LAS unsigned char* vl, const bf16_t* Q, const bf16_t* K, const bf16_t* V, bf16_t* Y, int b, int h, int qg, int lane) {
    const int r = lane & 31, hh = lane >> 5;
    const size_t rowbase = (size_t)b * SEQ;
    const int qw0 = 32 * qg;
    bf16x8 qf[4];
    { const bf16_t* qp = Q + (rowbase + qw0 + r) * 512 + h * 64 + 8 * hh;
#pragma unroll
      for (int s = 0; s < 4; ++s) qf[s] = *(const bf16x8*)(qp + 16 * s); }
    f32x16 O0, O1;
#pragma unroll
    for (int i = 0; i < 16; ++i) { O0[i] = 0.f; O1[i] = 0.f; }
    float carry = 0.f;
    const bf16_t* kp = K + (rowbase + r) * 512 + h * 64 + 8 * hh;
    const bf16_t* vp = V + (rowbase + (lane >> 3)) * 512 + h * 64 + (lane & 7) * 8;
    const int vst = (lane >> 3) * VSTR + (lane & 7) * 16;
    bf16x8 kf[4]; u32x4 vr[4];
#pragma unroll
    for (int s = 0; s < 4; ++s) kf[s] = *(const bf16x8*)(kp + (size_t)(32 * qg) * 512 + 16 * s);
#pragma unroll
    for (int i = 0; i < 4; ++i) vr[i] = *(const u32x4*)(vp + (size_t)(32 * qg + 8 * i) * 512);
    const int q4 = (lane & 15) >> 2, p4 = lane & 3, blk = (lane >> 4) & 1;
    const int vlane_off = (4 * hh + q4) * VSTR + 8 * (4 * blk + p4);
    for (int kb = qg; kb >= 0; --kb) {
        asm volatile("" ::: "memory");
#pragma unroll
        for (int i = 0; i < 4; ++i) *(LAS u32x4*)(vl + vst + 8 * i * VSTR) = vr[i];
        bf16x8 kc[4];
#pragma unroll
        for (int s = 0; s < 4; ++s) kc[s] = kf[s];
        if (kb > 0) {
#pragma unroll
            for (int s = 0; s < 4; ++s) kf[s] = *(const bf16x8*)(kp + (size_t)(32 * (kb - 1)) * 512 + 16 * s);
#pragma unroll
            for (int i = 0; i < 4; ++i) vr[i] = *(const u32x4*)(vp + (size_t)(32 * (kb - 1) + 8 * i) * 512);
        }
        const bool diag = (kb == qg);
        f32x16 z;
#pragma unroll
        for (int i = 0; i < 16; ++i) z[i] = 0.f;
#pragma unroll
        for (int s = 0; s < 4; ++s) z = MFMA32(kc[s], qf[s], z);
        float sp[16];
#pragma unroll
        for (int i = 0; i < 16; ++i) {
            const float e = __builtin_amdgcn_exp2f(z[i]);
            float v = __builtin_amdgcn_logf(1.0f + e);
            if (diag && !(crow(i, hh) < r)) v = 0.f;
            sp[i] = v;
        }
        float G[4], Gp[4];
#pragma unroll
        for (int g = 0; g < 4; ++g) { G[g] = (sp[4 * g] + sp[4 * g + 1]) + (sp[4 * g + 2] + sp[4 * g + 3]); Gp[g] = sx(G[g], 32, lane); }
        float suf = carry; float w[16];
#pragma unroll
        for (int g = 3; g >= 0; --g) {
            float run = suf + (hh == 0 ? Gp[g] : 0.f);
#pragma unroll
            for (int i = 4 * g + 3; i >= 4 * g; --i) {
                run += sp[i];
                float wv = __builtin_amdgcn_exp2f(z[i] - run);
                if (diag && !(crow(i, hh) < r)) wv = 0.f;
                w[i] = wv;
            }
            suf += G[g] + Gp[g];
        }
        carry = suf;
        LDS_WAIT();
#pragma unroll
        for (int s = 0; s < 2; ++s) {
            const bf16x8 pf = pack8(w[8 * s], w[8 * s + 1], w[8 * s + 2], w[8 * s + 3], w[8 * s + 4], w[8 * s + 5], w[8 * s + 6], w[8 * s + 7]);
            const LAS unsigned char* vq = vl + (16 * s) * VSTR + vlane_off;
            const bf16x8 a0 = tr8(vq, 8 * VSTR), a1 = tr8(vq + 64, 8 * VSTR);
            O0 = MFMA32(a0, pf, O0); O1 = MFMA32(a1, pf, O1);
        }
        if (__all(carry >= SB_EXIT)) break;
    }
    bf16_t* yp = Y + (rowbase + qw0 + r) * 1024 + 512 + h * 64;
    store_ot32(yp, O0, 1.0f, hh); store_ot32(yp + 32, O1, 1.0f, hh);
}

constexpr int SW_VOFF = 192 * KSTR;
constexpr int SW_BUF = 192 * KSTR + 192 * VSTR;
__device__ __forceinline__ void swa_phase(LAS unsigned char* lds, const bf16_t* Q, const bf16_t* K, const bf16_t* V, const float* sinks, bf16_t* Y, int bid, int G, int tid, int wid, int lane) {
    const int r = lane & 31, hh = lane >> 5, qsub = wid & 1;
    const int q4 = (lane & 15) >> 2, p4 = lane & 3, blk = (lane >> 4) & 1;
    const int vlane_off = (4 * hh + q4) * VSTR + 8 * (4 * blk + p4);
    int u = (G % 8 == 0) ? (bid % 8) * (G / 8) + bid / 8 : bid;
    if (u >= 2048) return;
    u32x4 kv[3], vv[3]; bf16x8 qn[4];
#define SWA_LOAD(uu) do { const int qc_ = (uu) & 31, kvh_ = ((uu) >> 5) & 3, b_ = (uu) >> 7; \
        _Pragma("unroll") for (int it = 0; it < 3; ++it) { const int idx = tid + it * 512, srow = idx >> 3, spc = idx & 7, kpos = 64 * qc_ - 128 + srow; \
            kv[it] = (u32x4){0u, 0u, 0u, 0u}; vv[it] = (u32x4){0u, 0u, 0u, 0u}; \
            if (kpos >= 0) { const unsigned off = ((unsigned)(b_ * SEQ + kpos) * 256u + (unsigned)(kvh_ * 64 + spc * 8)) * 2u; kv[it] = GLDU4(K, off); vv[it] = GLDU4(V, off); } } \
        { const unsigned qo = ((unsigned)(b_ * SEQ + 64 * qc_ + 32 * qsub + r) * 1024u + (unsigned)((4 * kvh_ + (wid >> 1)) * 64 + 8 * hh)) * 2u; \
          _Pragma("unroll") for (int s = 0; s < 4; ++s) qn[s] = __builtin_bit_cast(bf16x8, GLDU4(Q, qo + 32 * s)); } } while (0)
    SWA_LOAD(u);
    int cur = 0;
    __syncthreads();
    for (;;) {
        const int qc = u & 31, kvh = (u >> 5) & 3, b = u >> 7;
        const int head = 4 * kvh + (wid >> 1);
        const int qw0 = 64 * qc + 32 * qsub;
        const int kbase = 64 * qc - 128;
        LAS unsigned char* kb_ = lds + cur * SW_BUF; LAS unsigned char* vb_ = kb_ + 192 * KSTR;
#pragma unroll
        for (int it = 0; it < 3; ++it) { const int idx = tid + it * 512, srow = idx >> 3, spc = idx & 7; *(LAS u32x4*)(kb_ + srow * KSTR + spc * 16) = kv[it]; *(LAS u32x4*)(vb_ + srow * VSTR + spc * 16) = vv[it]; }
        bf16x8 qf[4];
#pragma unroll
        for (int s = 0; s < 4; ++s) qf[s] = qn[s];
        __syncthreads();
        const int un = u + G; const bool has_next = un < 2048;
        if (has_next) SWA_LOAD(un);
        f32x16 O0, O1;
#pragma unroll
        for (int i = 0; i < 16; ++i) { O0[i] = 0.f; O1[i] = 0.f; }
        float mrun = sinks[head] * LOG2E, lsum = (hh == 0) ? 1.0f : 0.0f;
#pragma unroll
        for (int j = 0; j < 5; ++j) {
            const int rb = qsub + j;
            const int key0 = kbase + 32 * rb;
            if (key0 >= 0) {
                f32x16 z;
#pragma unroll
                for (int i = 0; i < 16; ++i) z[i] = 0.f;
#pragma unroll
                for (int s = 0; s < 4; ++s) { const bf16x8 a = *(const LAS bf16x8*)(kb_ + (32 * rb + r) * KSTR + 32 * s + 16 * hh); z = MFMA32(a, qf[s], z); }
                float bm = -3.0e38f;
#pragma unroll
                for (int i = 0; i < 16; ++i) {
                    bool valid = true;
                    if (j == 0) valid = (crow(i, hh) > r);
                    if (j == 4) valid = (crow(i, hh) <= r);
                    if (!valid) z[i] = -3.0e38f;
                    bm = fmaxf(bm, z[i]);
                }
                bm = fmaxf(bm, sx(bm, 32, lane));
                if (__any(bm > mrun + 8.0f)) {
                    const float mnew = fmaxf(mrun, bm);
                    const float alpha = __builtin_amdgcn_exp2f(mrun - mnew);
                    mrun = mnew; lsum *= alpha;
#pragma unroll
                    for (int i = 0; i < 16; ++i) { O0[i] *= alpha; O1[i] *= alpha; }
                }
                float w[16]; float ps = 0.f;
#pragma unroll
                for (int i = 0; i < 16; ++i) { w[i] = __builtin_amdgcn_exp2f(z[i] - mrun); ps += w[i]; }
                lsum += ps;
#pragma unroll
                for (int s = 0; s < 2; ++s) {
                    const bf16x8 pf = pack8(w[8 * s], w[8 * s + 1], w[8 * s + 2], w[8 * s + 3], w[8 * s + 4], w[8 * s + 5], w[8 * s + 6], w[8 * s + 7]);
                    const LAS unsigned char* vp = vb_ + (32 * rb + 16 * s) * VSTR + vlane_off;
                    const bf16x8 a0 = tr8(vp, 8 * VSTR), a1 = tr8(vp + 64, 8 * VSTR);
                    O0 = MFMA32(a0, pf, O0); O1 = MFMA32(a1, pf, O1);
                }
            }
        }
        lsum += sx(lsum, 32, lane);
        const float inv = 1.0f / lsum;
        bf16_t* yp = Y + ((size_t)b * SEQ + qw0 + r) * 1024 + head * 64;
        store_ot32(yp, O0, inv, hh); store_ot32(yp + 32, O1, inv, hh);
        if (!has_next) break;
        u = un; cur ^= 1;
    }
#undef SWA_LOAD
}

constexpr int XCS = 68;
constexpr int LR_RAWSTR = 144, LR_GR = 37376, LR_XCW = 53760, LR_EXCH = 123392, LR_CW = 125440  , LR_WF = 126720  ;
struct LruArgs { const bf16_t* XR; const bf16_t* GR; bf16_t* Y; const float* convw; const float* convb; const float* wa; const float* ba; const float* wx; const float* bx; const float* lam; };
__device__ __forceinline__ void lru_item(LAS unsigned char* lds, const LruArgs& A, int item, int tid, int wid, int lane) {
    const int b = item >> 4, n = (item >> 1) & 7, half = item & 1;
    const int r = lane & 31, hh = lane >> 5;
    const int co = lane & 7, tsub = lane >> 3;
    const size_t rowbase = (size_t)b * SEQ;
    LAS float* xcw = (LAS float*)(lds + LR_XCW + wid * (32 * XCS * 4));
    LAS float* exch = (LAS float*)(lds + LR_EXCH);
    __syncthreads();
    {
        LAS float* cwl = (LAS float*)(lds + LR_CW);
#pragma unroll
        for (int k = 0; k < 4; ++k)
#pragma unroll
            for (int j = 0; j < 8; ++j) cwl[k * 64 + 8 * co + j] = A.convw[k * 512 + 64 * n + 8 * co + j];
#pragma unroll
        for (int j = 0; j < 8; ++j) cwl[256 + 8 * co + j] = A.convb[64 * n + 8 * co + j];
#pragma unroll
        for (int s = 0; s < 4; ++s) {
            float ta[8], tx[8];
#pragma unroll
            for (int j = 0; j < 8; ++j) { const int idx = (n * 64 + 16 * s + 8 * hh + j) * 64 + 32 * half + r; ta[j] = A.wa[idx]; tx[j] = A.wx[idx]; }
            *(LAS bf16x8*)(lds + LR_WF + (2 * s) * 1024 + lane * 16) = pack8(ta[0], ta[1], ta[2], ta[3], ta[4], ta[5], ta[6], ta[7]);
            *(LAS bf16x8*)(lds + LR_WF + (2 * s + 1) * 1024 + lane * 16) = pack8(tx[0], tx[1], tx[2], tx[3], tx[4], tx[5], tx[6], tx[7]);
        }
    }
    const int c = 64 * n + 32 * half + r;
    const float ba_c = A.ba[c], bx_c = A.bx[c];
    const float lam_c = A.lam[c];
    const float spl2 = 8.0f * (fmaxf(-lam_c, 0.f) + log1pf(expf(-fabsf(lam_c)))) * LOG2E;
    u32x4 praw[5], pgr[2];
    const bf16_t* xrb = A.XR + rowbase * 512 + 64 * n;
    const bf16_t* grb = A.GR + rowbase * 512 + 64 * n + 32 * half;
#define LRU_LOAD(cc) do { \
        _Pragma("unroll") for (int i_ = 0; i_ < 5; ++i_) { const int idx = tid + 512 * i_, j = idx >> 3, pc = idx & 7, pos = 256 * (cc) - 3 + j; \
            praw[i_] = (u32x4){0u, 0u, 0u, 0u}; if (idx < 2072 && pos >= 0) praw[i_] = *(const u32x4*)(xrb + (size_t)pos * 512 + 8 * pc); } \
        _Pragma("unroll") for (int i_ = 0; i_ < 2; ++i_) { const int idx = tid + 512 * i_, j = idx >> 2, pc = idx & 3; \
            pgr[i_] = *(const u32x4*)(grb + (size_t)(256 * (cc) + j) * 512 + 8 * pc); } } while (0)
    LRU_LOAD(0);
    float carry = 0.f;
    for (int cch = 0; cch < 8; ++cch) {
        __syncthreads();
#pragma unroll
        for (int i_ = 0; i_ < 5; ++i_) { const int idx = tid + 512 * i_; if (idx < 2072) *(LAS u32x4*)(lds + (idx >> 3) * LR_RAWSTR + (idx & 7) * 16) = praw[i_]; }
#pragma unroll
        for (int i_ = 0; i_ < 2; ++i_) { const int idx = tid + 512 * i_; *(LAS u32x4*)(lds + LR_GR + (idx >> 2) * 64 + (idx & 3) * 16) = pgr[i_]; }
        if (cch < 7) LRU_LOAD(cch + 1);
        __syncthreads();
        float cw[4][8], cbv[8];
        {
            const LAS float* cwl = (const LAS float*)(lds + LR_CW);
#pragma unroll
            for (int k = 0; k < 4; ++k) { const f32x4 t0 = *(const LAS f32x4*)(cwl + k * 64 + 8 * co), t1 = *(const LAS f32x4*)(cwl + k * 64 + 8 * co + 4);
                cw[k][0] = t0[0]; cw[k][1] = t0[1]; cw[k][2] = t0[2]; cw[k][3] = t0[3]; cw[k][4] = t1[0]; cw[k][5] = t1[1]; cw[k][6] = t1[2]; cw[k][7] = t1[3]; }
            const f32x4 t0 = *(const LAS f32x4*)(cwl + 256 + 8 * co), t1 = *(const LAS f32x4*)(cwl + 256 + 8 * co + 4);
            cbv[0] = t0[0]; cbv[1] = t0[1]; cbv[2] = t0[2]; cbv[3] = t0[3]; cbv[4] = t1[0]; cbv[5] = t1[1]; cbv[6] = t1[2]; cbv[7] = t1[3];
        }
#pragma unroll
        for (int p = 0; p < 4; ++p) {
            const int tl = 8 * p + tsub;
            float av[8];
#pragma unroll
            for (int j = 0; j < 8; ++j) av[j] = cbv[j];
#pragma unroll
            for (int k = 0; k < 4; ++k) {
                const u32x4 raw = *(const LAS u32x4*)(lds + (32 * wid + tl + k) * LR_RAWSTR + co * 16);
                av[0] += cw[k][0] * bflo(raw.x); av[1] += cw[k][1] * bfhi(raw.x); av[2] += cw[k][2] * bflo(raw.y); av[3] += cw[k][3] * bfhi(raw.y);
                av[4] += cw[k][4] * bflo(raw.z); av[5] += cw[k][5] * bfhi(raw.z); av[6] += cw[k][6] * bflo(raw.w); av[7] += cw[k][7] * bfhi(raw.w);
            }
            *(LAS f32x4*)(xcw + tl * XCS + 8 * co) = (f32x4){av[0], av[1], av[2], av[3]};
            *(LAS f32x4*)(xcw + tl * XCS + 8 * co + 4) = (f32x4){av[4], av[5], av[6], av[7]};
        }
        LDS_WAIT();
        f32x16 R, I;
#pragma unroll
        for (int i = 0; i < 16; ++i) { R[i] = 0.f; I[i] = 0.f; }
#pragma unroll
        for (int s = 0; s < 4; ++s) {
            const f32x4 a0 = *(const LAS f32x4*)(xcw + r * XCS + 16 * s + 8 * hh), a1 = *(const LAS f32x4*)(xcw + r * XCS + 16 * s + 8 * hh + 4);
            const bf16x8 af = pack8(a0[0], a0[1], a0[2], a0[3], a1[0], a1[1], a1[2], a1[3]);
            const bf16x8 wa_f = *(const LAS bf16x8*)(lds + LR_WF + (2 * s) * 1024 + lane * 16), wx_f = *(const LAS bf16x8*)(lds + LR_WF + (2 * s + 1) * 1024 + lane * 16);
            R = MFMA32(af, wa_f, R); I = MFMA32(af, wx_f, I);
        }
        float av_[16], uv_[16];
#pragma unroll
        for (int i = 0; i < 16; ++i) {
            const float xcf = xcw[crow(i, hh) * XCS + 32 * half + r];
            const float rr = __builtin_amdgcn_rcpf(1.0f + __builtin_amdgcn_exp2f(-(R[i] + ba_c) * LOG2E));
            const float ii = __builtin_amdgcn_rcpf(1.0f + __builtin_amdgcn_exp2f(-(I[i] + bx_c) * LOG2E));
            const float la2 = -rr * spl2;
            const float a = __builtin_amdgcn_exp2f(la2);
            const float y = la2 * (2.0f / LOG2E);
            const float om = (y > -0.25f) ? -y * (1.0f + y * (0.5f + y * ((1.0f / 6.0f) + y * ((1.0f / 24.0f) + y * (1.0f / 120.0f))))) : 1.0f - a * a;
            av_[i] = a; uv_[i] = sqrtf(om) * ii * xcf;
        }
        asm volatile("" ::: "memory");
        float Ag[4], Bg[4], pA[4], pB[4];
#pragma unroll
        for (int g = 0; g < 4; ++g) {
            Ag[g] = (av_[4 * g] * av_[4 * g + 1]) * (av_[4 * g + 2] * av_[4 * g + 3]);
            Bg[g] = ((uv_[4 * g] * av_[4 * g + 1] + uv_[4 * g + 1]) * av_[4 * g + 2] + uv_[4 * g + 2]) * av_[4 * g + 3] + uv_[4 * g + 3];
            pA[g] = sx(Ag[g], 32, lane); pB[g] = sx(Bg[g], 32, lane);
        }
        float hcur = 0.f, acur = 1.0f;
#pragma unroll
        for (int g = 0; g < 4; ++g) {
            const float A0 = hh == 0 ? Ag[g] : pA[g], B0 = hh == 0 ? Bg[g] : pB[g];
            const float A1 = hh == 0 ? pA[g] : Ag[g], B1 = hh == 0 ? pB[g] : Bg[g];
            const float s0 = hcur, c0 = acur; hcur = A0 * hcur + B0; acur *= A0;
            const float s1 = hcur, c1 = acur; hcur = A1 * hcur + B1; acur *= A1;
            float hv = hh == 0 ? s0 : s1, ac = hh == 0 ? c0 : c1;
#pragma unroll
            for (int i = 4 * g; i < 4 * g + 4; ++i) { hv = av_[i] * hv + uv_[i]; ac *= av_[i]; uv_[i] = hv; av_[i] = ac; }
        }
        if (hh == 0) { exch[(wid * 32 + r) * 2] = acur; exch[(wid * 32 + r) * 2 + 1] = hcur; }
        __syncthreads();
        float hin = carry, run = carry;
#pragma unroll
        for (int w8 = 0; w8 < 8; ++w8) { if (w8 == wid) hin = run; run = exch[(w8 * 32 + r) * 2] * run + exch[(w8 * 32 + r) * 2 + 1]; }
        carry = run;
        LAS unsigned char* ot = (LAS unsigned char*)xcw;
#pragma unroll
        for (int i = 0; i < 16; ++i) {
            const int tl = crow(i, hh);
            const float hv = uv_[i] + av_[i] * hin;
            const float gv = bflo((unsigned)*(const LAS unsigned short*)(lds + LR_GR + (32 * wid + tl) * 64 + r * 2));
            const float yy = 0.7978845608028654f * (gv + 0.044715f * gv * gv * gv);
            const float ge = gv * __builtin_amdgcn_rcpf(1.0f + __builtin_amdgcn_exp2f(-2.0f * LOG2E * yy));
            *(LAS unsigned short*)(ot + tl * 64 + r * 2) = (unsigned short)(pk2(hv * ge, 0.f) & 0xffffu);
        }
        LDS_WAIT();
#pragma unroll
        for (int k2 = 0; k2 < 2; ++k2) {
            const int idx = lane + 64 * k2, row = idx >> 2, pc = idx & 3;
            const u32x4 w = *(const LAS u32x4*)(ot + row * 64 + pc * 16);
            *(u32x4*)(A.Y + (rowbase + 256 * cch + 32 * wid + row) * 1024 + 64 * n + 32 * half + 8 * pc) = w;
        }
        asm volatile("" ::: "memory");
    }
#undef LRU_LOAD
}

__device__ __forceinline__ float wave_sum(float v, int lane) {
#pragma unroll
    for (int o = 1; o < 64; o <<= 1) v += sx(v, o, lane);
    return v;
}
__device__ __forceinline__ int headperm(int n) { return (n & ~255) | (((n >> 5) & 1) << 7) | (((n >> 6) & 3) << 5) | (n & 31); }
struct TrItem { const float* W; bf16_t* WT; int N, K, k0, n0, d0, perm; };
__device__ __forceinline__ void tr_load(const TrItem& t, int lane, float (&tv)[32]) {
#pragma unroll
    for (int i = 0; i < 32; ++i) { const int kk = 2 * i + (lane >> 5); tv[i] = t.W[(size_t)(t.k0 + kk) * t.N + t.n0 + (lane & 31)]; }
}
__device__ __forceinline__ void tr_store(const TrItem& t, int lane, const float (&tv)[32], LAS float* scr) {
#pragma unroll
    for (int i = 0; i < 32; ++i) { const int kk = 2 * i + (lane >> 5); scr[kk * 33 + (lane & 31)] = tv[i]; }
    LDS_WAIT();
    const int c8 = lane & 7;
#pragma unroll
    for (int j = 0; j < 4; ++j) { const int nl = (lane >> 3) + 8 * j; const LAS float* sp = scr + (8 * c8) * 33 + nl; const int n = t.perm ? (16 * ((nl >> 2) & 1) + 4 * (nl >> 3) + (nl & 3)) : nl;
        u32x4 o; o.x = pk2(sp[0 * 33], sp[1 * 33]); o.y = pk2(sp[2 * 33], sp[3 * 33]); o.z = pk2(sp[4 * 33], sp[5 * 33]); o.w = pk2(sp[6 * 33], sp[7 * 33]);
        *(u32x4*)(t.WT + (size_t)(t.d0 + n) * t.K + t.k0 + 8 * c8) = o; }
    LDS_WAIT();
}

#define XB_TMO      128
#define XB_XCNT(j)  (256  + 64 * (j))
#define XB_XSUB(j)  (1280 + 64 * (j))
#define XB_XGEN(j)  (2304 + 64 * (j))
#define XB_TOP      3328
#define XB_TOPGEN   3392
#define XCD_BAR_WORDS 3456
#define XB_SPIN_CAP (1u << 20)
__device__ __forceinline__ unsigned xb_ld(unsigned* p)              { return __hip_atomic_load(p, __ATOMIC_RELAXED, __HIP_MEMORY_SCOPE_AGENT); }
__device__ __forceinline__ unsigned xb_add(unsigned* p, unsigned v) { return __hip_atomic_fetch_add(p, v, __ATOMIC_RELAXED, __HIP_MEMORY_SCOPE_AGENT); }
__device__ __forceinline__ unsigned xb_xcc_id() { return (unsigned)__builtin_amdgcn_s_getreg((3 << 11) | 20) & 0xFu; }
#define XB_SPIN(cond, bar) do { unsigned _sp = 0; while (cond) { __builtin_amdgcn_s_sleep(1); \
    if ((++_sp & 255u) == 0u) { if (xb_ld(&(bar)[XB_TMO])) break; if (_sp > XB_SPIN_CAP) { atomicAdd(&(bar)[XB_TMO], 1u); break; } } } } while (0)
struct XcdBarrier { unsigned* bar; unsigned x; volatile LAS unsigned* st; };
__device__ __forceinline__ void xcd_barrier_complete(unsigned* bar, unsigned x, unsigned& nloc, unsigned& nx) {
    const unsigned G = gridDim.x * gridDim.y * gridDim.z;
    unsigned sum, cnt, mine, sp = 0u;
    for (;;) {
        sum = 0u; cnt = 0u; mine = 0u;
#pragma unroll
        for (unsigned j = 0; j < 16; ++j) { const unsigned c = xb_ld(&bar[XB_XCNT(j)]); sum += c; cnt += (c > 0u) ? 1u : 0u; mine = (j == x) ? c : mine; }
        if (sum == G) break;
        __builtin_amdgcn_s_sleep(1);
        if ((++sp & 255u) == 0u) { if (xb_ld(&bar[XB_TMO])) break; if (sp > XB_SPIN_CAP) { atomicAdd(&bar[XB_TMO], 1u); break; } }
    }
    nloc = mine > 0u ? mine : 1u; nx = cnt > 0u ? cnt : 1u;
}
__device__ __forceinline__ void xcd_barrier(const XcdBarrier& b, const bool leader) {
    asm volatile("s_waitcnt vmcnt(0)" ::: "memory");
    __syncthreads();
    if (leader) {
        unsigned* bar = b.bar;
        __builtin_amdgcn_s_waitcnt(0);
        unsigned nloc = b.st[0], nx = b.st[1];
        if (nloc == 0u) { xcd_barrier_complete(bar, b.x, nloc, nx); b.st[0] = nloc; b.st[1] = nx; }
        const unsigned old = xb_add(&bar[XB_XSUB(b.x)], 1u);
        const unsigned gen = old / nloc;
        if (old + 1u == (gen + 1u) * nloc) {
            __builtin_amdgcn_fence(__ATOMIC_RELEASE, "agent");
            asm volatile("s_waitcnt vmcnt(0)" ::: "memory");
            const unsigned og = xb_add(&bar[XB_TOP], 1u);
            const unsigned tg = og / nx;
            if (og + 1u == (tg + 1u) * nx) xb_add(&bar[XB_TOPGEN], 1u);
            else XB_SPIN(xb_ld(&bar[XB_TOPGEN]) == tg, bar);
            __builtin_amdgcn_fence(__ATOMIC_ACQUIRE, "agent");
            xb_add(&bar[XB_XGEN(b.x)], 1u);
            asm volatile("s_waitcnt vmcnt(0)" ::: "memory");
        } else {
            XB_SPIN(xb_ld(&bar[XB_XGEN(b.x)]) == gen, bar);
            __builtin_amdgcn_fence(__ATOMIC_ACQUIRE, "agent");
            asm volatile("s_waitcnt vmcnt(0)" ::: "memory");
        }
    }
    __syncthreads();
}

struct Args { const float* in[27]; float* out; unsigned char* ws; };

__global__ void __launch_bounds__(512, 2) fwd_mega(Args args) {
    extern __shared__ __attribute__((aligned(16))) unsigned char lds_raw[];
    LAS unsigned char* lds = (LAS unsigned char*)lds_raw;
    cg::grid_group grid = cg::this_grid();
#ifndef STAGGER_TICKS
#define STAGGER_TICKS 0
#endif
#define STAGGER() do { if (STAGGER_TICKS > 0 && ((bid >> 3) & 1)) { const unsigned long long t0_ = __builtin_amdgcn_s_memrealtime(); while (__builtin_amdgcn_s_memrealtime() - t0_ < (unsigned long long)STAGGER_TICKS) __builtin_amdgcn_s_sleep(16); } } while (0)
#define GSYNC_CG() do { if (args.ws == nullptr) grid.sync(); GSYNC(); } while (0)
#define GSYNC() do { int l_; asm volatile("v_mbcnt_lo_u32_b32 %0, -1, 0\n\tv_mbcnt_hi_u32_b32 %0, -1, %0" : "=v"(l_)); xcd_barrier(xbar, wid_s == 0 && l_ == 0); if (DUP_MASK & 4) xcd_barrier(xbar, wid_s == 0 && l_ == 0); } while (0)
    const int G = gridDim.x, bid = blockIdx.x, NGW = G * 8;
    const int wid_s = __builtin_amdgcn_readfirstlane((int)threadIdx.x >> 6);
    XcdBarrier xbar;
    {
        volatile LAS unsigned* st = (volatile LAS unsigned*)(lds + 139264);
        if (threadIdx.x < 4) st[threadIdx.x] = 0u;
        __syncthreads();
        xbar.bar = (unsigned*)(args.ws + WS_BAR); xbar.x = xb_xcc_id(); xbar.st = st;
        if (threadIdx.x == 0) (void)xb_add(&xbar.bar[XB_XCNT(xbar.x)], 1u);
    }
#define PHASE_IDS int lane_; asm volatile("v_mbcnt_lo_u32_b32 %0, -1, 0\n\tv_mbcnt_hi_u32_b32 %0, -1, %0" : "=v"(lane_)); const int lane = lane_ & 63; const int wid = wid_s; const int tid = wid * 64 + lane; const int gw = bid * 8 + wid; (void)gw;
    unsigned char* ws = args.ws;
    const float* x = args.in[0]; const float* cc = args.in[1]; const float* ada_w = args.in[2]; const float* ada_b = args.in[3];
    const float* norm_mix_g = args.in[4]; const float* norm_ffn_g = args.in[5];
    float* MOD = (float*)(ws + WS_MOD); float* SHW = (float*)(ws + WS_SHW);
    float* SSQ0 = (float*)(ws + WS_SSQ0); float* SSQ1 = (float*)(ws + WS_SSQ1); float* SSQ2 = (float*)(ws + WS_SSQ2); float* SSQ3 = (float*)(ws + WS_SSQ3);
    bf16_t* XG = (bf16_t*)(ws + WS_XG); bf16_t* PB = (bf16_t*)(ws + WS_P); bf16_t* YB = (bf16_t*)(ws + WS_Y); bf16_t* ACT = (bf16_t*)(ws + WS_ACT); bf16_t* XS = (bf16_t*)(ws + WS_XS);
    float* HALO = (float*)(ws + WS_HALO); float* FIXP = (float*)(ws + WS_FIXP); float* FIXU = (float*)(ws + WS_FIXU);
    bf16_t* W_IN0 = (bf16_t*)(ws + WS_W_IN0); bf16_t* W_OUT0 = (bf16_t*)(ws + WS_W_OUT0); bf16_t* W_GU0 = (bf16_t*)(ws + WS_W_GU0); bf16_t* W_DN0 = (bf16_t*)(ws + WS_W_DN0);
    bf16_t* W_IN1 = (bf16_t*)(ws + WS_W_IN1); bf16_t* W_OUT1 = (bf16_t*)(ws + WS_W_OUT1); bf16_t* W_GU1 = (bf16_t*)(ws + WS_W_GU1); bf16_t* W_DN1 = (bf16_t*)(ws + WS_W_DN1);

    for (int prep = 0; prep < ((DUP_MASK & 8) ? 2 : 1); ++prep) {
    for (int item = bid; item < 256; item += G) {
        PHASE_IDS
        const int l = item >> 7, chunk = item & 127;
        LAS float* sl = (LAS float*)lds;
        LAS float* part = (LAS float*)(lds + 65536);
        __syncthreads();
        for (int idx = tid; idx < 16384; idx += 512) { const float v = cc[idx]; sl[idx] = v / (1.0f + __expf(-v)); }
        __syncthreads();
        float acc[16];
#pragma unroll
        for (int bb = 0; bb < 16; ++bb) acc[bb] = 0.f;
        const int colc = chunk * 48 + (lane < 48 ? lane : 47);
        const float* Wp = ada_w + (size_t)l * 1024 * 6144 + colc;
        float wv[16], wn[16];
#pragma unroll
        for (int j = 0; j < 16; ++j) { wv[j] = Wp[(size_t)(128 * wid + j) * 6144]; wn[j] = 0.f; }
        for (int k = 128 * wid; k < 128 * wid + 128; k += 16) {
            if (k + 16 < 128 * wid + 128) {
#pragma unroll
                for (int j = 0; j < 16; ++j) wn[j] = Wp[(size_t)(k + 16 + j) * 6144];
            }
#pragma unroll
            for (int j4 = 0; j4 < 4; ++j4)
#pragma unroll
                for (int bb = 0; bb < 16; ++bb) { const f32x4 s4 = *(const LAS f32x4*)(sl + bb * 1024 + k + 4 * j4); acc[bb] += (s4[0] * wv[4 * j4] + s4[1] * wv[4 * j4 + 1]) + (s4[2] * wv[4 * j4 + 2] + s4[3] * wv[4 * j4 + 3]); }
#pragma unroll
            for (int j = 0; j < 16; ++j) wv[j] = wn[j];
        }
#pragma unroll
        for (int bb = 0; bb < 16; ++bb) part[(wid * 16 + bb) * 64 + lane] = acc[bb];
        __syncthreads();
        for (int o = tid; o < 1024; o += 512) {
            const int bb = o >> 6, cl = o & 63;
            if (cl < 48) {
                float sacc = ada_b[l * 6144 + chunk * 48 + cl];
#pragma unroll
                for (int w8 = 0; w8 < 8; ++w8) sacc += part[(w8 * 16 + bb) * 64 + cl];
                MOD[((size_t)l * 16 + bb) * 6144 + chunk * 48 + cl] = sacc;
            }
        }
        __syncthreads();
    }
    {
        PHASE_IDS
        LAS float* scr = (LAS float*)(lds + wid * 16384);
        constexpr int NITEMS = 1280 + 512 + 3 * 1408 + 768 + 512 + 3 * 1408;
#define TR_DECODE(T_, it_) do { int rI = (it_); int mapk; \
            if (rI < 1280) { T_.W = args.in[6]; T_.N = 2560; T_.K = 1024; T_.WT = W_IN0; mapk = 1; } \
            else if ((rI -= 1280) < 512) { T_.W = args.in[16]; T_.N = 1024; T_.K = 1024; T_.WT = W_OUT0; mapk = 0; } \
            else if ((rI -= 512) < 1408) { T_.W = args.in[22]; T_.N = FF; T_.K = 1024; T_.WT = W_GU0; mapk = 3; } \
            else if ((rI -= 1408) < 1408) { T_.W = args.in[23]; T_.N = FF; T_.K = 1024; T_.WT = W_GU0; mapk = 4; } \
            else if ((rI -= 1408) < 1408) { T_.W = args.in[26]; T_.N = 1024; T_.K = FF; T_.WT = W_DN0; mapk = 0; } \
            else if ((rI -= 1408) < 768) { T_.W = args.in[17]; T_.N = 1536; T_.K = 1024; T_.WT = W_IN1; mapk = 2; } \
            else if ((rI -= 768) < 512) { T_.W = args.in[21]; T_.N = 1024; T_.K = 1024; T_.WT = W_OUT1; mapk = 0; } \
            else if ((rI -= 512) < 1408) { T_.W = args.in[22] + (size_t)1024 * FF; T_.N = FF; T_.K = 1024; T_.WT = W_GU1; mapk = 3; } \
            else if ((rI -= 1408) < 1408) { T_.W = args.in[23] + (size_t)1024 * FF; T_.N = FF; T_.K = 1024; T_.WT = W_GU1; mapk = 4; } \
            else { rI -= 1408; T_.W = args.in[26] + (size_t)FF * 1024; T_.N = 1024; T_.K = FF; T_.WT = W_DN1; mapk = 0; } \
            const int nblk = T_.N / 32, kb_ = rI / nblk, nb_ = rI % nblk; T_.k0 = 64 * kb_; T_.n0 = 32 * nb_; \
            int d0 = T_.n0; \
            if (mapk == 1) { const int region = T_.n0 >> 9; if (region == 2 || region == 3) d0 = headperm(T_.n0); } \
            else if (mapk == 2) { if (T_.n0 < 1280) d0 = headperm(T_.n0); } \
            else if (mapk == 3) d0 = 256 * (T_.n0 >> 7) + (T_.n0 & 127); \
            else if (mapk == 4) d0 = 256 * (T_.n0 >> 7) + 128 + (T_.n0 & 127); \
            T_.d0 = d0; T_.perm = 1; } while (0)
        for (int it = gw; it < NITEMS; it += 2 * NGW) {
            const bool two = (it + NGW) < NITEMS;
            TrItem ta, tb; TR_DECODE(ta, it); TR_DECODE(tb, two ? it + NGW : it);
            float va[32], vb[32];
            tr_load(ta, lane, va);
            if (two) tr_load(tb, lane, vb);
            tr_store(ta, lane, va, scr);
            if (two) tr_store(tb, lane, vb, scr);
        }
#undef TR_DECODE
    }
    GSYNC_CG();

    {
    PHASE_IDS
    for (int i0 = 0; i0 < 32; i0 += 8) {
        f32x4 v4[8];
#pragma unroll
        for (int i = 0; i < 8; ++i) {
            const int e = (tid + 512 * (i0 + i)) * 4, gi = e >> 14, bb = (e >> 10) & 15, k = e & 1023;
            v4[i] = *(const f32x4*)(MOD + ((size_t)((gi >> 1) * 16 + bb)) * 6144 + ((gi & 1) ? 3 * 1024 : 0) + k);
        }
#pragma unroll
        for (int i = 0; i < 8; ++i) {
            const int e = (tid + 512 * (i0 + i)) * 4;
            u32x2 w; w.x = pk2(v4[i][0], v4[i][1]); w.y = pk2(v4[i][2], v4[i][3]);
            *(LAS u32x2*)(lds + (size_t)e * 2) = w;
        }
    }
    {
        const int mbase = gw * (M / NGW);
        const int bb = mbase >> 11;
        f32x4 gm[4];
#pragma unroll
        for (int j = 0; j < 4; ++j) { const int c4 = 2 * lane + (j & 1) + 128 * (j >> 1);
            gm[j] = *((const f32x4*)norm_mix_g + c4) * (*((const f32x4*)(MOD + (size_t)bb * 6144 + 1024) + c4) + 1.0f); }
        const int nrow = M / NGW;
        for (int i0 = 0; i0 + 4 <= nrow; i0 += 4) {
            f32x4 v[4][4];
#pragma unroll
            for (int rr = 0; rr < 4; ++rr)
#pragma unroll
                for (int j = 0; j < 4; ++j) v[rr][j] = *((const f32x4*)(x + (size_t)(mbase + i0 + rr) * 1024) + 2 * lane + (j & 1) + 128 * (j >> 1));
            float sacc[4];
#pragma unroll
            for (int rr = 0; rr < 4; ++rr) {
                u32x4* op = (u32x4*)(XG + (size_t)(mbase + i0 + rr) * 1024) + lane;
                sacc[rr] = 0.f;
#pragma unroll
                for (int jj = 0; jj < 2; ++jj) {
                    const f32x4 q0 = v[rr][2 * jj] * v[rr][2 * jj], q1 = v[rr][2 * jj + 1] * v[rr][2 * jj + 1];
                    sacc[rr] += ((q0[0] + q0[1]) + (q0[2] + q0[3])) + ((q1[0] + q1[1]) + (q1[2] + q1[3]));
                    const f32x4 o0 = v[rr][2 * jj] * gm[2 * jj], o1 = v[rr][2 * jj + 1] * gm[2 * jj + 1];
                    u32x4 w; w.x = pk2(o0[0], o0[1]); w.y = pk2(o0[2], o0[3]); w.z = pk2(o1[0], o1[1]); w.w = pk2(o1[2], o1[3]); op[64 * jj] = w;
                }
            }
#pragma unroll
            for (int o = 1; o < 64; o <<= 1) {
#pragma unroll
                for (int rr = 0; rr < 4; ++rr) sacc[rr] += sx(sacc[rr], o, lane);
            }
            if (lane < 4) SSQ0[mbase + i0 + lane] = lane == 0 ? sacc[0] : (lane == 1 ? sacc[1] : (lane == 2 ? sacc[2] : sacc[3]));
        }
    }
    __syncthreads();
    {
        constexpr int NROWS = 2560 + 5632 + 1536 + 5632;
        for (int p0 = gw; p0 < NROWS; p0 += 2 * NGW) {
            asm volatile("" ::: "memory");
            u32x4 r0[2], r1[2]; int gi_[2], pl_[2], N_[2]; float* out_[2];
#pragma unroll
            for (int rr = 0; rr < 2; ++rr) {
                int p = p0 + rr * NGW; if (p >= NROWS) p = p0;
                const bf16_t* Wt; int gi, pl, N; float* outp;
                if (p < 2560) { gi = 0; pl = p; N = 2560; Wt = W_IN0; outp = SHW + SHW_IN0; }
                else if (p < 8192) { gi = 1; pl = p - 2560; N = 5632; Wt = W_GU0; outp = SHW + SHW_GU0; }
                else if (p < 9728) { gi = 2; pl = p - 8192; N = 1536; Wt = W_IN1; outp = SHW + SHW_IN1; }
                else { gi = 3; pl = p - 9728; N = 5632; Wt = W_GU1; outp = SHW + SHW_GU1; }
                r0[rr] = *(const u32x4*)(Wt + (size_t)pl * 1024 + 8 * lane); r1[rr] = *(const u32x4*)(Wt + (size_t)pl * 1024 + 512 + 8 * lane);
                gi_[rr] = gi; pl_[rr] = pl; N_[rr] = N; out_[rr] = outp;
            }
#pragma unroll
            for (int rr = 0; rr < 2; ++rr) {
                if (rr == 1 && p0 + NGW >= NROWS) break;
                float wv[16];
                wv[0] = bflo(r0[rr].x); wv[1] = bfhi(r0[rr].x); wv[2] = bflo(r0[rr].y); wv[3] = bfhi(r0[rr].y); wv[4] = bflo(r0[rr].z); wv[5] = bfhi(r0[rr].z); wv[6] = bflo(r0[rr].w); wv[7] = bfhi(r0[rr].w);
                wv[8] = bflo(r1[rr].x); wv[9] = bfhi(r1[rr].x); wv[10] = bflo(r1[rr].y); wv[11] = bfhi(r1[rr].y); wv[12] = bflo(r1[rr].z); wv[13] = bfhi(r1[rr].z); wv[14] = bflo(r1[rr].w); wv[15] = bfhi(r1[rr].w);
                float d[16];
                const LAS unsigned char* sbase = lds + (size_t)gi_[rr] * 32768 + 16 * lane;
#pragma unroll
                for (int bb = 0; bb < 16; ++bb) {
                    const u32x4 s0 = *(const LAS u32x4*)(sbase + bb * 2048), s1 = *(const LAS u32x4*)(sbase + bb * 2048 + 1024);
                    d[bb] = (wv[0] * bflo(s0.x) + wv[1] * bfhi(s0.x)) + (wv[2] * bflo(s0.y) + wv[3] * bfhi(s0.y)) + (wv[4] * bflo(s0.z) + wv[5] * bfhi(s0.z)) + (wv[6] * bflo(s0.w) + wv[7] * bfhi(s0.w))
                          + (wv[8] * bflo(s1.x) + wv[9] * bfhi(s1.x)) + (wv[10] * bflo(s1.y) + wv[11] * bfhi(s1.y)) + (wv[12] * bflo(s1.z) + wv[13] * bfhi(s1.z)) + (wv[14] * bflo(s1.w) + wv[15] * bfhi(s1.w));
                }
                const bool h5 = (lane & 32) != 0, h4 = (lane & 16) != 0, h3 = (lane & 8) != 0, h2 = (lane & 4) != 0;
                float e8[8], e4[4], e2[2];
#pragma unroll
                for (int j = 0; j < 8; ++j) { const float snd = h5 ? d[j] : d[j + 8], kp = h5 ? d[j + 8] : d[j]; e8[j] = kp + sx(snd, 32, lane); }
#pragma unroll
                for (int j = 0; j < 4; ++j) { const float snd = h4 ? e8[j] : e8[j + 4], kp = h4 ? e8[j + 4] : e8[j]; e4[j] = kp + sx(snd, 16, lane); }
#pragma unroll
                for (int j = 0; j < 2; ++j) { const float snd = h3 ? e4[j] : e4[j + 2], kp = h3 ? e4[j + 2] : e4[j]; e2[j] = kp + sx(snd, 8, lane); }
                float tot; { const float snd = h2 ? e2[0] : e2[1], kp = h2 ? e2[1] : e2[0]; tot = kp + sx(snd, 4, lane); }
                tot += sx(tot, 2, lane); tot += sx(tot, 1, lane);
                const int bsel = (h5 ? 8 : 0) + (h4 ? 4 : 0) + (h3 ? 2 : 0) + (h2 ? 1 : 0);
                if ((lane & 3) == 0) out_[rr][(size_t)bsel * N_[rr] + pl_[rr]] = tot;
            }
        }
    }
    }
    GSYNC();

    }
    pg8::StaticOrder S;
    {
        PHASE_IDS
        pg8::Gemm g{XG, W_IN0, M, 2560, 1024}; S.init(M, 2560, G, bid);
        EpiIn<0> E{SSQ0, SHW + SHW_IN0, 2560, PB, args.in[14], args.in[15]};
        pg8::gemm_phase<EpiIn<0>>(lds, g, S, E, tid);
    }
#if (DUP_MASK & 32)
    {
        PHASE_IDS
        pg8::Gemm g{XG, W_IN0, M, 2560, 1024}; S.init(M, 2560, G, bid);
        EpiIn<0> E{SSQ0, SHW + SHW_IN0, 2560, PB, args.in[14], args.in[15]};
        pg8::gemm_phase<EpiIn<0>>(lds, g, S, E, tid);
    }
#endif
    GSYNC();

    {
        const bf16_t* XR = PB; const bf16_t* GR = PB + (size_t)M * 512; const bf16_t* Qb = PB + (size_t)2 * M * 512; const bf16_t* Kb = PB + (size_t)3 * M * 512; const bf16_t* Vb = PB + (size_t)4 * M * 512;
        PHASE_IDS
        LruArgs LA{XR, GR, YB, args.in[7], args.in[8], args.in[9], args.in[10], args.in[11], args.in[12], args.in[13]};
        for (int rep = 0; rep < ((DUP_MASK & 1) ? 2 : 1); ++rep) {
        for (int rep2 = 0; rep2 < ((DUP_MASK & 256) ? 2 : 1); ++rep2)
        for (int item = bid; item < 256; item += G) lru_item(lds, LA, item, tid, wid, lane);
        __syncthreads();
        for (int bu = bid; bu < 1024; bu += G) {
            const int bh = bu & 127, qhi = 7 - (bu >> 7);
            sb_wave(lds + wid * SBW_BYTES, Qb, Kb, Vb, YB, bh >> 3, bh & 7, qhi * 8 + wid, lane);
        }
        }
    }
    GSYNC();

    {
        PHASE_IDS
        pg8::Gemm g{YB, W_OUT0, M, 1024, 1024}; S.init(M, 1024, G, bid);
        EpiRes<false, false> E{nullptr, nullptr, MOD + 2 * 1024, norm_mix_g, MOD + 1 * 1024, norm_ffn_g, MOD + 4 * 1024, XG, SSQ1};
        pg8::gemm_phase<EpiRes<false, false>>(lds, g, S, E, tid);
    }
    GSYNC();

    for (int layer = 0; layer < 2; ++layer) {
        if (layer == 1) {
            {
                PHASE_IDS
                pg8::Gemm g{XG, W_IN1, M, 1536, 1024}; S.init(M, 1536, G, bid);
                EpiIn<1> E{SSQ2, SHW + SHW_IN1, 1536, PB, args.in[18], args.in[19]};
                pg8::gemm_phase<EpiIn<1>>(lds, g, S, E, tid);
            }
            GSYNC();
            {
                const bf16_t* Qb = PB; const bf16_t* Kb = PB + (size_t)M * 1024; const bf16_t* Vb = Kb + (size_t)M * 256;
                PHASE_IDS
                for (int rep = 0; rep < ((DUP_MASK & 16) ? 2 : 1); ++rep)
                swa_phase(lds, Qb, Kb, Vb, args.in[20], YB, bid, G, tid, wid, lane);
            }
            GSYNC();
            {
                PHASE_IDS
                pg8::Gemm g{YB, W_OUT1, M, 1024, 1024}; S.init(M, 1024, G, bid);
                EpiRes<false, false> E{nullptr, nullptr, MOD + (size_t)16 * 6144 + 2 * 1024, norm_mix_g + 1024, MOD + (size_t)16 * 6144 + 1 * 1024, norm_ffn_g + 1024, MOD + (size_t)16 * 6144 + 4 * 1024, XG, SSQ3};
                pg8::gemm_phase<EpiRes<false, false>>(lds, g, S, E, tid);
            }
            GSYNC();
        }
#if (DUP_MASK & 64)
        {
            PHASE_IDS
            pg8::Gemm g{XG, layer ? W_GU1 : W_GU0, M, 5632, 1024}; S.init(M, 5632, G, bid);
            EpiGU E{layer ? SSQ3 : SSQ1, SHW + (layer ? SHW_GU1 : SHW_GU0), args.in[24] + (size_t)layer * 3 * FF, args.in[25] + (size_t)layer * FF, ACT, HALO, FIXP, FIXU};
            pg8::gemm_phase<EpiGU>(lds, g, S, E, tid);
        }
#endif
        {
            PHASE_IDS
            pg8::Gemm g{XG, layer ? W_GU1 : W_GU0, M, 5632, 1024}; S.init(M, 5632, G, bid);
            EpiGU E{layer ? SSQ3 : SSQ1, SHW + (layer ? SHW_GU1 : SHW_GU0), args.in[24] + (size_t)layer * 3 * FF, args.in[25] + (size_t)layer * FF, ACT, HALO, FIXP, FIXU};
            pg8::gemm_phase<EpiGU>(lds, g, S, E, tid);
        }
        GSYNC();
        {
            PHASE_IDS
            const float* cw = args.in[24] + (size_t)layer * 3 * FF;
            pg8::StaticOrder SF; SF.init(M, 1024, G, bid);
            Unit fu; int prev_pm = -1;
            for (int ui = 0; SF.next(ui, fu); ++ui) {
                if (fu.pm == prev_pm) continue;
                prev_pm = fu.pm;
                for (int base = tid; base < 8 * 704; base += 4 * 512) {
                    f32x4 P4[4], U4[4], H1[4], H2[4], W0[4], W1[4];
#pragma unroll
                    for (int q = 0; q < 4; ++q) {
                        int idx = base + 512 * q; if (idx >= 8 * 704) idx = 8 * 704 - 1;
                        const int c4 = idx % 704, sr = idx / 704, s_ = sr & 1, gs = 4 * fu.pm + (sr >> 1);
                        const size_t fo = ((size_t)gs * 2 + s_) * FF + 4 * c4;
                        const int gp = gs > 0 ? gs - 1 : 0;
                        P4[q] = *(const f32x4*)(FIXP + fo); U4[q] = *(const f32x4*)(FIXU + fo);
                        H1[q] = *(const f32x4*)(HALO + ((size_t)gp * 2 + 1) * FF + 4 * c4); H2[q] = *(const f32x4*)(HALO + ((size_t)gp * 2) * FF + 4 * c4);
                        W0[q] = *(const f32x4*)(cw + 4 * c4); W1[q] = *(const f32x4*)(cw + FF + 4 * c4);
                    }
#pragma unroll
                    for (int q = 0; q < 4; ++q) {
                        const int idx = base + 512 * q;
                        if (idx < 8 * 704) {
                            const int c4 = idx % 704, sr = idx / 704, s_ = sr & 1, gs = 4 * fu.pm + (sr >> 1);
                            f32x4 a4 = P4[q];
                            if ((gs & 31) != 0) { if (s_ == 0) a4 = a4 + W1[q] * H1[q] + W0[q] * H2[q]; else a4 = a4 + W0[q] * H1[q]; }
                            const f32x4 o = silu4(a4) * U4[q]; u32x2 w; w.x = pk2(o[0], o[1]); w.y = pk2(o[2], o[3]);
                            *(u32x2*)(ACT + (size_t)(gs * 64 + s_) * FF + 4 * c4) = w;
                        }
                    }
                }
            }
            asm volatile("s_waitcnt vmcnt(0)" ::: "memory");
            __syncthreads();
        }
        if (layer == 0) {
            PHASE_IDS
            pg8::Gemm g{ACT, W_DN0, M, 1024, FF}; S.init(M, 1024, G, bid);
            EpiRes<false, false> E{nullptr, nullptr, MOD + 5 * 1024, norm_ffn_g, MOD + 4 * 1024, norm_mix_g + 1024, MOD + (size_t)16 * 6144 + 1 * 1024, XG, SSQ2};
            pg8::gemm_phase<EpiRes<false, false>>(lds, g, S, E, tid);
#if (DUP_MASK & 1024)
            { EpiNull E3{HALO}; pg8::gemm_phase<EpiNull>(lds, g, S, E3, tid); }
#endif
            GSYNC();
        } else {
            PHASE_IDS
            pg8::Gemm g{ACT, W_DN1, M, 1024, FF}; S.init(M, 1024, G, bid);
            EpiRes<false, true> E{nullptr, args.out, MOD + (size_t)16 * 6144 + 5 * 1024, norm_ffn_g + 1024, MOD + (size_t)16 * 6144 + 4 * 1024, nullptr, nullptr, XG, nullptr};
            pg8::gemm_phase<EpiRes<false, true>>(lds, g, S, E, tid);
        }
    }
}

extern "C" void kernel_launch(void* const* d_in, const int* in_sizes, int n_in, void* d_out, int out_size, void* d_ws, size_t ws_size, hipStream_t stream) {
    static int grid = 0;
    if (grid == 0) {
        if (n_in != 27 || out_size != M * DM || ws_size < WS_END) { fprintf(stderr, "kernel_launch: unexpected shapes (n_in %d out %d ws %zu)\n", n_in, out_size, ws_size); grid = -1; return; }
        int dev = 0, cus = 0, per_cu = 0;
        (void)hipGetDevice(&dev);
        (void)hipDeviceGetAttribute(&cus, hipDeviceAttributeMultiprocessorCount, dev);
        (void)hipFuncSetAttribute((const void*)fwd_mega, hipFuncAttributeMaxDynamicSharedMemorySize, LDS_BYTES);
        (void)hipOccupancyMaxActiveBlocksPerMultiprocessor(&per_cu, (const void*)fwd_mega, 512, LDS_BYTES);
        (void)hipGetLastError();
        grid = cus;
        if (per_cu < 1) fprintf(stderr, "kernel_launch: occupancy query says %d blocks/CU\n", per_cu);
    }
    if (grid < 0) return;
    (void)hipMemsetAsync(d_ws, 0, WS_ZERO_BYTES, stream);
    Args a{};
    for (int i = 0; i < 27; ++i) a.in[i] = (const float*)d_in[i];
    a.out = (float*)d_out; a.ws = (unsigned char*)d_ws;
    void* kargs[] = {&a};
    hipError_t e = hipLaunchCooperativeKernel((const void*)fwd_mega, dim3(grid), dim3(512), kargs, LDS_BYTES, stream);
    if (e != hipSuccess) fprintf(stderr, "cooperative launch failed: %s (grid %d)\n", hipGetErrorString(e), grid);
}
```

```cpp
#include <hip/hip_runtime.h>
#include <hip/hip_cooperative_groups.h>
#include <cstdio>
#include <cstdint>
namespace cg = cooperative_groups;

#define LAS __attribute__((address_space(3)))
typedef unsigned short bf16_t;
typedef short bf16x8 __attribute__((ext_vector_type(8)));
typedef short s16x4 __attribute__((ext_vector_type(4)));
typedef float f32x4 __attribute__((ext_vector_type(4)));
typedef float f32x2 __attribute__((ext_vector_type(2)));
typedef float f32x16 __attribute__((ext_vector_type(16)));
typedef unsigned u32x4 __attribute__((ext_vector_type(4)));
typedef unsigned u32x2 __attribute__((ext_vector_type(2)));
typedef __bf16 bf2_t __attribute__((ext_vector_type(2)));

__device__ __forceinline__ unsigned pk2(float lo, float hi) { f32x2 v = {lo, hi}; bf2_t r = __builtin_convertvector(v, bf2_t); return __builtin_bit_cast(unsigned, r); }
__device__ __forceinline__ float bflo(unsigned u) { return __uint_as_float(u << 16); }
__device__ __forceinline__ float bfhi(unsigned u) { return __uint_as_float(u & 0xffff0000u); }
#define LDS_WAIT() asm volatile("s_waitcnt lgkmcnt(0)" ::: "memory")
__device__ __forceinline__ float sx32(float v, int lane) {
    const unsigned u = __float_as_uint(v);
    const auto r = __builtin_amdgcn_permlane32_swap(u, u, false, false);
    return __uint_as_float((lane & 32) ? r[0] : r[1]);
}
__device__ __forceinline__ float sx16(float v, int lane) {
    const unsigned u = __float_as_uint(v);
    const auto r = __builtin_amdgcn_permlane16_swap(u, u, false, false);
    return __uint_as_float((lane & 16) ? r[0] : r[1]);
}
__device__ __forceinline__ float sx(float v, int mask, int lane) { return __int_as_float(__builtin_amdgcn_ds_bpermute((lane ^ mask) << 2, __float_as_int(v))); }

constexpr int NB = 16, SEQ = 2048, DM = 1024, M = NB * SEQ, FF = 2816;
constexpr float EPS = 1e-6f;
constexpr float LOG2E = 1.4426950408889634f;
constexpr float QSCALE = 0.125f * LOG2E;

constexpr size_t MiB = 1u << 20;
constexpr size_t WS_SSQ1 = 0, WS_SSQ2 = 128 * 1024, WS_SSQ3 = 256 * 1024, WS_ZERO_BYTES = 512 * 1024;
constexpr size_t WS_BAR = 384 * 1024;
constexpr size_t WS_SSQ0 = 512 * 1024;
constexpr size_t WS_MOD = 1 * MiB;
constexpr size_t WS_SHW = 2 * MiB;
constexpr size_t SHW_IN0 = 0, SHW_GU0 = 16 * 2560, SHW_IN1 = SHW_GU0 + 16 * 5632, SHW_GU1 = SHW_IN1 + 16 * 1536;
constexpr size_t WS_HALO = 3 * MiB, WS_FIXP = 15 * MiB, WS_FIXU = 27 * MiB;
constexpr size_t WS_W_IN0 = 40 * MiB, WS_W_OUT0 = 45 * MiB, WS_W_GU0 = 47 * MiB, WS_W_DN0 = 58 * MiB;
constexpr size_t WS_W_IN1 = 64 * MiB, WS_W_OUT1 = 67 * MiB, WS_W_GU1 = 69 * MiB, WS_W_DN1 = 80 * MiB;
constexpr size_t WS_XG = 96 * MiB;
constexpr size_t WS_P = 160 * MiB;
constexpr size_t WS_Y = 320 * MiB;
constexpr size_t WS_ACT = 160 * MiB;
constexpr size_t WS_XS = 384 * MiB;
constexpr size_t WS_END = 448 * MiB;

constexpr int LDS_BYTES = 147456;
#ifndef DUP_MASK
#define DUP_MASK 0
#endif

namespace pg8 {
constexpr int BM = 256, BK = 64, HALF = 128, HTB = HALF * BK * 2, STAGE_BYTES = 8 * HTB, NXCD = 8, WGM = 4;
__host__ __device__ __forceinline__ int lds_byte(int r, int c) { const int st = (r >> 4) * 2 + (c >> 5), rr = r & 15, cc = c & 31, ob = rr * 64 + cc * 2; return st * 1024 + (ob ^ (((ob >> 9) & 1) << 5)); }
__host__ __device__ __forceinline__ void stage_rc(int b, int& R, int& C) { const int st = b / 1024, sb = b % 1024, swz = sb ^ (((sb >> 9) & 1) << 5); R = (st >> 1) * 16 + swz / 64; C = (st & 1) * 32 + (swz % 64) / 2; }
struct Unit { int pm, pn; };
struct Gemm { const bf16_t* A; const bf16_t* Bt; int M, N, K; };
struct StaticOrder {
    int nM, nN, nwg, G, c;
    __host__ __device__ void init(int M_, int N_, int G_, int c_) { nM = M_ / BM; nN = N_ / BM; nwg = nM * nN; G = G_; c = c_; }
    __host__ __device__ bool next(int i, Unit& u) const {
        const long L = (long)i * G + c; if (L >= nwg) return false;
        int wgid = (int)L; { const int q = nwg / NXCD, r = nwg % NXCD, xcd = wgid % NXCD, off = wgid / NXCD; wgid = (xcd < r ? xcd * (q + 1) : r * (q + 1) + (xcd - r) * q) + off; }
        const int nig = WGM * nN, gid = wgid / nig, fm = gid * WGM, gsz = (nM - fm) < WGM ? (nM - fm) : WGM;
        u.pm = fm + ((wgid % nig) % gsz); u.pn = (wgid % nig) / gsz; return true;
    }
};

template <class Epi, bool ALIGN_EPI = true, bool SP2 = true>
__device__ __forceinline__ void gemm_phase(LAS unsigned char* lds, const Gemm g, const StaticOrder& S, const Epi& E, const int tid) {
    const int wid = __builtin_amdgcn_readfirstlane(tid >> 6), lane = tid & 63, wr = wid >> 2, wc = wid & 3, fr = lane & 15, fq = lane >> 4;
    const int K = g.K, nt = K / BK;
    unsigned voffA[2];
#pragma unroll
    for (int i = 0; i < 2; ++i) { int R, C; stage_rc(tid * 16 + i * 8192, R, C); voffA[i] = (unsigned)(R * K + C) * 2u; }
    const size_t kstep = (size_t)(BK * 2);
    const size_t hstep = (size_t)HALF * K * 2;
    const size_t tstep = 2 * hstep;
    const unsigned ldsw = (unsigned)wid * 1024u;
    const int aoff = lds_byte(wr * 64 + fr, fq * 8), boff = lds_byte(wc * 32 + fr, fq * 8);
#define PG8_SA(b, h) (((b) * 2 + (h)) * HTB)
#define PG8_SB(b, h) ((4 + (b) * 2 + (h)) * HTB)
#define PG8_STAGE(bufoff, gbase, voff) do { _Pragma("unroll") for (int _i = 0; _i < 2; ++_i) \
        __builtin_amdgcn_global_load_lds((const unsigned*)((const char*)(gbase) + (voff)[_i]), (LAS unsigned*)(lds + (bufoff) + ldsw + _i * 8192), 16, 0, 0); } while (0)
#define PG8_LDA(dst, b, h) do { _Pragma("unroll") for (int m = 0; m < 4; ++m) _Pragma("unroll") for (int k = 0; k < 2; ++k) dst[m][k] = *(const LAS bf16x8*)(lds + PG8_SA(b, h) + aoff + m * 2048 + k * 1024); } while (0)
#define PG8_LDB(dst, b, h) do { _Pragma("unroll") for (int n = 0; n < 2; ++n) _Pragma("unroll") for (int k = 0; k < 2; ++k) dst[n][k] = *(const LAS bf16x8*)(lds + PG8_SB(b, h) + boff + n * 2048 + k * 1024); } while (0)
#define PG8_MMA(ai, bj, At, Bt) do { __builtin_amdgcn_s_setprio(1); _Pragma("unroll") for (int m = 0; m < 4; ++m) _Pragma("unroll") for (int n = 0; n < 2; ++n) _Pragma("unroll") for (int k = 0; k < 2; ++k) \
        acc[ai][bj][m][n] = __builtin_amdgcn_mfma_f32_16x16x32_bf16(Bt[n][k], At[m][k], acc[ai][bj][m][n], 0, 0, 0); __builtin_amdgcn_s_setprio(0); } while (0)
#define PG8_WAIT_V(n) asm volatile("s_waitcnt vmcnt(" #n ")" ::: "memory")
#define PG8_WAIT_L(n) asm volatile("s_waitcnt lgkmcnt(" #n ")" ::: "memory")
#define PG8_BAR __builtin_amdgcn_s_barrier()
#define PG8_SCHED __builtin_amdgcn_sched_barrier(0)
    Unit cur, nxt; int ui = 0;
    if (!S.next(0, cur)) return;
    f32x4 acc[2][2][4][2];
#pragma unroll
    for (int a = 0; a < 2; ++a)
#pragma unroll
        for (int b = 0; b < 2; ++b)
#pragma unroll
            for (int m = 0; m < 4; ++m)
#pragma unroll
                for (int n = 0; n < 2; ++n) acc[a][b][m][n] = (f32x4){0.f, 0.f, 0.f, 0.f};
    bf16x8 At[4][2], B0[2][2], B1[2][2];
    const char* cA = (const char*)g.A + (size_t)cur.pm * tstep; const char* cB = (const char*)g.Bt + (size_t)cur.pn * tstep;
    {
        PG8_STAGE(PG8_SB(0, 0), cB, voffA); PG8_STAGE(PG8_SB(0, 1), cB + hstep, voffA); PG8_STAGE(PG8_SA(0, 0), cA, voffA); PG8_STAGE(PG8_SA(0, 1), cA + hstep, voffA);
        if (wr == 1) PG8_BAR;
        PG8_WAIT_V(2); PG8_BAR;
        PG8_STAGE(PG8_SB(1, 0), cB + kstep, voffA); PG8_STAGE(PG8_SA(1, 0), cA + kstep, voffA); PG8_STAGE(PG8_SB(1, 1), cB + hstep + kstep, voffA);
        PG8_WAIT_V(6); PG8_BAR;
    }
    for (;;) {
        const bool has_next = S.next(ui + 1, nxt);
        const char* nA = has_next ? (const char*)g.A + (size_t)nxt.pm * tstep : cA; const char* nB = has_next ? (const char*)g.Bt + (size_t)nxt.pn * tstep : cB;
        for (int t = 0; t < nt; t += 2) {
            const bool last = (t == nt - 2);
            const char* a1 = cA + (size_t)(t + 1) * kstep;
            const char* a2 = last ? nA : cA + (size_t)(t + 2) * kstep; const char* b2 = last ? nB : cB + (size_t)(t + 2) * kstep;
            const char* a3 = a2 + kstep; const char* b3 = b2 + kstep;
            PG8_LDB(B0, 0, 0); PG8_LDB(B1, 0, 1); PG8_SCHED; PG8_LDA(At, 0, 0); PG8_STAGE(PG8_SA(1, 1), a1 + hstep, voffA);
            PG8_WAIT_V(8); PG8_WAIT_L(0); PG8_BAR; PG8_MMA(0, 0, At, B0); PG8_MMA(0, 1, At, B1); PG8_BAR; PG8_SCHED;
            PG8_LDA(At, 0, 1); PG8_STAGE(PG8_SB(0, 0), b2, voffA); PG8_STAGE(PG8_SB(0, 1), b2 + hstep, voffA); PG8_STAGE(PG8_SA(0, 0), a2, voffA);
            PG8_WAIT_V(8); PG8_WAIT_L(0); PG8_BAR; PG8_MMA(1, 0, At, B0); PG8_MMA(1, 1, At, B1); PG8_BAR; PG8_SCHED;
            PG8_LDB(B0, 1, 0); PG8_LDB(B1, 1, 1); PG8_SCHED; PG8_LDA(At, 1, 0); PG8_STAGE(PG8_SA(0, 1), a2 + hstep, voffA);
            PG8_WAIT_V(8); PG8_WAIT_L(0); PG8_BAR; PG8_MMA(0, 0, At, B0); PG8_MMA(0, 1, At, B1); PG8_BAR; PG8_SCHED;
            PG8_LDA(At, 1, 1); PG8_STAGE(PG8_SB(1, 0), b3, voffA); PG8_STAGE(PG8_SB(1, 1), b3 + hstep, voffA); PG8_STAGE(PG8_SA(1, 0), a3, voffA);
            PG8_WAIT_V(8); PG8_WAIT_L(0); PG8_BAR; PG8_MMA(1, 0, At, B0); PG8_MMA(1, 1, At, B1); PG8_BAR; PG8_SCHED;
        }
        if constexpr (ALIGN_EPI) { if (wr == 0) PG8_BAR; }
        { int le_; asm volatile("v_mbcnt_lo_u32_b32 %0, -1, 0\n\tv_mbcnt_hi_u32_b32 %0, -1, %0" : "=v"(le_));
          E(acc, cur, wr, wc, le_ & 15, (le_ >> 4) & 3); }
        if (!has_next) break;
#pragma unroll
        for (int a = 0; a < 2; ++a)
#pragma unroll
            for (int b = 0; b < 2; ++b)
#pragma unroll
                for (int m = 0; m < 4; ++m)
#pragma unroll
                    for (int n = 0; n < 2; ++n) acc[a][b][m][n] = (f32x4){0.f, 0.f, 0.f, 0.f};
        cur = nxt; cA = nA; cB = nB; ++ui;
        if constexpr (ALIGN_EPI) { if (wr == 1) PG8_BAR; }
    }
    PG8_WAIT_V(0);
    if constexpr (!ALIGN_EPI) { if (wr == 0) PG8_BAR; }
    PG8_BAR;
#undef PG8_SA
#undef PG8_SB
#undef PG8_STAGE
#undef PG8_LDA
#undef PG8_LDB
#undef PG8_MMA
#undef PG8_WAIT_V
#undef PG8_WAIT_L
#undef PG8_BAR
#undef PG8_SCHED
}
}
using pg8::Unit;


#define GLD4(base, boff) (*(const f32x4*)((const char*)(base) + (unsigned)(boff)))
#define GST4(base, boff, v) (*(f32x4*)((char*)(base) + (unsigned)(boff)) = (v))
#define GST2(base, boff, v) (*(u32x2*)((char*)(base) + (unsigned)(boff)) = (v))
#define GLD1(base, boff) (*(const float*)((const char*)(base) + (unsigned)(boff)))
#define GLDU4(base, boff) (*(const u32x4*)((const char*)(base) + (unsigned)(boff)))
#define GSTU4(base, boff, v) (*(u32x4*)((char*)(base) + (unsigned)(boff)) = (v))

template <int LAYER> struct EpiIn {
    const float* ssq; const float* shw; int N; bf16_t* P; const float* gq; const float* gk;
    __device__ __forceinline__ void operator()(const f32x4 (&acc)[2][2][4][2], const Unit& u, int wr, int wc, int fr_in, int fq_in) const {
        int fr = fr_in, fq = fq_in; asm volatile("" : "+v"(fr), "+v"(fq));
        const int b = u.pm >> 3; const int lane_e = fq * 16 + fr;
        bf16_t* base; int ld, col0, mode;
        if (LAYER == 0) { const int region = u.pn >> 1; base = P + (size_t)region * M * 512; ld = 512; col0 = (u.pn & 1) * 256; mode = region == 2 ? 1 : (region == 3 ? 2 : 0); }
        else {
            if (u.pn < 4) { base = P; ld = 1024; col0 = u.pn * 256; mode = 1; }
            else if (u.pn == 4) { base = P + (size_t)M * 1024; ld = 256; col0 = 0; mode = 2; }
            else { base = P + (size_t)M * 1024 + (size_t)M * 256; ld = 256; col0 = 0; mode = 0; }
        }
        const float* bias = shw + (size_t)b * N + u.pn * 256;
        const unsigned boff = (unsigned)(wc * 32 + 4 * fq) * 4u;
        f32x4 bv[2][2];
#pragma unroll
        for (int bj = 0; bj < 2; ++bj)
#pragma unroll
            for (int n = 0; n < 2; ++n) bv[bj][n] = GLD4(bias, boff + (bj * 128 + n * 16) * 4);
        const int row0 = u.pm * 256 + wr * 64 + fr;
        float rsv[2][4];
#pragma unroll
        for (int ai = 0; ai < 2; ++ai)
#pragma unroll
            for (int m = 0; m < 4; ++m) rsv[ai][m] = GLD1(ssq, (unsigned)row0 * 4u + (ai * 128 + m * 16) * 4);
#pragma unroll
        for (int ai = 0; ai < 2; ++ai)
#pragma unroll
            for (int m = 0; m < 4; ++m) rsv[ai][m] = rsqrtf(rsv[ai][m] * (1.0f / 1024.0f) + EPS);
        const unsigned ldb = (unsigned)ld * 2u;
        if (mode == 0) {
            const unsigned o0 = (unsigned)row0 * ldb + (unsigned)(col0 + wc * 32 + 8 * fq) * 2u;
#pragma unroll
            for (int ai = 0; ai < 2; ++ai)
#pragma unroll
                for (int m = 0; m < 4; ++m) {
                    const float rs = rsv[ai][m];
                    const unsigned ro = o0 + (unsigned)(ai * 128 + m * 16) * ldb;
#pragma unroll
                    for (int bj = 0; bj < 2; ++bj) { const f32x4 v0 = acc[ai][bj][m][0] * rs + bv[bj][0], v1 = acc[ai][bj][m][1] * rs + bv[bj][1];
                        u32x4 w; w.x = pk2(v0[0], v0[1]); w.y = pk2(v0[2], v0[3]); w.z = pk2(v1[0], v1[1]); w.w = pk2(v1[2], v1[3]); GSTU4(base, ro + (bj * 128) * 2, w); }
                }
        } else {
            const float* gn = (mode == 1) ? gq : gk; const float sc = (mode == 1) ? QSCALE : 1.0f;
            f32x4 gv[2][2];
#pragma unroll
            for (int bj = 0; bj < 2; ++bj)
#pragma unroll
                for (int n = 0; n < 2; ++n) gv[bj][n] = GLD4(gn, (unsigned)(8 * fq) * 4u + (32 * bj + 4 * n) * 4) * sc;
            const unsigned o0 = (unsigned)row0 * ldb + (unsigned)(col0 + 64 * wc + 8 * fq) * 2u;
#pragma unroll
            for (int ai = 0; ai < 2; ++ai)
#pragma unroll
                for (int m = 0; m < 4; ++m) {
                    const float rs = rsv[ai][m];
                    f32x4 v[2][2]; float ss = 0.f;
#pragma unroll
                    for (int bj = 0; bj < 2; ++bj)
#pragma unroll
                        for (int n = 0; n < 2; ++n) { v[bj][n] = acc[ai][bj][m][n] * rs + bv[bj][n]; const f32x4 q = v[bj][n] * v[bj][n]; ss += (q[0] + q[1]) + (q[2] + q[3]); }
                    ss += sx16(ss, lane_e); ss += sx32(ss, lane_e);
                    const float hr = rsqrtf(ss * (1.0f / 64.0f) + EPS);
                    const unsigned ro = o0 + (unsigned)(ai * 128 + m * 16) * ldb;
#pragma unroll
                    for (int bj = 0; bj < 2; ++bj) { const f32x4 o0_ = v[bj][0] * hr * gv[bj][0], o1_ = v[bj][1] * hr * gv[bj][1];
                        u32x4 w; w.x = pk2(o0_[0], o0_[1]); w.y = pk2(o0_[2], o0_[3]); w.z = pk2(o1_[0], o1_[1]); w.w = pk2(o1_[2], o1_[3]); GSTU4(base, ro + (32 * bj) * 2, w); }
                }
        }
    }
};

#define GLD2(base, boff) (*(const u32x2*)((const char*)(base) + (unsigned)(boff)))
template <bool IN_F32, bool LAST> struct EpiRes {
    const float* xin32; float* xout32; const float* gate; const float* pg; const float* psc; const float* ng; const float* nsc; bf16_t* xg; float* ssq;
    __device__ __forceinline__ void operator()(const f32x4 (&acc)[2][2][4][2], const Unit& u, int wr, int wc, int fr_in, int fq_in) const {
        int fr = fr_in, fq = fq_in; asm volatile("" : "+v"(fr), "+v"(fq));
        const int b = u.pm >> 3; const int lane_e = fq * 16 + fr; (void)lane_e;
        const int col = u.pn * 256 + wc * 32 + 8 * fq;
        const float* gtp = gate + (size_t)b * 6144; const float* nsp = LAST ? gate : nsc + (size_t)b * 6144; const float* psp = IN_F32 ? gate : psc + (size_t)b * 6144;
        f32x4 gt[2][2], gm[2][2], ri[2][2];
#pragma unroll
        for (int bj = 0; bj < 2; ++bj)
#pragma unroll
            for (int n = 0; n < 2; ++n) {
                const unsigned co = (unsigned)col * 4u + (bj * 128 + n * 4) * 4;
                gt[bj][n] = GLD4(gtp, co);
                if (!LAST) gm[bj][n] = GLD4(ng, co) * (GLD4(nsp, co) + 1.0f);
                if (!IN_F32) { const f32x4 d = GLD4(pg, co) * (GLD4(psp, co) + 1.0f); ri[bj][n] = (f32x4){1.0f / d[0], 1.0f / d[1], 1.0f / d[2], 1.0f / d[3]}; }
            }
        const int row0 = u.pm * 256 + wr * 64 + fr;
        const unsigned e0 = (unsigned)row0 * 1024u + (unsigned)col;
        u32x4 raw[2][2][2][IN_F32 ? 2 : 1];
#define EPIRES_LOAD(buf, hb_) do { _Pragma("unroll") for (int mm = 0; mm < 2; ++mm) _Pragma("unroll") for (int bj = 0; bj < 2; ++bj) { \
            const unsigned eo = e0 + (unsigned)(((hb_ >> 1) * 128 + ((hb_ & 1) * 2 + mm) * 16) * 1024 + bj * 128); \
            if (IN_F32) { raw[buf][mm][bj][0] = GLDU4(xin32, eo * 4u); raw[buf][mm][bj][IN_F32 ? 1 : 0] = GLDU4(xin32, eo * 4u + 16u); } \
            else raw[buf][mm][bj][0] = GLDU4(xg, eo * 2u); } } while (0)
        EPIRES_LOAD(0, 0);
#pragma unroll
        for (int hb = 0; hb < 4; ++hb) {
            const int ai = hb >> 1, cb_ = hb & 1;
            if (hb < 3) { if (cb_ == 0) EPIRES_LOAD(1, (hb + 1)); else EPIRES_LOAD(0, (hb + 1)); }
#pragma unroll
            for (int mm = 0; mm < 2; ++mm) {
                const int m = (hb & 1) * 2 + mm;
                const unsigned ro = e0 + (unsigned)((ai * 128 + m * 16) * 1024);
                float s = 0.f;
#pragma unroll
                for (int bj = 0; bj < 2; ++bj) {
                    f32x4 x0, x1;
                    if (IN_F32) { x0 = __builtin_bit_cast(f32x4, raw[cb_][mm][bj][0]); x1 = __builtin_bit_cast(f32x4, raw[cb_][mm][bj][IN_F32 ? 1 : 0]); }
                    else { const u32x4 r4 = raw[cb_][mm][bj][0]; x0 = (f32x4){bflo(r4.x), bfhi(r4.x), bflo(r4.y), bfhi(r4.y)} * ri[bj][0]; x1 = (f32x4){bflo(r4.z), bfhi(r4.z), bflo(r4.w), bfhi(r4.w)} * ri[bj][1]; }
                    const f32x4 v0 = x0 + gt[bj][0] * acc[ai][bj][m][0], v1 = x1 + gt[bj][1] * acc[ai][bj][m][1];
                    const unsigned eo = ro + (unsigned)(bj * 128);
                    if (LAST) { GST4(xout32, eo * 4u, v0); GST4(xout32, eo * 4u + 16u, v1); }
                    else {
                        const f32x4 q0 = v0 * v0, q1 = v1 * v1; s += ((q0[0] + q0[1]) + (q0[2] + q0[3])) + ((q1[0] + q1[1]) + (q1[2] + q1[3]));
                        const f32x4 o0 = v0 * gm[bj][0], o1 = v1 * gm[bj][1];
                        u32x4 w; w.x = pk2(o0[0], o0[1]); w.y = pk2(o0[2], o0[3]); w.z = pk2(o1[0], o1[1]); w.w = pk2(o1[2], o1[3]); GSTU4(xg, eo * 2u, w);
                    }
                }
                if (!LAST) { s += sx16(s, lane_e); s += sx32(s, lane_e); if (fq == 0) unsafeAtomicAdd(ssq + (row0 + ai * 128 + m * 16), s); }
            }
        }
#undef EPIRES_LOAD
    }
};

struct EpiNull {
    float* sink;
    __device__ __forceinline__ void operator()(const f32x4 (&acc)[2][2][4][2], const Unit& u, int wr, int wc, int fr, int fq) const {
        f32x4 t = (f32x4){0.f, 0.f, 0.f, 0.f};
#pragma unroll
        for (int ai = 0; ai < 2; ++ai)
#pragma unroll
            for (int bj = 0; bj < 2; ++bj)
#pragma unroll
                for (int m = 0; m < 4; ++m)
#pragma unroll
                    for (int n = 0; n < 2; ++n) t = t + acc[ai][bj][m][n];
        if (t[0] + t[1] + t[2] + t[3] == 1.2345e33f) sink[u.pm] = t[0];
    }
};

__device__ __forceinline__ f32x4 silu4(f32x4 a) {
    f32x4 r;
#pragma unroll
    for (int e = 0; e < 4; ++e) r[e] = a[e] * __builtin_amdgcn_rcpf(1.0f + __builtin_amdgcn_exp2f(-a[e] * LOG2E));
    return r;
}
template <int N_> __device__ __forceinline__ f32x4 ror4(f32x4 v) {
    f32x4 r;
#pragma unroll
    for (int e = 0; e < 4; ++e) r[e] = __int_as_float(__builtin_amdgcn_mov_dpp(__float_as_int(v[e]), 0x120 + N_, 0xf, 0xf, false));
    return r;
}
struct EpiGU {
    const float* ssq; const float* shw; const float* cw; const float* cbias; bf16_t* act; float* halo; float* fixp; float* fixu;
    __device__ __forceinline__ void operator()(const f32x4 (&acc)[2][2][4][2], const Unit& u, int wr, int wc, int fr_in, int fq_in) const {
        int fr = fr_in, fq = fq_in; asm volatile("" : "+v"(fr), "+v"(fq));
        const int b = u.pm >> 3;
        const int fcol = u.pn * 128 + wc * 32 + 8 * fq;
        const float* bias = shw + (size_t)b * 5632 + u.pn * 256;
        const unsigned boff = (unsigned)(wc * 32 + 4 * fq) * 4u;
        const int row0 = u.pm * 256 + wr * 64 + fr;
        float rsv[2][4];
#pragma unroll
        for (int ai = 0; ai < 2; ++ai)
#pragma unroll
            for (int m = 0; m < 4; ++m) rsv[ai][m] = GLD1(ssq, (unsigned)row0 * 4u + (ai * 128 + m * 16) * 4);
        f32x4 bg_[2], bu_[2], w0_[2], w1_[2], w2_[2], cb_[2];
#pragma unroll
        for (int n = 0; n < 2; ++n) {
            bg_[n] = GLD4(bias, boff + n * 64); bu_[n] = GLD4(bias, boff + 512 + n * 64);
            const unsigned co = (unsigned)fcol * 4u + n * 16;
            w0_[n] = GLD4(cw, co); w1_[n] = GLD4(cw, co + FF * 4); w2_[n] = GLD4(cw, co + 2 * FF * 4); cb_[n] = GLD4(cbias, co);
        }
#pragma unroll
        for (int ai = 0; ai < 2; ++ai)
#pragma unroll
            for (int m = 0; m < 4; ++m) rsv[ai][m] = rsqrtf(rsv[ai][m] * (1.0f / 1024.0f) + EPS);
        const unsigned aoff0 = ((unsigned)row0 * (unsigned)FF + (unsigned)fcol) * 2u;
#pragma unroll
        for (int ai = 0; ai < 2; ++ai) {
            const int gs = u.pm * 4 + ai * 2 + wr;
            f32x4 p1[2], p2[2];
#pragma unroll
            for (int n = 0; n < 2; ++n) { p1[n] = (f32x4){0.f, 0.f, 0.f, 0.f}; p2[n] = p1[n]; }
#pragma unroll
            for (int m = 0; m < 4; ++m) {
                const float rs = rsv[ai][m];
                f32x4 o[2];
#pragma unroll
                for (int n = 0; n < 2; ++n) {
                    const f32x4 g = acc[ai][0][m][n] * rs + bg_[n];
                    const f32x4 up = acc[ai][1][m][n] * rs + bu_[n];
                    const f32x4 c1 = ror4<1>(g), c2 = ror4<2>(g);
                    const f32x4 g1 = fr >= 1 ? c1 : p1[n];
                    const f32x4 g2 = fr >= 2 ? c2 : p2[n];
                    if (m == 0 && fr < 2) {
                        f32x4 pp = w2_[n] * g + cb_[n]; if (fr == 1) pp = pp + w1_[n] * g1;
                        const unsigned fo = ((unsigned)(gs * 2 + fr) * (unsigned)FF + (unsigned)fcol) * 4u + n * 16;
                        GST4(fixp, fo, pp); GST4(fixu, fo, up);
                    }
                    const f32x4 a = w2_[n] * g + w1_[n] * g1 + w0_[n] * g2 + cb_[n];
                    o[n] = silu4(a) * up;
                    if (m == 3 && fr >= 14) GST4(halo, ((unsigned)(gs * 2 + (fr - 14)) * (unsigned)FF + (unsigned)fcol) * 4u + n * 16, g);
                    p1[n] = c1; p2[n] = c2;
                }
                if (!(m == 0 && fr < 2)) {
                    u32x4 w; w.x = pk2(o[0][0], o[0][1]); w.y = pk2(o[0][2], o[0][3]); w.z = pk2(o[1][0], o[1][1]); w.w = pk2(o[1][2], o[1][3]);
                    GSTU4(act, aoff0 + (unsigned)((ai * 128 + m * 16) * FF) * 2u, w);
                }
            }
        }
    }
};

#define MFMA32(a, b, c) __builtin_amdgcn_mfma_f32_32x32x16_bf16((a), (b), (c), 0, 0, 0)
__device__ __forceinline__ int crow(int i, int h) { return (i & 3) + 8 * (i >> 2) + 4 * h; }
__device__ __forceinline__ bf16x8 pack8(float a0, float a1, float a2, float a3, float a4, float a5, float a6, float a7) {
    u32x4 p; p.x = pk2(a0, a1); p.y = pk2(a2, a3); p.z = pk2(a4, a5); p.w = pk2(a6, a7); return __builtin_bit_cast(bf16x8, p);
}
__device__ __forceinline__ bf16x8 tr8(const LAS unsigned char* p_lo, int hi_off) {
    const s16x4 lo = __builtin_amdgcn_ds_read_tr16_b64_v4i16((LAS s16x4*)p_lo);
    const s16x4 hi = __builtin_amdgcn_ds_read_tr16_b64_v4i16((LAS s16x4*)(p_lo + hi_off));
    return __builtin_shufflevector(lo, hi, 0, 1, 2, 3, 4, 5, 6, 7);
}

__device__ __forceinline__ void store_ot32(bf16_t* rowp, const f32x16& O, float sc, int hh) {
    u32x2 o2[4];
#pragma unroll
    for (int g = 0; g < 4; ++g) { o2[g].x = pk2(O[4 * g] * sc, O[4 * g + 1] * sc); o2[g].y = pk2(O[4 * g + 2] * sc, O[4 * g + 3] * sc); }
#pragma unroll
    for (int k = 0; k < 4; k += 2) {
        u32x2 a = o2[k], b = o2[k + 1];
        { const auto rx = __builtin_amdgcn_permlane32_swap(a.x, b.x, false, false); a.x = rx[0]; b.x = rx[1]; }
        { const auto ry = __builtin_amdgcn_permlane32_swap(a.y, b.y, false, false); a.y = ry[0]; b.y = ry[1]; }
        u32x4 w; w.x = a.x; w.y = a.y; w.z = b.x; w.w = b.y;
        *(u32x4*)((char*)rowp + (hh ? 16 : 0) + 16 * k) = w;
    }
}
constexpr int KSTR = 144, VSTR = 192;
constexpr int SBW_BYTES = 32 * VSTR;
constexpr float SB_EXIT = 64.0f;
__device__ __forceinline__ void sb_wave(LAS unsigned char* vl, const bf16_t* Q, const bf16_t* K, const bf16_t* V, bf16_t* Y, int b, int h, int qg, int lane) {
    const int r = lane & 31, hh = lane >> 5;
    const size_t rowbase = (size_t)b * SEQ;
    const int qw0 = 32 * qg;
    bf16x8 qf[4];
    { const bf16_t* qp = Q + (rowbase + qw0 + r) * 512 + h * 64 + 8 * hh;
#pragma unroll
      for (int s = 0; s < 4; ++s) qf[s] = *(const bf16x8*)(qp + 16 * s); }
    f32x16 O0, O1;
#pragma unroll
    for (int i = 0; i < 16; ++i) { O0[i] = 0.f; O1[i] = 0.f; }
    float carry = 0.f;
    const bf16_t* kp = K + (rowbase + r) * 512 + h * 64 + 8 * hh;
    const bf16_t* vp = V + (rowbase + (lane >> 3)) * 512 + h * 64 + (lane & 7) * 8;
    const int vst = (lane >> 3) * VSTR + (lane & 7) * 16;
    bf16x8 kf[4]; u32x4 vr[4];
#pragma unroll
    for (int s = 0; s < 4; ++s) kf[s] = *(const bf16x8*)(kp + (size_t)(32 * qg) * 512 + 16 * s);
#pragma unroll
    for (int i = 0; i < 4; ++i) vr[i] = *(const u32x4*)(vp + (size_t)(32 * qg + 8 * i) * 512);
    const int q4 = (lane & 15) >> 2, p4 = lane & 3, blk = (lane >> 4) & 1;
    const int vlane_off = (4 * hh + q4) * VSTR + 8 * (4 * blk + p4);
    for (int kb = qg; kb >= 0; --kb) {
        asm volatile("" ::: "memory");
#pragma unroll
        for (int i = 0; i < 4; ++i) *(LAS u32x4*)(vl + vst + 8 * i * VSTR) = vr[i];
        bf16x8 kc[4];
#pragma unroll
        for (int s = 0; s < 4; ++s) kc[s] = kf[s];
        if (kb > 0) {
#pragma unroll
            for (int s = 0; s < 4; ++s) kf[s] = *(const bf16x8*)(kp + (size_t)(32 * (kb - 1)) * 512 + 16 * s);
#pragma unroll
            for (int i = 0; i < 4; ++i) vr[i] = *(const u32x4*)(vp + (size_t)(32 * (kb - 1) + 8 * i) * 512);
        }
        const bool diag = (kb == qg);
        f32x16 z;
#pragma unroll
        for (int i = 0; i < 16; ++i) z[i] = 0.f;
#pragma unroll
        for (int s = 0; s < 4; ++s) z = MFMA32(kc[s], qf[s], z);
        float sp[16];
#pragma unroll
        for (int i = 0; i < 16; ++i) {
            const float e = __builtin_amdgcn_exp2f(z[i]);
            float v = __builtin_amdgcn_logf(1.0f + e);
            if (diag && !(crow(i, hh) < r)) v = 0.f;
            sp[i] = v;
        }
        float G[4], Gp[4];
#pragma unroll
        for (int g = 0; g < 4; ++g) { G[g] = (sp[4 * g] + sp[4 * g + 1]) + (sp[4 * g + 2] + sp[4 * g + 3]); Gp[g] = sx32(G[g], lane); }
        float suf = carry; float w[16];
#pragma unroll
        for (int g = 3; g >= 0; --g) {
            float run = suf + (hh == 0 ? Gp[g] : 0.f);
#pragma unroll
            for (int i = 4 * g + 3; i >= 4 * g; --i) {
                run += sp[i];
                float wv = __builtin_amdgcn_exp2f(z[i] - run);
                if (diag && !(crow(i, hh) < r)) wv = 0.f;
                w[i] = wv;
            }
            suf += G[g] + Gp[g];
        }
        carry = suf;
        LDS_WAIT();
#pragma unroll
        for (int s = 0; s < 2; ++s) {
            const bf16x8 pf = pack8(w[8 * s], w[8 * s + 1], w[8 * s + 2], w[8 * s + 3], w[8 * s + 4], w[8 * s + 5], w[8 * s + 6], w[8 * s + 7]);
            const LAS unsigned char* vq = vl + (16 * s) * VSTR + vlane_off;
            const bf16x8 a0 = tr8(vq, 8 * VSTR), a1 = tr8(vq + 64, 8 * VSTR);
            O0 = MFMA32(a0, pf, O0); O1 = MFMA32(a1, pf, O1);
        }
        if (__all(carry >= SB_EXIT)) break;
    }
    bf16_t* yp = Y + (rowbase + qw0 + r) * 1024 + 512 + h * 64;
    store_ot32(yp, O0, 1.0f, hh); store_ot32(yp + 32, O1, 1.0f, hh);
}

constexpr int SW_VOFF = 192 * KSTR;
constexpr int SW_BUF = 192 * KSTR + 192 * VSTR;
__device__ __forceinline__ void swa_phase(LAS unsigned char* lds, const bf16_t* Q, const bf16_t* K, const bf16_t* V, const float* sinks, bf16_t* Y, int bid, int G, int tid, int wid, int lane) {
    const int r = lane & 31, hh = lane >> 5, qsub = wid & 1;
    const int q4 = (lane & 15) >> 2, p4 = lane & 3, blk = (lane >> 4) & 1;
    const int vlane_off = (4 * hh + q4) * VSTR + 8 * (4 * blk + p4);
    int u = (G % 8 == 0) ? (bid % 8) * (G / 8) + bid / 8 : bid;
    if (u >= 2048) return;
    u32x4 kv[3], vv[3]; bf16x8 qn[4];
#define SWA_LOAD(uu) do { const int qc_ = (uu) & 31, kvh_ = ((uu) >> 5) & 3, b_ = (uu) >> 7; \
        _Pragma("unroll") for (int it = 0; it < 3; ++it) { const int idx = tid + it * 512, srow = idx >> 3, spc = idx & 7, kpos = 64 * qc_ - 128 + srow; \
            kv[it] = (u32x4){0u, 0u, 0u, 0u}; vv[it] = (u32x4){0u, 0u, 0u, 0u}; \
            if (kpos >= 0) { const unsigned off = ((unsigned)(b_ * SEQ + kpos) * 256u + (unsigned)(kvh_ * 64 + spc * 8)) * 2u; kv[it] = GLDU4(K, off); vv[it] = GLDU4(V, off); } } \
        { const unsigned qo = ((unsigned)(b_ * SEQ + 64 * qc_ + 32 * qsub + r) * 1024u + (unsigned)((4 * kvh_ + (wid >> 1)) * 64 + 8 * hh)) * 2u; \
          _Pragma("unroll") for (int s = 0; s < 4; ++s) qn[s] = __builtin_bit_cast(bf16x8, GLDU4(Q, qo + 32 * s)); } } while (0)
    SWA_LOAD(u);
    int cur = 0;
    __syncthreads();
    for (;;) {
        const int qc = u & 31, kvh = (u >> 5) & 3, b = u >> 7;
        const int head = 4 * kvh + (wid >> 1);
        const int qw0 = 64 * qc + 32 * qsub;
        const int kbase = 64 * qc - 128;
        LAS unsigned char* kb_ = lds + cur * SW_BUF; LAS unsigned char* vb_ = kb_ + 192 * KSTR;
#pragma unroll
        for (int it = 0; it < 3; ++it) { const int idx = tid + it * 512, srow = idx >> 3, spc = idx & 7; *(LAS u32x4*)(kb_ + srow * KSTR + spc * 16) = kv[it]; *(LAS u32x4*)(vb_ + srow * VSTR + spc * 16) = vv[it]; }
        bf16x8 qf[4];
#pragma unroll
        for (int s = 0; s < 4; ++s) qf[s] = qn[s];
        __syncthreads();
        const int un = u + G; const bool has_next = un < 2048;
        if (has_next) SWA_LOAD(un);
        f32x16 O0, O1;
#pragma unroll
        for (int i = 0; i < 16; ++i) { O0[i] = 0.f; O1[i] = 0.f; }
        float mrun = sinks[head] * LOG2E, lsum = (hh == 0) ? 1.0f : 0.0f;
#pragma unroll
        for (int j = 0; j < 5; ++j) {
            const int rb = qsub + j;
            const int key0 = kbase + 32 * rb;
            if (key0 >= 0) {
                f32x16 z;
#pragma unroll
                for (int i = 0; i < 16; ++i) z[i] = 0.f;
#pragma unroll
                for (int s = 0; s < 4; ++s) { const bf16x8 a = *(const LAS bf16x8*)(kb_ + (32 * rb + r) * KSTR + 32 * s + 16 * hh); z = MFMA32(a, qf[s], z); }
                float bm = -3.0e38f;
#pragma unroll
                for (int i = 0; i < 16; ++i) {
                    bool valid = true;
                    if (j == 0) valid = (crow(i, hh) > r);
                    if (j == 4) valid = (crow(i, hh) <= r);
                    if (!valid) z[i] = -3.0e38f;
                    bm = fmaxf(bm, z[i]);
                }
                bm = fmaxf(bm, sx32(bm, lane));
                if (__any(bm > mrun + 8.0f)) {
                    const float mnew = fmaxf(mrun, bm);
                    const float alpha = __builtin_amdgcn_exp2f(mrun - mnew);
                    mrun = mnew; lsum *= alpha;
#pragma unroll
                    for (int i = 0; i < 16; ++i) { O0[i] *= alpha; O1[i] *= alpha; }
                }
                float w[16]; float ps = 0.f;
#pragma unroll
                for (int i = 0; i < 16; ++i) { w[i] = __builtin_amdgcn_exp2f(z[i] - mrun); ps += w[i]; }
                lsum += ps;
#pragma unroll
                for (int s = 0; s < 2; ++s) {
                    const bf16x8 pf = pack8(w[8 * s], w[8 * s + 1], w[8 * s + 2], w[8 * s + 3], w[8 * s + 4], w[8 * s + 5], w[8 * s + 6], w[8 * s + 7]);
                    const LAS unsigned char* vp = vb_ + (32 * rb + 16 * s) * VSTR + vlane_off;
                    const bf16x8 a0 = tr8(vp, 8 * VSTR), a1 = tr8(vp + 64, 8 * VSTR);
                    O0 = MFMA32(a0, pf, O0); O1 = MFMA32(a1, pf, O1);
                }
            }
        }
        lsum += sx32(lsum, lane);
        const float inv = 1.0f / lsum;
        bf16_t* yp = Y + ((size_t)b * SEQ + qw0 + r) * 1024 + head * 64;
        store_ot32(yp, O0, inv, hh); store_ot32(yp + 32, O1, inv, hh);
        if (!has_next) break;
        u = un; cur ^= 1;
    }
#undef SWA_LOAD
}

constexpr int XCS = 68;
constexpr int LR_RAWSTR = 144, LR_GR = 37376, LR_XCW = 53760, LR_EXCH = 123392, LR_CW = 125440  , LR_WF = 126720  ;
struct LruArgs { const bf16_t* XR; const bf16_t* GR; bf16_t* Y; const float* convw; const float* convb; const float* wa; const float* ba; const float* wx; const float* bx; const float* lam; };
__device__ __forceinline__ void lru_item(LAS unsigned char* lds, const LruArgs& A, int item, int tid, int wid, int lane) {
    const int b = item >> 4, n = (item >> 1) & 7, half = item & 1;
    const int r = lane & 31, hh = lane >> 5;
    const int co = lane & 7, tsub = lane >> 3;
    const size_t rowbase = (size_t)b * SEQ;
    LAS float* xcw = (LAS float*)(lds + LR_XCW + wid * (32 * XCS * 4));
    LAS float* exch = (LAS float*)(lds + LR_EXCH);
    __syncthreads();
    {
        LAS float* cwl = (LAS float*)(lds + LR_CW);
#pragma unroll
        for (int k = 0; k < 4; ++k)
#pragma unroll
            for (int j = 0; j < 8; ++j) cwl[k * 64 + 8 * co + j] = A.convw[k * 512 + 64 * n + 8 * co + j];
#pragma unroll
        for (int j = 0; j < 8; ++j) cwl[256 + 8 * co + j] = A.convb[64 * n + 8 * co + j];
#pragma unroll
        for (int s = 0; s < 4; ++s) {
            float ta[8], tx[8];
#pragma unroll
            for (int j = 0; j < 8; ++j) { const int idx = (n * 64 + 16 * s + 8 * hh + j) * 64 + 32 * half + r; ta[j] = A.wa[idx]; tx[j] = A.wx[idx]; }
            *(LAS bf16x8*)(lds + LR_WF + (2 * s) * 1024 + lane * 16) = pack8(ta[0], ta[1], ta[2], ta[3], ta[4], ta[5], ta[6], ta[7]);
            *(LAS bf16x8*)(lds + LR_WF + (2 * s + 1) * 1024 + lane * 16) = pack8(tx[0], tx[1], tx[2], tx[3], tx[4], tx[5], tx[6], tx[7]);
        }
    }
    const int c = 64 * n + 32 * half + r;
    const float ba_c = A.ba[c], bx_c = A.bx[c];
    const float lam_c = A.lam[c];
    const float spl2 = 8.0f * (fmaxf(-lam_c, 0.f) + log1pf(expf(-fabsf(lam_c)))) * LOG2E;
    u32x4 praw[5], pgr[2];
    const bf16_t* xrb = A.XR + rowbase * 512 + 64 * n;
    const bf16_t* grb = A.GR + rowbase * 512 + 64 * n + 32 * half;
#define LRU_LOAD(cc) do { \
        _Pragma("unroll") for (int i_ = 0; i_ < 5; ++i_) { const int idx = tid + 512 * i_, j = idx >> 3, pc = idx & 7, pos = 256 * (cc) - 3 + j; \
            praw[i_] = (u32x4){0u, 0u, 0u, 0u}; if (idx < 2072 && pos >= 0) praw[i_] = *(const u32x4*)(xrb + (size_t)pos * 512 + 8 * pc); } \
        _Pragma("unroll") for (int i_ = 0; i_ < 2; ++i_) { const int idx = tid + 512 * i_, j = idx >> 2, pc = idx & 3; \
            pgr[i_] = *(const u32x4*)(grb + (size_t)(256 * (cc) + j) * 512 + 8 * pc); } } while (0)
    LRU_LOAD(0);
    float carry = 0.f;
    for (int cch = 0; cch < 8; ++cch) {
        __syncthreads();
#pragma unroll
        for (int i_ = 0; i_ < 5; ++i_) { const int idx = tid + 512 * i_; if (idx < 2072) *(LAS u32x4*)(lds + (idx >> 3) * LR_RAWSTR + (idx & 7) * 16) = praw[i_]; }
#pragma unroll
        for (int i_ = 0; i_ < 2; ++i_) { const int idx = tid + 512 * i_; *(LAS u32x4*)(lds + LR_GR + (idx >> 2) * 64 + (idx & 3) * 16) = pgr[i_]; }
        if (cch < 7) LRU_LOAD(cch + 1);
        __syncthreads();
        float cw[4][8], cbv[8];
        {
            const LAS float* cwl = (const LAS float*)(lds + LR_CW);
#pragma unroll
            for (int k = 0; k < 4; ++k) { const f32x4 t0 = *(const LAS f32x4*)(cwl + k * 64 + 8 * co), t1 = *(const LAS f32x4*)(cwl + k * 64 + 8 * co + 4);
                cw[k][0] = t0[0]; cw[k][1] = t0[1]; cw[k][2] = t0[2]; cw[k][3] = t0[3]; cw[k][4] = t1[0]; cw[k][5] = t1[1]; cw[k][6] = t1[2]; cw[k][7] = t1[3]; }
            const f32x4 t0 = *(const LAS f32x4*)(cwl + 256 + 8 * co), t1 = *(const LAS f32x4*)(cwl + 256 + 8 * co + 4);
            cbv[0] = t0[0]; cbv[1] = t0[1]; cbv[2] = t0[2]; cbv[3] = t0[3]; cbv[4] = t1[0]; cbv[5] = t1[1]; cbv[6] = t1[2]; cbv[7] = t1[3];
        }
#pragma unroll
        for (int p = 0; p < 4; ++p) {
            const int tl = 8 * p + tsub;
            float av[8];
#pragma unroll
            for (int j = 0; j < 8; ++j) av[j] = cbv[j];
#pragma unroll
            for (int k = 0; k < 4; ++k) {
                const u32x4 raw = *(const LAS u32x4*)(lds + (32 * wid + tl + k) * LR_RAWSTR + co * 16);
                av[0] += cw[k][0] * bflo(raw.x); av[1] += cw[k][1] * bfhi(raw.x); av[2] += cw[k][2] * bflo(raw.y); av[3] += cw[k][3] * bfhi(raw.y);
                av[4] += cw[k][4] * bflo(raw.z); av[5] += cw[k][5] * bfhi(raw.z); av[6] += cw[k][6] * bflo(raw.w); av[7] += cw[k][7] * bfhi(raw.w);
            }
            *(LAS f32x4*)(xcw + tl * XCS + 8 * co) = (f32x4){av[0], av[1], av[2], av[3]};
            *(LAS f32x4*)(xcw + tl * XCS + 8 * co + 4) = (f32x4){av[4], av[5], av[6], av[7]};
        }
        LDS_WAIT();
        f32x16 R, I;
#pragma unroll
        for (int i = 0; i < 16; ++i) { R[i] = 0.f; I[i] = 0.f; }
#pragma unroll
        for (int s = 0; s < 4; ++s) {
            const f32x4 a0 = *(const LAS f32x4*)(xcw + r * XCS + 16 * s + 8 * hh), a1 = *(const LAS f32x4*)(xcw + r * XCS + 16 * s + 8 * hh + 4);
            const bf16x8 af = pack8(a0[0], a0[1], a0[2], a0[3], a1[0], a1[1], a1[2], a1[3]);
            const bf16x8 wa_f = *(const LAS bf16x8*)(lds + LR_WF + (2 * s) * 1024 + lane * 16), wx_f = *(const LAS bf16x8*)(lds + LR_WF + (2 * s + 1) * 1024 + lane * 16);
            R = MFMA32(af, wa_f, R); I = MFMA32(af, wx_f, I);
        }
        float av_[16], uv_[16];
#pragma unroll
        for (int i = 0; i < 16; ++i) {
            const float xcf = xcw[crow(i, hh) * XCS + 32 * half + r];
            const float rr = __builtin_amdgcn_rcpf(1.0f + __builtin_amdgcn_exp2f(-(R[i] + ba_c) * LOG2E));
            const float ii = __builtin_amdgcn_rcpf(1.0f + __builtin_amdgcn_exp2f(-(I[i] + bx_c) * LOG2E));
            const float la2 = -rr * spl2;
            const float a = __builtin_amdgcn_exp2f(la2);
            const float y = la2 * (2.0f / LOG2E);
            const float om = (y > -0.25f) ? -y * (1.0f + y * (0.5f + y * ((1.0f / 6.0f) + y * ((1.0f / 24.0f) + y * (1.0f / 120.0f))))) : 1.0f - a * a;
            av_[i] = a; uv_[i] = sqrtf(om) * ii * xcf;
        }
        asm volatile("" ::: "memory");
        float Ag[4], Bg[4], pA[4], pB[4];
#pragma unroll
        for (int g = 0; g < 4; ++g) {
            Ag[g] = (av_[4 * g] * av_[4 * g + 1]) * (av_[4 * g + 2] * av_[4 * g + 3]);
            Bg[g] = ((uv_[4 * g] * av_[4 * g + 1] + uv_[4 * g + 1]) * av_[4 * g + 2] + uv_[4 * g + 2]) * av_[4 * g + 3] + uv_[4 * g + 3];
            pA[g] = sx32(Ag[g], lane); pB[g] = sx32(Bg[g], lane);
        }
        float hcur = 0.f, acur = 1.0f;
#pragma unroll
        for (int g = 0; g < 4; ++g) {
            const float A0 = hh == 0 ? Ag[g] : pA[g], B0 = hh == 0 ? Bg[g] : pB[g];
            const float A1 = hh == 0 ? pA[g] : Ag[g], B1 = hh == 0 ? pB[g] : Bg[g];
            const float s0 = hcur, c0 = acur; hcur = A0 * hcur + B0; acur *= A0;
            const float s1 = hcur, c1 = acur; hcur = A1 * hcur + B1; acur *= A1;
            float hv = hh == 0 ? s0 : s1, ac = hh == 0 ? c0 : c1;
#pragma unroll
            for (int i = 4 * g; i < 4 * g + 4; ++i) { hv = av_[i] * hv + uv_[i]; ac *= av_[i]; uv_[i] = hv; av_[i] = ac; }
        }
        if (hh == 0) { exch[(wid * 32 + r) * 2] = acur; exch[(wid * 32 + r) * 2 + 1] = hcur; }
        __syncthreads();
        float hin = carry, run = carry;
#pragma unroll
        for (int w8 = 0; w8 < 8; ++w8) { if (w8 == wid) hin = run; run = exch[(w8 * 32 + r) * 2] * run + exch[(w8 * 32 + r) * 2 + 1]; }
        carry = run;
        LAS unsigned char* ot = (LAS unsigned char*)xcw;
#pragma unroll
        for (int i = 0; i < 16; ++i) {
            const int tl = crow(i, hh);
            const float hv = uv_[i] + av_[i] * hin;
            const float gv = bflo((unsigned)*(const LAS unsigned short*)(lds + LR_GR + (32 * wid + tl) * 64 + r * 2));
            const float yy = 0.7978845608028654f * (gv + 0.044715f * gv * gv * gv);
            const float ge = gv * __builtin_amdgcn_rcpf(1.0f + __builtin_amdgcn_exp2f(-2.0f * LOG2E * yy));
            *(LAS unsigned short*)(ot + tl * 64 + r * 2) = (unsigned short)(pk2(hv * ge, 0.f) & 0xffffu);
        }
        LDS_WAIT();
#pragma unroll
        for (int k2 = 0; k2 < 2; ++k2) {
            const int idx = lane + 64 * k2, row = idx >> 2, pc = idx & 3;
            const u32x4 w = *(const LAS u32x4*)(ot + row * 64 + pc * 16);
            *(u32x4*)(A.Y + (rowbase + 256 * cch + 32 * wid + row) * 1024 + 64 * n + 32 * half + 8 * pc) = w;
        }
        asm volatile("" ::: "memory");
    }
#undef LRU_LOAD
}

__device__ __forceinline__ float wave_sum(float v, int lane) {
#pragma unroll
    for (int o = 1; o < 64; o <<= 1) v += sx(v, o, lane);
    return v;
}
__device__ __forceinline__ int headperm(int n) { return (n & ~255) | (((n >> 5) & 1) << 7) | (((n >> 6) & 3) << 5) | (n & 31); }
struct TrItem { const float* W; bf16_t* WT; int N, K, k0, n0, d0, perm; };
__device__ __forceinline__ void tr_load(const TrItem& t, int lane, float (&tv)[32]) {
#pragma unroll
    for (int i = 0; i < 32; ++i) { const int kk = 2 * i + (lane >> 5); tv[i] = t.W[(size_t)(t.k0 + kk) * t.N + t.n0 + (lane & 31)]; }
}
__device__ __forceinline__ void tr_store(const TrItem& t, int lane, const float (&tv)[32], LAS float* scr) {
#pragma unroll
    for (int i = 0; i < 32; ++i) { const int kk = 2 * i + (lane >> 5); scr[kk * 33 + (lane & 31)] = tv[i]; }
    LDS_WAIT();
    const int c8 = lane & 7;
#pragma unroll
    for (int j = 0; j < 4; ++j) { const int nl = (lane >> 3) + 8 * j; const LAS float* sp = scr + (8 * c8) * 33 + nl; const int n = t.perm ? (16 * ((nl >> 2) & 1) + 4 * (nl >> 3) + (nl & 3)) : nl;
        u32x4 o; o.x = pk2(sp[0 * 33], sp[1 * 33]); o.y = pk2(sp[2 * 33], sp[3 * 33]); o.z = pk2(sp[4 * 33], sp[5 * 33]); o.w = pk2(sp[6 * 33], sp[7 * 33]);
        *(u32x4*)(t.WT + (size_t)(t.d0 + n) * t.K + t.k0 + 8 * c8) = o; }
    LDS_WAIT();
}

#define XB_TMO      128
#define XB_XCNT(j)  (256  + 64 * (j))
#define XB_XSUB(j)  (1280 + 64 * (j))
#define XB_XGEN(j)  (2304 + 64 * (j))
#define XB_TOP      3328
#define XB_TOPGEN   3392
#define XCD_BAR_WORDS 3456
#define XB_SPIN_CAP (1u << 20)
__device__ __forceinline__ unsigned xb_ld(unsigned* p)              { return __hip_atomic_load(p, __ATOMIC_RELAXED, __HIP_MEMORY_SCOPE_AGENT); }
__device__ __forceinline__ unsigned xb_add(unsigned* p, unsigned v) { return __hip_atomic_fetch_add(p, v, __ATOMIC_RELAXED, __HIP_MEMORY_SCOPE_AGENT); }
__device__ __forceinline__ unsigned xb_xcc_id() { return (unsigned)__builtin_amdgcn_s_getreg((3 << 11) | 20) & 0xFu; }
#define XB_SPIN(cond, bar) do { unsigned _sp = 0; while (cond) { __builtin_amdgcn_s_sleep(1); \
    if ((++_sp & 255u) == 0u) { if (xb_ld(&(bar)[XB_TMO])) break; if (_sp > XB_SPIN_CAP) { atomicAdd(&(bar)[XB_TMO], 1u); break; } } } } while (0)
struct XcdBarrier { unsigned* bar; unsigned x; volatile LAS unsigned* st; };
__device__ __forceinline__ void xcd_barrier_complete(unsigned* bar, unsigned x, unsigned& nloc, unsigned& nx) {
    const unsigned G = gridDim.x * gridDim.y * gridDim.z;
    unsigned sum, cnt, mine, sp = 0u;
    for (;;) {
        sum = 0u; cnt = 0u; mine = 0u;
#pragma unroll
        for (unsigned j = 0; j < 16; ++j) { const unsigned c = xb_ld(&bar[XB_XCNT(j)]); sum += c; cnt += (c > 0u) ? 1u : 0u; mine = (j == x) ? c : mine; }
        if (sum == G) break;
        __builtin_amdgcn_s_sleep(1);
        if ((++sp & 255u) == 0u) { if (xb_ld(&bar[XB_TMO])) break; if (sp > XB_SPIN_CAP) { atomicAdd(&bar[XB_TMO], 1u); break; } }
    }
    nloc = mine > 0u ? mine : 1u; nx = cnt > 0u ? cnt : 1u;
}
__device__ __forceinline__ void xcd_barrier(const XcdBarrier& b, const bool leader) {
    asm volatile("s_waitcnt vmcnt(0)" ::: "memory");
    __syncthreads();
    if (leader) {
        unsigned* bar = b.bar;
        __builtin_amdgcn_s_waitcnt(0);
        unsigned nloc = b.st[0], nx = b.st[1];
        if (nloc == 0u) { xcd_barrier_complete(bar, b.x, nloc, nx); b.st[0] = nloc; b.st[1] = nx; }
        const unsigned old = xb_add(&bar[XB_XSUB(b.x)], 1u);
        const unsigned gen = old / nloc;
        if (old + 1u == (gen + 1u) * nloc) {
            __builtin_amdgcn_fence(__ATOMIC_RELEASE, "agent");
            asm volatile("s_waitcnt vmcnt(0)" ::: "memory");
            const unsigned og = xb_add(&bar[XB_TOP], 1u);
            const unsigned tg = og / nx;
            if (og + 1u == (tg + 1u) * nx) xb_add(&bar[XB_TOPGEN], 1u);
            else XB_SPIN(xb_ld(&bar[XB_TOPGEN]) == tg, bar);
            __builtin_amdgcn_fence(__ATOMIC_ACQUIRE, "agent");
            xb_add(&bar[XB_XGEN(b.x)], 1u);
            asm volatile("s_waitcnt vmcnt(0)" ::: "memory");
        } else {
            XB_SPIN(xb_ld(&bar[XB_XGEN(b.x)]) == gen, bar);
            __builtin_amdgcn_fence(__ATOMIC_ACQUIRE, "agent");
            asm volatile("s_waitcnt vmcnt(0)" ::: "memory");
        }
    }
    __syncthreads();
}

struct Args { const float* in[27]; float* out; unsigned char* ws; };

__global__ void __launch_bounds__(512, 2) fwd_mega(Args args) {
    extern __shared__ __attribute__((aligned(16))) unsigned char lds_raw[];
    LAS unsigned char* lds = (LAS unsigned char*)lds_raw;
    cg::grid_group grid = cg::this_grid();
#ifndef STAGGER_TICKS
#define STAGGER_TICKS 0
#endif
#define STAGGER() do { if (STAGGER_TICKS > 0 && ((bid >> 3) & 1)) { const unsigned long long t0_ = __builtin_amdgcn_s_memrealtime(); while (__builtin_amdgcn_s_memrealtime() - t0_ < (unsigned long long)STAGGER_TICKS) __builtin_amdgcn_s_sleep(16); } } while (0)
#define GSYNC_CG() do { if (args.ws == nullptr) grid.sync(); GSYNC(); } while (0)
#define GSYNC() do { int l_; asm volatile("v_mbcnt_lo_u32_b32 %0, -1, 0\n\tv_mbcnt_hi_u32_b32 %0, -1, %0" : "=v"(l_)); xcd_barrier(xbar, wid_s == 0 && l_ == 0); if (DUP_MASK & 4) xcd_barrier(xbar, wid_s == 0 && l_ == 0); } while (0)
    const int G = gridDim.x, bid = blockIdx.x, NGW = G * 8;
    const int wid_s = __builtin_amdgcn_readfirstlane((int)threadIdx.x >> 6);
    XcdBarrier xbar;
    {
        volatile LAS unsigned* st = (volatile LAS unsigned*)(lds + 139264);
        if (threadIdx.x < 4) st[threadIdx.x] = 0u;
        __syncthreads();
        xbar.bar = (unsigned*)(args.ws + WS_BAR); xbar.x = xb_xcc_id(); xbar.st = st;
        if (threadIdx.x == 0) (void)xb_add(&xbar.bar[XB_XCNT(xbar.x)], 1u);
    }
#define PHASE_IDS int lane_; asm volatile("v_mbcnt_lo_u32_b32 %0, -1, 0\n\tv_mbcnt_hi_u32_b32 %0, -1, %0" : "=v"(lane_)); const int lane = lane_ & 63; const int wid = wid_s; const int tid = wid * 64 + lane; const int gw = bid * 8 + wid; (void)gw;
    unsigned char* ws = args.ws;
    const float* x = args.in[0]; const float* cc = args.in[1]; const float* ada_w = args.in[2]; const float* ada_b = args.in[3];
    const float* norm_mix_g = args.in[4]; const float* norm_ffn_g = args.in[5];
    float* MOD = (float*)(ws + WS_MOD); float* SHW = (float*)(ws + WS_SHW);
    float* SSQ0 = (float*)(ws + WS_SSQ0); float* SSQ1 = (float*)(ws + WS_SSQ1); float* SSQ2 = (float*)(ws + WS_SSQ2); float* SSQ3 = (float*)(ws + WS_SSQ3);
    bf16_t* XG = (bf16_t*)(ws + WS_XG); bf16_t* PB = (bf16_t*)(ws + WS_P); bf16_t* YB = (bf16_t*)(ws + WS_Y); bf16_t* ACT = (bf16_t*)(ws + WS_ACT); bf16_t* XS = (bf16_t*)(ws + WS_XS);
    float* HALO = (float*)(ws + WS_HALO); float* FIXP = (float*)(ws + WS_FIXP); float* FIXU = (float*)(ws + WS_FIXU);
    bf16_t* W_IN0 = (bf16_t*)(ws + WS_W_IN0); bf16_t* W_OUT0 = (bf16_t*)(ws + WS_W_OUT0); bf16_t* W_GU0 = (bf16_t*)(ws + WS_W_GU0); bf16_t* W_DN0 = (bf16_t*)(ws + WS_W_DN0);
    bf16_t* W_IN1 = (bf16_t*)(ws + WS_W_IN1); bf16_t* W_OUT1 = (bf16_t*)(ws + WS_W_OUT1); bf16_t* W_GU1 = (bf16_t*)(ws + WS_W_GU1); bf16_t* W_DN1 = (bf16_t*)(ws + WS_W_DN1);

    for (int prep = 0; prep < ((DUP_MASK & 8) ? 2 : 1); ++prep) {
    for (int item = bid; item < 256; item += G) {
        PHASE_IDS
        const int l = item >> 7, chunk = item & 127;
        LAS float* sl = (LAS float*)lds;
        LAS float* part = (LAS float*)(lds + 65536);
        __syncthreads();
        for (int idx = tid; idx < 16384; idx += 512) { const float v = cc[idx]; sl[idx] = v / (1.0f + __expf(-v)); }
        __syncthreads();
        float acc[16];
#pragma unroll
        for (int bb = 0; bb < 16; ++bb) acc[bb] = 0.f;
        const int colc = chunk * 48 + (lane < 48 ? lane : 47);
        const float* Wp = ada_w + (size_t)l * 1024 * 6144 + colc;
        float wv[16], wn[16];
#pragma unroll
        for (int j = 0; j < 16; ++j) { wv[j] = Wp[(size_t)(128 * wid + j) * 6144]; wn[j] = 0.f; }
        for (int k = 128 * wid; k < 128 * wid + 128; k += 16) {
            if (k + 16 < 128 * wid + 128) {
#pragma unroll
                for (int j = 0; j < 16; ++j) wn[j] = Wp[(size_t)(k + 16 + j) * 6144];
            }
#pragma unroll
            for (int j4 = 0; j4 < 4; ++j4)
#pragma unroll
                for (int bb = 0; bb < 16; ++bb) { const f32x4 s4 = *(const LAS f32x4*)(sl + bb * 1024 + k + 4 * j4); acc[bb] += (s4[0] * wv[4 * j4] + s4[1] * wv[4 * j4 + 1]) + (s4[2] * wv[4 * j4 + 2] + s4[3] * wv[4 * j4 + 3]); }
#pragma unroll
            for (int j = 0; j < 16; ++j) wv[j] = wn[j];
        }
#pragma unroll
        for (int bb = 0; bb < 16; ++bb) part[(wid * 16 + bb) * 64 + lane] = acc[bb];
        __syncthreads();
        for (int o = tid; o < 1024; o += 512) {
            const int bb = o >> 6, cl = o & 63;
            if (cl < 48) {
                float sacc = ada_b[l * 6144 + chunk * 48 + cl];
#pragma unroll
                for (int w8 = 0; w8 < 8; ++w8) sacc += part[(w8 * 16 + bb) * 64 + cl];
                MOD[((size_t)l * 16 + bb) * 6144 + chunk * 48 + cl] = sacc;
            }
        }
        __syncthreads();
    }
    {
        PHASE_IDS
        LAS float* scr = (LAS float*)(lds + wid * 16384);
        constexpr int NITEMS = 1280 + 512 + 3 * 1408 + 768 + 512 + 3 * 1408;
#define TR_DECODE(T_, it_) do { int rI = (it_); int mapk; \
            if (rI < 1280) { T_.W = args.in[6]; T_.N = 2560; T_.K = 1024; T_.WT = W_IN0; mapk = 1; } \
            else if ((rI -= 1280) < 512) { T_.W = args.in[16]; T_.N = 1024; T_.K = 1024; T_.WT = W_OUT0; mapk = 0; } \
            else if ((rI -= 512) < 1408) { T_.W = args.in[22]; T_.N = FF; T_.K = 1024; T_.WT = W_GU0; mapk = 3; } \
            else if ((rI -= 1408) < 1408) { T_.W = args.in[23]; T_.N = FF; T_.K = 1024; T_.WT = W_GU0; mapk = 4; } \
            else if ((rI -= 1408) < 1408) { T_.W = args.in[26]; T_.N = 1024; T_.K = FF; T_.WT = W_DN0; mapk = 0; } \
            else if ((rI -= 1408) < 768) { T_.W = args.in[17]; T_.N = 1536; T_.K = 1024; T_.WT = W_IN1; mapk = 2; } \
            else if ((rI -= 768) < 512) { T_.W = args.in[21]; T_.N = 1024; T_.K = 1024; T_.WT = W_OUT1; mapk = 0; } \
            else if ((rI -= 512) < 1408) { T_.W = args.in[22] + (size_t)1024 * FF; T_.N = FF; T_.K = 1024; T_.WT = W_GU1; mapk = 3; } \
            else if ((rI -= 1408) < 1408) { T_.W = args.in[23] + (size_t)1024 * FF; T_.N = FF; T_.K = 1024; T_.WT = W_GU1; mapk = 4; } \
            else { rI -= 1408; T_.W = args.in[26] + (size_t)FF * 1024; T_.N = 1024; T_.K = FF; T_.WT = W_DN1; mapk = 0; } \
            const int nblk = T_.N / 32, kb_ = rI / nblk, nb_ = rI % nblk; T_.k0 = 64 * kb_; T_.n0 = 32 * nb_; \
            int d0 = T_.n0; \
            if (mapk == 1) { const int region = T_.n0 >> 9; if (region == 2 || region == 3) d0 = headperm(T_.n0); } \
            else if (mapk == 2) { if (T_.n0 < 1280) d0 = headperm(T_.n0); } \
            else if (mapk == 3) d0 = 256 * (T_.n0 >> 7) + (T_.n0 & 127); \
            else if (mapk == 4) d0 = 256 * (T_.n0 >> 7) + 128 + (T_.n0 & 127); \
            T_.d0 = d0; T_.perm = 1; } while (0)
        for (int it = gw; it < NITEMS; it += 2 * NGW) {
            const bool two = (it + NGW) < NITEMS;
            TrItem ta, tb; TR_DECODE(ta, it); TR_DECODE(tb, two ? it + NGW : it);
            float va[32], vb[32];
            tr_load(ta, lane, va);
            if (two) tr_load(tb, lane, vb);
            tr_store(ta, lane, va, scr);
            if (two) tr_store(tb, lane, vb, scr);
        }
#undef TR_DECODE
    }
    GSYNC_CG();

    {
    PHASE_IDS
    for (int i0 = 0; i0 < 32; i0 += 8) {
        f32x4 v4[8];
#pragma unroll
        for (int i = 0; i < 8; ++i) {
            const int e = (tid + 512 * (i0 + i)) * 4, gi = e >> 14, bb = (e >> 10) & 15, k = e & 1023;
            v4[i] = *(const f32x4*)(MOD + ((size_t)((gi >> 1) * 16 + bb)) * 6144 + ((gi & 1) ? 3 * 1024 : 0) + k);
        }
#pragma unroll
        for (int i = 0; i < 8; ++i) {
            const int e = (tid + 512 * (i0 + i)) * 4;
            u32x2 w; w.x = pk2(v4[i][0], v4[i][1]); w.y = pk2(v4[i][2], v4[i][3]);
            *(LAS u32x2*)(lds + (size_t)e * 2) = w;
        }
    }
    {
        const int mbase = gw * (M / NGW);
        const int bb = mbase >> 11;
        f32x4 gm[4];
#pragma unroll
        for (int j = 0; j < 4; ++j) { const int c4 = 2 * lane + (j & 1) + 128 * (j >> 1);
            gm[j] = *((const f32x4*)norm_mix_g + c4) * (*((const f32x4*)(MOD + (size_t)bb * 6144 + 1024) + c4) + 1.0f); }
        const int nrow = M / NGW;
        for (int i0 = 0; i0 + 4 <= nrow; i0 += 4) {
            f32x4 v[4][4];
#pragma unroll
            for (int rr = 0; rr < 4; ++rr)
#pragma unroll
                for (int j = 0; j < 4; ++j) v[rr][j] = *((const f32x4*)(x + (size_t)(mbase + i0 + rr) * 1024) + 2 * lane + (j & 1) + 128 * (j >> 1));
            float sacc[4];
#pragma unroll
            for (int rr = 0; rr < 4; ++rr) {
                u32x4* op = (u32x4*)(XG + (size_t)(mbase + i0 + rr) * 1024) + lane;
                sacc[rr] = 0.f;
#pragma unroll
                for (int jj = 0; jj < 2; ++jj) {
                    const f32x4 q0 = v[rr][2 * jj] * v[rr][2 * jj], q1 = v[rr][2 * jj + 1] * v[rr][2 * jj + 1];
                    sacc[rr] += ((q0[0] + q0[1]) + (q0[2] + q0[3])) + ((q1[0] + q1[1]) + (q1[2] + q1[3]));
                    const f32x4 o0 = v[rr][2 * jj] * gm[2 * jj], o1 = v[rr][2 * jj + 1] * gm[2 * jj + 1];
                    u32x4 w; w.x = pk2(o0[0], o0[1]); w.y = pk2(o0[2], o0[3]); w.z = pk2(o1[0], o1[1]); w.w = pk2(o1[2], o1[3]); op[64 * jj] = w;
                }
            }
#pragma unroll
            for (int o = 1; o < 64; o <<= 1) {
#pragma unroll
                for (int rr = 0; rr < 4; ++rr) sacc[rr] += sx(sacc[rr], o, lane);
            }
            if (lane < 4) SSQ0[mbase + i0 + lane] = lane == 0 ? sacc[0] : (lane == 1 ? sacc[1] : (lane == 2 ? sacc[2] : sacc[3]));
        }
    }
    __syncthreads();
    {
        constexpr int NROWS = 2560 + 5632 + 1536 + 5632;
        for (int p0 = gw; p0 < NROWS; p0 += 2 * NGW) {
            asm volatile("" ::: "memory");
            u32x4 r0[2], r1[2]; int gi_[2], pl_[2], N_[2]; float* out_[2];
#pragma unroll
            for (int rr = 0; rr < 2; ++rr) {
                int p = p0 + rr * NGW; if (p >= NROWS) p = p0;
                const bf16_t* Wt; int gi, pl, N; float* outp;
                if (p < 2560) { gi = 0; pl = p; N = 2560; Wt = W_IN0; outp = SHW + SHW_IN0; }
                else if (p < 8192) { gi = 1; pl = p - 2560; N = 5632; Wt = W_GU0; outp = SHW + SHW_GU0; }
                else if (p < 9728) { gi = 2; pl = p - 8192; N = 1536; Wt = W_IN1; outp = SHW + SHW_IN1; }
                else { gi = 3; pl = p - 9728; N = 5632; Wt = W_GU1; outp = SHW + SHW_GU1; }
                r0[rr] = *(const u32x4*)(Wt + (size_t)pl * 1024 + 8 * lane); r1[rr] = *(const u32x4*)(Wt + (size_t)pl * 1024 + 512 + 8 * lane);
                gi_[rr] = gi; pl_[rr] = pl; N_[rr] = N; out_[rr] = outp;
            }
#pragma unroll
            for (int rr = 0; rr < 2; ++rr) {
                if (rr == 1 && p0 + NGW >= NROWS) break;
                float wv[16];
                wv[0] = bflo(r0[rr].x); wv[1] = bfhi(r0[rr].x); wv[2] = bflo(r0[rr].y); wv[3] = bfhi(r0[rr].y); wv[4] = bflo(r0[rr].z); wv[5] = bfhi(r0[rr].z); wv[6] = bflo(r0[rr].w); wv[7] = bfhi(r0[rr].w);
                wv[8] = bflo(r1[rr].x); wv[9] = bfhi(r1[rr].x); wv[10] = bflo(r1[rr].y); wv[11] = bfhi(r1[rr].y); wv[12] = bflo(r1[rr].z); wv[13] = bfhi(r1[rr].z); wv[14] = bflo(r1[rr].w); wv[15] = bfhi(r1[rr].w);
                float d[16];
                const LAS unsigned char* sbase = lds + (size_t)gi_[rr] * 32768 + 16 * lane;
#pragma unroll
                for (int bb = 0; bb < 16; ++bb) {
                    const u32x4 s0 = *(const LAS u32x4*)(sbase + bb * 2048), s1 = *(const LAS u32x4*)(sbase + bb * 2048 + 1024);
                    d[bb] = (wv[0] * bflo(s0.x) + wv[1] * bfhi(s0.x)) + (wv[2] * bflo(s0.y) + wv[3] * bfhi(s0.y)) + (wv[4] * bflo(s0.z) + wv[5] * bfhi(s0.z)) + (wv[6] * bflo(s0.w) + wv[7] * bfhi(s0.w))
                          + (wv[8] * bflo(s1.x) + wv[9] * bfhi(s1.x)) + (wv[10] * bflo(s1.y) + wv[11] * bfhi(s1.y)) + (wv[12] * bflo(s1.z) + wv[13] * bfhi(s1.z)) + (wv[14] * bflo(s1.w) + wv[15] * bfhi(s1.w));
                }
                const bool h5 = (lane & 32) != 0, h4 = (lane & 16) != 0, h3 = (lane & 8) != 0, h2 = (lane & 4) != 0;
                float e8[8], e4[4], e2[2];
#pragma unroll
                for (int j = 0; j < 8; ++j) { const float snd = h5 ? d[j] : d[j + 8], kp = h5 ? d[j + 8] : d[j]; e8[j] = kp + sx32(snd, lane); }
#pragma unroll
                for (int j = 0; j < 4; ++j) { const float snd = h4 ? e8[j] : e8[j + 4], kp = h4 ? e8[j + 4] : e8[j]; e4[j] = kp + sx16(snd, lane); }
#pragma unroll
                for (int j = 0; j < 2; ++j) { const float snd = h3 ? e4[j] : e4[j + 2], kp = h3 ? e4[j + 2] : e4[j]; e2[j] = kp + sx(snd, 8, lane); }
                float tot; { const float snd = h2 ? e2[0] : e2[1], kp = h2 ? e2[1] : e2[0]; tot = kp + sx(snd, 4, lane); }
                tot += sx(tot, 2, lane); tot += sx(tot, 1, lane);
                const int bsel = (h5 ? 8 : 0) + (h4 ? 4 : 0) + (h3 ? 2 : 0) + (h2 ? 1 : 0);
                if ((lane & 3) == 0) out_[rr][(size_t)bsel * N_[rr] + pl_[rr]] = tot;
            }
        }
    }
    }
    GSYNC();

    }
    pg8::StaticOrder S;
    {
        PHASE_IDS
        pg8::Gemm g{XG, W_IN0, M, 2560, 1024}; S.init(M, 2560, G, bid);
        EpiIn<0> E{SSQ0, SHW + SHW_IN0, 2560, PB, args.in[14], args.in[15]};
        pg8::gemm_phase<EpiIn<0>>(lds, g, S, E, tid);
    }
#if (DUP_MASK & 32)
    {
        PHASE_IDS
        pg8::Gemm g{XG, W_IN0, M, 2560, 1024}; S.init(M, 2560, G, bid);
        EpiIn<0> E{SSQ0, SHW + SHW_IN0, 2560, PB, args.in[14], args.in[15]};
        pg8::gemm_phase<EpiIn<0>>(lds, g, S, E, tid);
    }
#endif
    GSYNC();

    {
        const bf16_t* XR = PB; const bf16_t* GR = PB + (size_t)M * 512; const bf16_t* Qb = PB + (size_t)2 * M * 512; const bf16_t* Kb = PB + (size_t)3 * M * 512; const bf16_t* Vb = PB + (size_t)4 * M * 512;
        PHASE_IDS
        LruArgs LA{XR, GR, YB, args.in[7], args.in[8], args.in[9], args.in[10], args.in[11], args.in[12], args.in[13]};
        for (int rep = 0; rep < ((DUP_MASK & 1) ? 2 : 1); ++rep) {
        for (int rep2 = 0; rep2 < ((DUP_MASK & 256) ? 2 : 1); ++rep2)
        for (int item = bid; item < 256; item += G) lru_item(lds, LA, item, tid, wid, lane);
        __syncthreads();
        for (int bu = bid; bu < 1024; bu += G) {
            const int bh = bu & 127, qhi = 7 - (bu >> 7);
            sb_wave(lds + wid * SBW_BYTES, Qb, Kb, Vb, YB, bh >> 3, bh & 7, qhi * 8 + wid, lane);
        }
        }
    }
    GSYNC();

    {
        PHASE_IDS
        pg8::Gemm g{YB, W_OUT0, M, 1024, 1024}; S.init(M, 1024, G, bid);
        EpiRes<false, false> E{nullptr, nullptr, MOD + 2 * 1024, norm_mix_g, MOD + 1 * 1024, norm_ffn_g, MOD + 4 * 1024, XG, SSQ1};
        pg8::gemm_phase<EpiRes<false, false>>(lds, g, S, E, tid);
    }
    GSYNC();

    for (int layer = 0; layer < 2; ++layer) {
        if (layer == 1) {
            {
                PHASE_IDS
                pg8::Gemm g{XG, W_IN1, M, 1536, 1024}; S.init(M, 1536, G, bid);
                EpiIn<1> E{SSQ2, SHW + SHW_IN1, 1536, PB, args.in[18], args.in[19]};
                pg8::gemm_phase<EpiIn<1>>(lds, g, S, E, tid);
            }
            GSYNC();
            {
                const bf16_t* Qb = PB; const bf16_t* Kb = PB + (size_t)M * 1024; const bf16_t* Vb = Kb + (size_t)M * 256;
                PHASE_IDS
                for (int rep = 0; rep < ((DUP_MASK & 16) ? 2 : 1); ++rep)
                swa_phase(lds, Qb, Kb, Vb, args.in[20], YB, bid, G, tid, wid, lane);
            }
            GSYNC();
            {
                PHASE_IDS
                pg8::Gemm g{YB, W_OUT1, M, 1024, 1024}; S.init(M, 1024, G, bid);
                EpiRes<false, false> E{nullptr, nullptr, MOD + (size_t)16 * 6144 + 2 * 1024, norm_mix_g + 1024, MOD + (size_t)16 * 6144 + 1 * 1024, norm_ffn_g + 1024, MOD + (size_t)16 * 6144 + 4 * 1024, XG, SSQ3};
                pg8::gemm_phase<EpiRes<false, false>>(lds, g, S, E, tid);
            }
            GSYNC();
        }
#if (DUP_MASK & 64)
        {
            PHASE_IDS
            pg8::Gemm g{XG, layer ? W_GU1 : W_GU0, M, 5632, 1024}; S.init(M, 5632, G, bid);
            EpiGU E{layer ? SSQ3 : SSQ1, SHW + (layer ? SHW_GU1 : SHW_GU0), args.in[24] + (size_t)layer * 3 * FF, args.in[25] + (size_t)layer * FF, ACT, HALO, FIXP, FIXU};
            pg8::gemm_phase<EpiGU>(lds, g, S, E, tid);
        }
#endif
        {
            PHASE_IDS
            pg8::Gemm g{XG, layer ? W_GU1 : W_GU0, M, 5632, 1024}; S.init(M, 5632, G, bid);
            EpiGU E{layer ? SSQ3 : SSQ1, SHW + (layer ? SHW_GU1 : SHW_GU0), args.in[24] + (size_t)layer * 3 * FF, args.in[25] + (size_t)layer * FF, ACT, HALO, FIXP, FIXU};
            pg8::gemm_phase<EpiGU>(lds, g, S, E, tid);
        }
        GSYNC();
        {
            PHASE_IDS
            const float* cw = args.in[24] + (size_t)layer * 3 * FF;
            pg8::StaticOrder SF; SF.init(M, 1024, G, bid);
            Unit fu; int prev_pm = -1;
            for (int ui = 0; SF.next(ui, fu); ++ui) {
                if (fu.pm == prev_pm) continue;
                prev_pm = fu.pm;
                for (int base = tid; base < 8 * 704; base += 4 * 512) {
                    f32x4 P4[4], U4[4], H1[4], H2[4], W0[4], W1[4];
#pragma unroll
                    for (int q = 0; q < 4; ++q) {
                        int idx = base + 512 * q; if (idx >= 8 * 704) idx = 8 * 704 - 1;
                        const int c4 = idx % 704, sr = idx / 704, s_ = sr & 1, gs = 4 * fu.pm + (sr >> 1);
                        const size_t fo = ((size_t)gs * 2 + s_) * FF + 4 * c4;
                        const int gp = gs > 0 ? gs - 1 : 0;
                        P4[q] = *(const f32x4*)(FIXP + fo); U4[q] = *(const f32x4*)(FIXU + fo);
                        H1[q] = *(const f32x4*)(HALO + ((size_t)gp * 2 + 1) * FF + 4 * c4); H2[q] = *(const f32x4*)(HALO + ((size_t)gp * 2) * FF + 4 * c4);
                        W0[q] = *(const f32x4*)(cw + 4 * c4); W1[q] = *(const f32x4*)(cw + FF + 4 * c4);
                    }
#pragma unroll
                    for (int q = 0; q < 4; ++q) {
                        const int idx = base + 512 * q;
                        if (idx < 8 * 704) {
                            const int c4 = idx % 704, sr = idx / 704, s_ = sr & 1, gs = 4 * fu.pm + (sr >> 1);
                            f32x4 a4 = P4[q];
                            if ((gs & 31) != 0) { if (s_ == 0) a4 = a4 + W1[q] * H1[q] + W0[q] * H2[q]; else a4 = a4 + W0[q] * H1[q]; }
                            const f32x4 o = silu4(a4) * U4[q]; u32x2 w; w.x = pk2(o[0], o[1]); w.y = pk2(o[2], o[3]);
                            *(u32x2*)(ACT + (size_t)(gs * 64 + s_) * FF + 4 * c4) = w;
                        }
                    }
                }
            }
            asm volatile("s_waitcnt vmcnt(0)" ::: "memory");
            __syncthreads();
        }
        if (layer == 0) {
            PHASE_IDS
            pg8::Gemm g{ACT, W_DN0, M, 1024, FF}; S.init(M, 1024, G, bid);
            EpiRes<false, false> E{nullptr, nullptr, MOD + 5 * 1024, norm_ffn_g, MOD + 4 * 1024, norm_mix_g + 1024, MOD + (size_t)16 * 6144 + 1 * 1024, XG, SSQ2};
            pg8::gemm_phase<EpiRes<false, false>>(lds, g, S, E, tid);
#if (DUP_MASK & 1024)
            { EpiNull E3{HALO}; pg8::gemm_phase<EpiNull>(lds, g, S, E3, tid); }
#endif
            GSYNC();
        } else {
            PHASE_IDS
            pg8::Gemm g{ACT, W_DN1, M, 1024, FF}; S.init(M, 1024, G, bid);
            EpiRes<false, true> E{nullptr, args.out, MOD + (size_t)16 * 6144 + 5 * 1024, norm_ffn_g + 1024, MOD + (size_t)16 * 6144 + 4 * 1024, nullptr, nullptr, XG, nullptr};
            pg8::gemm_phase<EpiRes<false, true>>(lds, g, S, E, tid);
        }
    }
}

extern "C" void kernel_launch(void* const* d_in, const int* in_sizes, int n_in, void* d_out, int out_size, void* d_ws, size_t ws_size, hipStream_t stream) {
    static int grid = 0;
    if (grid == 0) {
        if (n_in != 27 || out_size != M * DM || ws_size < WS_END) { fprintf(stderr, "kernel_launch: unexpected shapes (n_in %d out %d ws %zu)\n", n_in, out_size, ws_size); grid = -1; return; }
        int dev = 0, cus = 0, per_cu = 0;
        (void)hipGetDevice(&dev);
        (void)hipDeviceGetAttribute(&cus, hipDeviceAttributeMultiprocessorCount, dev);
        (void)hipFuncSetAttribute((const void*)fwd_mega, hipFuncAttributeMaxDynamicSharedMemorySize, LDS_BYTES);
        (void)hipOccupancyMaxActiveBlocksPerMultiprocessor(&per_cu, (const void*)fwd_mega, 512, LDS_BYTES);
        (void)hipGetLastError();
        grid = cus;
        if (per_cu < 1) fprintf(stderr, "kernel_launch: occupancy query says %d blocks/CU\n", per_cu);
    }
    if (grid < 0) return;
    (void)hipMemsetAsync(d_ws, 0, WS_ZERO_BYTES, stream);
    Args a{};
    for (int i = 0; i < 27; ++i) a.in[i] = (const float*)d_in[i];
    a.out = (float*)d_out; a.ws = (unsigned char*)d_ws;
    void* kargs[] = {&a};
    hipError_t e = hipLaunchCooperativeKernel((const void*)fwd_mega, dim3(grid), dim3(512), kargs, LDS_BYTES, stream);
    if (e != hipSuccess) fprintf(stderr, "cooperative launch failed: %s (grid %d)\n", hipGetErrorString(e), grid);
}
```
